# Optimizing an MI355X kernel written in HIP

```python
import math
import jax, jax.numpy as jnp
from jax import lax
import numpy as np

D_MODEL = 4096
BATCH = 2
SEQ = 8192
DEPTH = 2

MIX_WIDTH = D_MODEL
GROUP_WIDTH = MIX_WIDTH // 4
CHUNK = 128
GMLP_HEAD_DIM = 128
GMLP_HEADS = GROUP_WIDTH // GMLP_HEAD_DIM
CONV_WIDTH = 31
CONV_PAD = CONV_WIDTH // 2
POOL_WINDOWS = (2, 4, 8, 16)
POOL_CH = GROUP_WIDTH // len(POOL_WINDOWS)
DIFF_HEAD_DIM = 64
DIFF_HEADS = GROUP_WIDTH // (2 * DIFF_HEAD_DIM)
ROT_DIM = DIFF_HEAD_DIM // 4
ROPE_THETA = 500000.0
Q_BLOCK = 128
D_FF = 4 * D_MODEL
IN_WIDTHS = (2 * GROUP_WIDTH, 2 * GROUP_WIDTH, GROUP_WIDTH, GROUP_WIDTH, GROUP_WIDTH, GROUP_WIDTH)
IN_SPLITS = tuple(int(s) for s in np.cumsum(IN_WIDTHS)[:-1])
D_IN = sum(IN_WIDTHS)

kernel_name = "hybrid_parallel_group_encoder_block"


def _rms_norm(x, g, eps=1e-6):
    xf = x.astype(jnp.float32)
    y = xf * lax.rsqrt(jnp.mean(xf * xf, axis=-1, keepdims=True) + eps)
    return (y * g.astype(jnp.float32)).astype(x.dtype)


def _layer_norm(x, g, b, eps=1e-5):
    xf = x.astype(jnp.float32)
    mu = jnp.mean(xf, axis=-1, keepdims=True)
    xc = xf - mu
    y = xc * lax.rsqrt(jnp.mean(xc * xc, axis=-1, keepdims=True) + eps)
    return (y * g.astype(jnp.float32) + b.astype(jnp.float32)).astype(x.dtype)


def _rope(x, cos, sin):
    half = ROT_DIM // 2
    shape = (1, x.shape[1]) + (1,) * (x.ndim - 3) + (half,)
    c = cos.reshape(shape)
    s = sin.reshape(shape)
    x1 = x[..., :half].astype(jnp.float32)
    x2 = x[..., half:ROT_DIM].astype(jnp.float32)
    return jnp.concatenate([(x1 * c - x2 * s).astype(x.dtype),
                            (x2 * c + x1 * s).astype(x.dtype),
                            x[..., ROT_DIM:]], axis=-1)


def _gmlp_mixer(z, ln_g, ln_b, ws, bs):
    z = jax.nn.gelu(z, approximate=False)
    u, v = jnp.split(z, 2, axis=-1)
    v = _layer_norm(v, ln_g, ln_b)
    b_, s_, _ = v.shape
    vc = v.reshape(b_, s_ // CHUNK, CHUNK, GMLP_HEADS, GMLP_HEAD_DIM)
    sv = jnp.einsum('hij,bnjhc->bnihc', ws, vc) + bs.T[None, None, :, :, None]
    return u * sv.reshape(b_, s_, GROUP_WIDTH)


def _conv_mixer(z, w, b, ln_g, ln_b):
    a, gate = jnp.split(z, 2, axis=-1)
    h = a * jax.nn.sigmoid(gate)
    h = lax.conv_general_dilated(h, w[:, None, :], window_strides=(1,),
                                 padding=[(CONV_PAD, CONV_PAD)],
                                 dimension_numbers=('NWC', 'WIO', 'NWC'),
                                 feature_group_count=GROUP_WIDTH) + b
    h = _layer_norm(h, ln_g, ln_b)
    return jax.nn.silu(h)


def _pool_mixer(z, pool_w, scale):
    b_, s_, _ = z.shape
    zf = z.astype(jnp.float32)
    cs = jnp.concatenate([jnp.zeros((b_, 1, GROUP_WIDTH), jnp.float32),
                          jnp.cumsum(zf, axis=1)], axis=1)
    t = jnp.arange(s_)
    outs = []
    for gi, w in enumerate(POOL_WINDOWS):
        lo = jnp.clip(t - w // 2, 0, s_)
        hi = jnp.clip(t + w // 2, 0, s_)
        sl = slice(gi * POOL_CH, (gi + 1) * POOL_CH)
        csg = cs[:, :, sl]
        mean = (csg[:, hi] - csg[:, lo]) / (hi - lo).astype(jnp.float32)[None, :, None]
        outs.append(mean - zf[:, :, sl])
    pooled = jnp.stack(outs, axis=2).astype(z.dtype)
    y = jnp.einsum('bsgc,gcd->bsgd', pooled, pool_w).reshape(b_, s_, GROUP_WIDTH)
    return y * scale


def _diff_attention(zq, zk, zv, qn_g, kn_g, lq1, lk1, lq2, lk2, subln_g, cos, sin, lam_init):
    b_, s_, _ = zq.shape
    q = zq.reshape(b_, s_, DIFF_HEADS, 2, DIFF_HEAD_DIM)
    k = zk.reshape(b_, s_, DIFF_HEADS, 2, DIFF_HEAD_DIM)
    vf = zv.reshape(b_, s_, DIFF_HEADS, 2 * DIFF_HEAD_DIM).astype(jnp.float32)
    q = _rope(_rms_norm(q, qn_g), cos, sin) * (DIFF_HEAD_DIM ** -0.5)
    k = _rope(_rms_norm(k, kn_g), cos, sin)
    f32 = jnp.float32
    lam = (jnp.exp(jnp.sum(lq1.astype(f32) * lk1.astype(f32)))
           - jnp.exp(jnp.sum(lq2.astype(f32) * lk2.astype(f32))) + lam_init)
    nb = s_ // Q_BLOCK
    qb = q.reshape(b_, nb, Q_BLOCK, DIFF_HEADS, 2, DIFF_HEAD_DIM).transpose(1, 0, 2, 3, 4, 5)

    def block(qblk):
        s = jnp.einsum('bqhcd,bkhcd->bhcqk', qblk, k).astype(f32)
        p = jax.nn.softmax(s, axis=-1)
        a = p[:, :, 0] - lam * p[:, :, 1]
        return jnp.einsum('bhqk,bkhe->bqhe', a, vf)

    o = lax.map(block, qb)
    o = o.transpose(1, 0, 2, 3, 4).reshape(b_, s_, DIFF_HEADS, 2 * DIFF_HEAD_DIM).astype(zq.dtype)
    o = _rms_norm(o, subln_g) * (1.0 - lam_init)
    return o.reshape(b_, s_, GROUP_WIDTH)


def setup_inputs(seed: int = 0) -> dict:
    key = jax.random.key(seed)
    ks = jax.random.split(key, 32)
    f32 = jnp.float32
    L, D, G = DEPTH, D_MODEL, GROUP_WIDTH

    def nrm(k, shape, scale):
        return jax.random.normal(k, shape, f32) * scale

    def gain(k, shape):
        return 1.0 + 0.01 * jax.random.normal(k, shape, f32)

    return {
        "x": nrm(ks[0], (BATCH, SEQ, D), 1.0),
        "attn_norm_g": gain(ks[1], (L, D)),
        "w_in": nrm(ks[2], (L, D, D_IN), D ** -0.5),
        "gmlp_ln_g": gain(ks[3], (L, G)),
        "gmlp_ln_b": nrm(ks[4], (L, G), 0.01),
        "gmlp_ws": nrm(ks[5], (L, GMLP_HEADS, CHUNK, CHUNK), CHUNK ** -0.5),
        "gmlp_bs": gain(ks[6], (L, GMLP_HEADS, CHUNK)),
        "conv_w": nrm(ks[7], (L, CONV_WIDTH, G), CONV_WIDTH ** -0.5),
        "conv_b": nrm(ks[8], (L, G), 0.01),
        "conv_ln_g": gain(ks[9], (L, G)),
        "conv_ln_b": nrm(ks[10], (L, G), 0.01),
        "pool_w": nrm(ks[11], (L, len(POOL_WINDOWS), POOL_CH, POOL_CH), POOL_CH ** -0.5),
        "pool_scale": 1.0 + 0.1 * jax.random.normal(ks[12], (L, G), f32),
        "q_norm_g": gain(ks[13], (L, DIFF_HEAD_DIM)),
        "k_norm_g": gain(ks[14], (L, DIFF_HEAD_DIM)),
        "lambda_q1": nrm(ks[15], (L, DIFF_HEAD_DIM), 0.1),
        "lambda_k1": nrm(ks[16], (L, DIFF_HEAD_DIM), 0.1),
        "lambda_q2": nrm(ks[17], (L, DIFF_HEAD_DIM), 0.1),
        "lambda_k2": nrm(ks[18], (L, DIFF_HEAD_DIM), 0.1),
        "subln_g": gain(ks[19], (L, 2 * DIFF_HEAD_DIM)),
        "w_out": nrm(ks[20], (L, MIX_WIDTH, D), MIX_WIDTH ** -0.5),
        "mlp_norm_g": gain(ks[21], (L, D)),
        "w_up": nrm(ks[22], (L, D, D_FF), D ** -0.5),
        "w_down": nrm(ks[23], (L, D_FF, D), D_FF ** -0.5),
    }


def reference(x, attn_norm_g, w_in, gmlp_ln_g, gmlp_ln_b, gmlp_ws, gmlp_bs, conv_w, conv_b,
              conv_ln_g, conv_ln_b, pool_w, pool_scale, q_norm_g, k_norm_g, lambda_q1,
              lambda_k1, lambda_q2, lambda_k2, subln_g, w_out, mlp_norm_g, w_up, w_down):
    s_ = x.shape[1]
    pos = jnp.arange(s_, dtype=jnp.float32)
    inv_freq = ROPE_THETA ** (-jnp.arange(0, ROT_DIM, 2, dtype=jnp.float32) / ROT_DIM)
    ang = pos[:, None] * inv_freq[None, :]
    cos, sin = jnp.cos(ang), jnp.sin(ang)
    for l in range(DEPTH):
        lam_init = 0.8 - 0.6 * math.exp(-0.3 * l)
        h = _rms_norm(x, attn_norm_g[l])
        z = h @ w_in[l]
        z_a, z_b, z_c, z_q, z_k, z_v = jnp.split(z, IN_SPLITS, axis=-1)
        y_a = _gmlp_mixer(z_a, gmlp_ln_g[l], gmlp_ln_b[l], gmlp_ws[l], gmlp_bs[l])
        y_b = _conv_mixer(z_b, conv_w[l], conv_b[l], conv_ln_g[l], conv_ln_b[l])
        y_c = _pool_mixer(z_c, pool_w[l], pool_scale[l])
        y_d = _diff_attention(z_q, z_k, z_v, q_norm_g[l], k_norm_g[l], lambda_q1[l],
                              lambda_k1[l], lambda_q2[l], lambda_k2[l], subln_g[l],
                              cos, sin, lam_init)
        y = jnp.concatenate([y_a, y_b, y_c, y_d], axis=-1) @ w_out[l]
        x = x + y
        h = _rms_norm(x, mlp_norm_g[l])
        x = x + jnp.square(jax.nn.relu(h @ w_up[l])) @ w_down[l]
    return x
```

```cpp
#include <hip/hip_runtime.h>
#include <cstdio>
#include <cstdint>
namespace pg8 {
#define PG8_LAS __attribute__((address_space(3)))
typedef unsigned short bf16_t;
typedef short bf16x8 __attribute__((ext_vector_type(8)));
typedef float f32x4 __attribute__((ext_vector_type(4)));
typedef unsigned u32x4 __attribute__((ext_vector_type(4)));
constexpr int BM = 256, BK = 64, HALF = 128, HTB = HALF * BK * 2  , STAGE_BYTES = 8 * HTB, NXCD = 8, WGM = 8;

__host__ __device__ __forceinline__ int lds_byte(int r, int c) { const int st = (r >> 4) * 2 + (c >> 5), rr = r & 15, cc = c & 31, ob = rr * 64 + cc * 2; return st * 1024 + (ob ^ (((ob >> 9) & 1) << 5)); }
__host__ __device__ __forceinline__ void stage_rc(int b, int& R, int& C) { const int st = b / 1024, sb = b % 1024, swz = sb ^ (((sb >> 9) & 1) << 5); R = (st >> 1) * 16 + swz / 64; C = (st & 1) * 32 + (swz % 64) / 2; }
__host__ __device__ __forceinline__ int perm32(int rho) { const int n = rho >> 4, i = rho & 15; return 8 * (i >> 2) + 4 * n + (i & 3); }

struct Unit { int pm, pn; };
struct Gemm { const bf16_t* A; const bf16_t* Bt; int M, N, K; };

struct StaticOrder {
    int nM, nN, nwg, G, c;
    __host__ __device__ void init(int M, int N, int G_, int c_) { nM = M / BM; nN = N / BM; nwg = nM * nN; G = G_; c = c_; }
    __host__ __device__ bool next(int i, Unit& u) const {
        const long L = (long)i * G + c; if (L >= nwg) return false;
        int wgid = (int)L; { const int q = nwg / NXCD, r = nwg % NXCD, xcd = wgid % NXCD, off = wgid / NXCD; wgid = (xcd < r ? xcd * (q + 1) : r * (q + 1) + (xcd - r) * q) + off; }
        const int nig = WGM * nN, gid = wgid / nig, fm = gid * WGM, gsz = (nM - fm) < WGM ? (nM - fm) : WGM;
        u.pm = fm + ((wgid % nig) % gsz); u.pn = (wgid % nig) / gsz; return true;
    }
    __device__ __forceinline__ void a_ready(const Unit&) const {}
    __device__ __forceinline__ void done(const Unit&) const {}
};

__device__ __forceinline__ unsigned cvt_pk_bf16(float lo, float hi) { unsigned r; asm volatile("v_cvt_pk_bf16_f32 %0, %1, %2" : "=v"(r) : "v"(lo), "v"(hi)); return r; }
typedef float f32x2 __attribute__((ext_vector_type(2)));
__device__ __forceinline__ f32x2 gelu_pk(f32x2 v) {
    const f32x2 av = __builtin_elementwise_abs(v), d = av * 0.2316418882f + 1.0f;
    f32x2 t; t.x = __builtin_amdgcn_rcpf(d.x); t.y = __builtin_amdgcn_rcpf(d.y);
    f32x2 q = t * 0.5307027145f + (-0.7265760135f); q = q * t + 0.7107068705f; q = q * t + (-0.142248368f); q = q * t + 0.127414796f; q = q * t;
    const f32x2 s = (v * v) * (-0.72134752044f);
    f32x2 e; e.x = __builtin_amdgcn_exp2f(s.x); e.y = __builtin_amdgcn_exp2f(s.y);
    const f32x2 m = v * (q * e), r = v - m;
    f32x2 o; o.x = v.x < 0.f ? m.x : r.x; o.y = v.y < 0.f ? m.y : r.y; return o;
}

template <int ACT  > struct EpiBf16 {
    static constexpr bool PERM = true, AFTER_DRAIN = false; static_assert(ACT == 0 || ACT == 1, "EpiBf16: ACT is 0 (none) or 1 (gelu_pk)");
    bf16_t* O; int ldc; const float* bias; int split_cols; size_t split_stride; float scale0;
    __device__ __forceinline__ void operator()(const f32x4 (&acc)[2][2][4][2], const Unit& u, int wr, int wc, int fr, int fq) const {
        const int row0 = u.pm * BM + wr * 64 + fr; int colt = u.pn * BM; bf16_t* base = O;
        float sc = 1.f; if (split_cols) { const int t = colt / split_cols; base += (size_t)t * split_stride; colt -= t * split_cols; if (t == 0) sc = scale0; }
        const int col0 = colt + wc * 32 + 8 * fq, bcol0 = u.pn * BM + wc * 32 + 8 * fq;
        f32x4 bv[2][2];
#pragma unroll
        for (int bj = 0; bj < 2; ++bj)
#pragma unroll
            for (int n = 0; n < 2; ++n) bv[bj][n] = bias ? *(const f32x4*)(bias + bcol0 + bj * HALF + 4 * n) : (f32x4){0.f, 0.f, 0.f, 0.f};
#pragma unroll
        for (int ai = 0; ai < 2; ++ai)
#pragma unroll
            for (int m = 0; m < 4; ++m) { bf16_t* rowp = base + (size_t)(row0 + ai * HALF + m * 16) * ldc + col0;
#pragma unroll
                for (int bj = 0; bj < 2; ++bj) { f32x4 v0 = acc[ai][bj][m][0] + bv[bj][0], v1 = acc[ai][bj][m][1] + bv[bj][1];
                    if (ACT == 1) { f32x2 a = gelu_pk((f32x2){v0[0], v0[1]}), b = gelu_pk((f32x2){v0[2], v0[3]}), c = gelu_pk((f32x2){v1[0], v1[1]}), d = gelu_pk((f32x2){v1[2], v1[3]});
                        v0 = (f32x4){a.x, a.y, b.x, b.y}; v1 = (f32x4){c.x, c.y, d.x, d.y}; }
                    v0 = v0 * sc; v1 = v1 * sc; u32x4 w; w.x = cvt_pk_bf16(v0[0], v0[1]); w.y = cvt_pk_bf16(v0[2], v0[3]); w.z = cvt_pk_bf16(v1[0], v1[1]); w.w = cvt_pk_bf16(v1[2], v1[3]);
                    *(u32x4*)(rowp + bj * HALF) = w; } }
    }
};

struct EpiZ {
    static constexpr bool PERM = true, AFTER_DRAIN = false;
    bf16_t* O; int ldc; int gelu_cols;
    __device__ __forceinline__ void operator()(const f32x4 (&acc)[2][2][4][2], const Unit& u, int wr, int wc, int fr, int fq) const {
        const int row0 = u.pm * BM + wr * 64 + fr; const int col0 = u.pn * BM + wc * 32 + 8 * fq; const bool act = (u.pn * BM) < gelu_cols;
#pragma unroll
        for (int ai = 0; ai < 2; ++ai)
#pragma unroll
            for (int m = 0; m < 4; ++m) { bf16_t* rowp = O + (size_t)(row0 + ai * HALF + m * 16) * ldc + col0;
#pragma unroll
                for (int bj = 0; bj < 2; ++bj) { f32x4 v0 = acc[ai][bj][m][0], v1 = acc[ai][bj][m][1];
                    if (act) { f32x2 a = gelu_pk((f32x2){v0[0], v0[1]}), b = gelu_pk((f32x2){v0[2], v0[3]}), c = gelu_pk((f32x2){v1[0], v1[1]}), d = gelu_pk((f32x2){v1[2], v1[3]});
                        v0 = (f32x4){a.x, a.y, b.x, b.y}; v1 = (f32x4){c.x, c.y, d.x, d.y}; }
                    u32x4 w; w.x = cvt_pk_bf16(v0[0], v0[1]); w.y = cvt_pk_bf16(v0[2], v0[3]); w.z = cvt_pk_bf16(v1[0], v1[1]); w.w = cvt_pk_bf16(v1[2], v1[3]);
                    *(u32x4*)(rowp + bj * HALF) = w; } }
    }
};
struct EpiRelu2 {
    static constexpr bool PERM = true, AFTER_DRAIN = false;
    bf16_t* O; int ldc;
    __device__ __forceinline__ void operator()(const f32x4 (&acc)[2][2][4][2], const Unit& u, int wr, int wc, int fr, int fq) const {
        const int row0 = u.pm * BM + wr * 64 + fr; const int col0 = u.pn * BM + wc * 32 + 8 * fq;
#pragma unroll
        for (int ai = 0; ai < 2; ++ai)
#pragma unroll
            for (int m = 0; m < 4; ++m) { bf16_t* rowp = O + (size_t)(row0 + ai * HALF + m * 16) * ldc + col0;
#pragma unroll
                for (int bj = 0; bj < 2; ++bj) { f32x4 v0 = acc[ai][bj][m][0], v1 = acc[ai][bj][m][1];
                    v0 = __builtin_elementwise_max(v0, (f32x4){0.f, 0.f, 0.f, 0.f}); v1 = __builtin_elementwise_max(v1, (f32x4){0.f, 0.f, 0.f, 0.f}); v0 = v0 * v0; v1 = v1 * v1;
                    u32x4 w; w.x = cvt_pk_bf16(v0[0], v0[1]); w.y = cvt_pk_bf16(v0[2], v0[3]); w.z = cvt_pk_bf16(v1[0], v1[1]); w.w = cvt_pk_bf16(v1[2], v1[3]);
                    *(u32x4*)(rowp + bj * HALF) = w; } }
    }
};
struct EpiRes {
    static constexpr bool PERM = false, AFTER_DRAIN = false;
    const float* base; float* out; int ldc;
    __device__ __forceinline__ void operator()(const f32x4 (&acc)[2][2][4][2], const Unit& u, int wr, int wc, int fr, int fq) const {
        const int row0 = u.pm * BM + wr * 64 + fr, col0 = u.pn * BM + wc * 32 + 4 * fq;
#pragma unroll
        for (int ai = 0; ai < 2; ++ai)
#pragma unroll
            for (int m = 0; m < 4; ++m) { const size_t off = (size_t)(row0 + ai * HALF + m * 16) * ldc + col0;
#pragma unroll
                for (int bj = 0; bj < 2; ++bj)
#pragma unroll
                    for (int n = 0; n < 2; ++n) { const f32x4 bs = *(const f32x4*)(base + off + bj * HALF + n * 16); *(f32x4*)(out + off + bj * HALF + n * 16) = bs + acc[ai][bj][m][n]; }
                if (m & 1) asm volatile("" ::: "memory"); }
    }
};
template <class Epi, class Sched, bool ALIGN_EPI = false, bool SP2 = false>
__device__ __forceinline__ void gemm_phase(PG8_LAS unsigned char* lds, const Gemm g, const Sched& S, const Epi& E) {
    int tid_ = threadIdx.x; asm volatile("" : "+v"(tid_));
    const int tid = tid_, wid = __builtin_amdgcn_readfirstlane(tid >> 6), lane = tid & 63, wr = wid >> 2, wc = wid & 3, fr = lane & 15, fq = lane >> 4;
    const int K = g.K, nt = K / BK;
    unsigned voffA[2], voffB[2];
#pragma unroll
    for (int i = 0; i < 2; ++i) { int R, C; stage_rc(tid * 16 + i * 8192, R, C); const int Rb = Epi::PERM ? ((R & ~31) + perm32(R & 31)) : R;
        voffA[i] = (unsigned)(R * K + C) * 2u; voffB[i] = (unsigned)(Rb * K + C) * 2u; }
    const size_t kstep = (size_t)(BK * 2);
    const size_t hstep = (size_t)HALF * K * 2;
    const size_t tstep = 2 * hstep;
    const unsigned ldsw = (unsigned)wid * 1024u;
    const int aoff = lds_byte(wr * 64 + fr, fq * 8), boff = lds_byte(wc * 32 + fr, fq * 8);
#define PG8_SA(b, h) (((b) * 2 + (h)) * HTB)
#define PG8_SB(b, h) ((4 + (b) * 2 + (h)) * HTB)
#define PG8_STAGE(bufoff, gbase, voff) do { _Pragma("unroll") for (int _i = 0; _i < 2; ++_i) \
        __builtin_amdgcn_global_load_lds((const unsigned*)((const char*)(gbase) + (voff)[_i]), (PG8_LAS unsigned*)(lds + (bufoff) + ldsw + _i * 8192), 16, 0, 0); } while (0)
#define PG8_LDA(dst, b, h) do { _Pragma("unroll") for (int m = 0; m < 4; ++m) _Pragma("unroll") for (int k = 0; k < 2; ++k) dst[m][k] = *(const PG8_LAS bf16x8*)(lds + PG8_SA(b, h) + aoff + m * 2048 + k * 1024); } while (0)
#define PG8_LDB(dst, b, h) do { _Pragma("unroll") for (int n = 0; n < 2; ++n) _Pragma("unroll") for (int k = 0; k < 2; ++k) dst[n][k] = *(const PG8_LAS bf16x8*)(lds + PG8_SB(b, h) + boff + n * 2048 + k * 1024); } while (0)
#define PG8_MMA(ai, bj, At, Bt) do { __builtin_amdgcn_s_setprio(1); _Pragma("unroll") for (int m = 0; m < 4; ++m) _Pragma("unroll") for (int n = 0; n < 2; ++n) _Pragma("unroll") for (int k = 0; k < 2; ++k) \
        acc[ai][bj][m][n] = __builtin_amdgcn_mfma_f32_16x16x32_bf16(Bt[n][k], At[m][k], acc[ai][bj][m][n], 0, 0, 0); __builtin_amdgcn_s_setprio(0); } while (0)
#define PG8_WAIT_V(n) asm volatile("s_waitcnt vmcnt(" #n ")" ::: "memory")
#define PG8_WAIT_L(n) asm volatile("s_waitcnt lgkmcnt(" #n ")" ::: "memory")
#define PG8_BAR __builtin_amdgcn_s_barrier()
#define PG8_SCHED __builtin_amdgcn_sched_barrier(0)
    Unit cur, nxt; int ui = 0;
    if (!S.next(0, cur)) return;
    f32x4 acc[2][2][4][2];
#pragma unroll
    for (int a = 0; a < 2; ++a)
#pragma unroll
        for (int b = 0; b < 2; ++b)
#pragma unroll
            for (int m = 0; m < 4; ++m)
#pragma unroll
                for (int n = 0; n < 2; ++n) acc[a][b][m][n] = (f32x4){0.f, 0.f, 0.f, 0.f};
    bf16x8 At[4][2], B0[2][2], B1[2][2];
    const char* cA = (const char*)g.A + (size_t)cur.pm * tstep; const char* cB = (const char*)g.Bt + (size_t)cur.pn * tstep;
    S.a_ready(cur);
    if constexpr (SP2) {
        PG8_STAGE(PG8_SB(0, 0), cB, voffB); PG8_STAGE(PG8_SB(0, 1), cB + hstep, voffB); PG8_STAGE(PG8_SA(0, 0), cA, voffA); PG8_STAGE(PG8_SA(0, 1), cA + hstep, voffA);
        if (wr == 1) PG8_BAR;
        PG8_WAIT_V(2); PG8_BAR;
        PG8_STAGE(PG8_SB(1, 0), cB + kstep, voffB); PG8_STAGE(PG8_SA(1, 0), cA + kstep, voffA); PG8_STAGE(PG8_SB(1, 1), cB + hstep + kstep, voffB);
        PG8_WAIT_V(6); PG8_BAR;
    } else {
        PG8_STAGE(PG8_SB(0, 0), cB, voffB); PG8_STAGE(PG8_SA(0, 0), cA, voffA); PG8_STAGE(PG8_SB(0, 1), cB + hstep, voffB); PG8_STAGE(PG8_SA(0, 1), cA + hstep, voffA);
        if (wr == 1) PG8_BAR;
        PG8_WAIT_V(4); PG8_BAR;
        PG8_STAGE(PG8_SB(1, 0), cB + kstep, voffB); PG8_STAGE(PG8_SA(1, 0), cA + kstep, voffA); PG8_STAGE(PG8_SB(1, 1), cB + hstep + kstep, voffB);
        PG8_WAIT_V(6); PG8_BAR;
    }
    for (;;) {
        const bool has_next = S.next(ui + 1, nxt);
        const char* nA = has_next ? (const char*)g.A + (size_t)nxt.pm * tstep : cA; const char* nB = has_next ? (const char*)g.Bt + (size_t)nxt.pn * tstep : cB;
        for (int t = 0; t < nt; t += 2) {
            const bool last = (t == nt - 2);
            const char* a1 = cA + (size_t)(t + 1) * kstep;
            const char* a2 = last ? nA : cA + (size_t)(t + 2) * kstep; const char* b2 = last ? nB : cB + (size_t)(t + 2) * kstep;
            const char* a3 = a2 + kstep; const char* b3 = b2 + kstep;
            if (last && has_next) S.a_ready(nxt);
            if constexpr (SP2) {
            PG8_LDB(B0, 0, 0); PG8_LDB(B1, 0, 1); PG8_SCHED; PG8_LDA(At, 0, 0); PG8_STAGE(PG8_SA(1, 1), a1 + hstep, voffA);
            PG8_WAIT_V(8); PG8_WAIT_L(0); PG8_BAR; PG8_MMA(0, 0, At, B0); PG8_MMA(0, 1, At, B1); PG8_BAR; PG8_SCHED;
            PG8_LDA(At, 0, 1); PG8_STAGE(PG8_SB(0, 0), b2, voffB); PG8_STAGE(PG8_SB(0, 1), b2 + hstep, voffB); PG8_STAGE(PG8_SA(0, 0), a2, voffA);
            PG8_WAIT_V(8); PG8_WAIT_L(0); PG8_BAR; PG8_MMA(1, 0, At, B0); PG8_MMA(1, 1, At, B1); PG8_BAR; PG8_SCHED;
            PG8_LDB(B0, 1, 0); PG8_LDB(B1, 1, 1); PG8_SCHED; PG8_LDA(At, 1, 0); PG8_STAGE(PG8_SA(0, 1), a2 + hstep, voffA);
            PG8_WAIT_V(8); PG8_WAIT_L(0); PG8_BAR; PG8_MMA(0, 0, At, B0); PG8_MMA(0, 1, At, B1); PG8_BAR; PG8_SCHED;
            PG8_LDA(At, 1, 1); PG8_STAGE(PG8_SB(1, 0), b3, voffB); PG8_STAGE(PG8_SB(1, 1), b3 + hstep, voffB); PG8_STAGE(PG8_SA(1, 0), a3, voffA);
            PG8_WAIT_V(8); PG8_WAIT_L(0); PG8_BAR; PG8_MMA(1, 0, At, B0); PG8_MMA(1, 1, At, B1); PG8_BAR; PG8_SCHED;
            } else {
            PG8_LDB(B0, 0, 0); PG8_SCHED; PG8_LDA(At, 0, 0); PG8_STAGE(PG8_SA(1, 1), a1 + hstep, voffA);
            PG8_WAIT_L(8); PG8_BAR; PG8_WAIT_L(0); PG8_MMA(0, 0, At, B0); PG8_BAR; PG8_SCHED;
            PG8_LDB(B1, 0, 1); PG8_STAGE(PG8_SB(0, 0), b2, voffB);
            PG8_BAR; PG8_WAIT_L(0); PG8_MMA(0, 1, At, B1); PG8_BAR;
            PG8_LDA(At, 0, 1); PG8_STAGE(PG8_SA(0, 0), a2, voffA);
            PG8_BAR; PG8_WAIT_L(0); PG8_MMA(1, 0, At, B0); PG8_BAR; PG8_SCHED;
            PG8_STAGE(PG8_SB(0, 1), b2 + hstep, voffB);
            PG8_WAIT_V(6); PG8_BAR; PG8_MMA(1, 1, At, B1); PG8_BAR;
            PG8_LDB(B0, 1, 0); PG8_SCHED; PG8_LDA(At, 1, 0); PG8_STAGE(PG8_SA(0, 1), a2 + hstep, voffA);
            PG8_WAIT_L(8); PG8_BAR; PG8_WAIT_L(0); PG8_MMA(0, 0, At, B0); PG8_BAR; PG8_SCHED;
            PG8_LDB(B1, 1, 1); PG8_STAGE(PG8_SB(1, 0), b3, voffB);
            PG8_BAR; PG8_WAIT_L(0); PG8_MMA(0, 1, At, B1); PG8_BAR;
            PG8_LDA(At, 1, 1); PG8_STAGE(PG8_SA(1, 0), a3, voffA);
            PG8_BAR; PG8_WAIT_L(0); PG8_MMA(1, 0, At, B0); PG8_BAR; PG8_SCHED;
            PG8_STAGE(PG8_SB(1, 1), b3 + hstep, voffB);
            PG8_WAIT_V(6); PG8_BAR; PG8_MMA(1, 1, At, B1); PG8_BAR;
            }
        }
        if constexpr (ALIGN_EPI) { if (wr == 0) PG8_BAR; }
        if constexpr (!Epi::AFTER_DRAIN) { E(acc, cur, wr, wc, fr, fq); S.done(cur); }
        if (!has_next) break;
#pragma unroll
        for (int a = 0; a < 2; ++a)
#pragma unroll
            for (int b = 0; b < 2; ++b)
#pragma unroll
                for (int m = 0; m < 4; ++m)
#pragma unroll
                    for (int n = 0; n < 2; ++n) acc[a][b][m][n] = (f32x4){0.f, 0.f, 0.f, 0.f};
        cur = nxt; cA = nA; cB = nB; ++ui;
        if constexpr (ALIGN_EPI) { if (wr == 1) PG8_BAR; }
    }
    PG8_WAIT_V(0);
    if constexpr (!ALIGN_EPI) { if (wr == 0) PG8_BAR; }
    PG8_BAR;
    if constexpr (Epi::AFTER_DRAIN) { E.fused(acc, cur, wr, wc, fr, fq, lds, wid, lane); S.done(cur); }
#undef PG8_SA
#undef PG8_SB
#undef PG8_STAGE
#undef PG8_LDA
#undef PG8_LDB
#undef PG8_MMA
#undef PG8_WAIT_V
#undef PG8_WAIT_L
#undef PG8_BAR
#undef PG8_SCHED
}
}

constexpr int NWAVES = 8;
constexpr int BATCH = 2, SEQ = 8192, DM = 4096, NLAYER = 2, GW = 1024, DIN = 8192, DFF = 16384;
constexpr int M = BATCH * SEQ;
constexpr int ZC_A = 0, ZC_B = 2048, ZC_C = 4096, ZC_Q = 5120, ZC_K = 6144, ZC_V = 7168;
constexpr int YC_A = 0, YC_B = 1024, YC_C = 2048, YC_D = 3072;
constexpr float QSCALE = 0.125f * 1.4426950408889634f;
#ifndef MK_SPLIT
#define MK_SPLIT 1
#endif

constexpr size_t MiB = 1u << 20;
constexpr size_t WS_CTL = 0, CTL_ZERO_BYTES = 64 * 1024;
constexpr size_t WS_ROPE = 1 * MiB;
constexpr size_t WS_PWT = 2 * MiB;
constexpr size_t WS_GWS = 3 * MiB;
constexpr size_t WS_WIN = 16 * MiB;
constexpr size_t WS_WOUT = 144 * MiB;
constexpr size_t WS_WUP = 208 * MiB;
constexpr size_t WS_WDN = 464 * MiB;
constexpr size_t WS_XN = 720 * MiB;
constexpr size_t WS_Z = 848 * MiB;
constexpr size_t WS_YC = 1104 * MiB;
constexpr size_t WS_HB = 1232 * MiB;
constexpr size_t WS_OS = 1744 * MiB;
constexpr size_t WS_END = 1808 * MiB;
constexpr int CW_BAR = 1024;

constexpr int RING_OFF = 0, RING_BYTES = 131072;
constexpr int LDSCTL_OFF = RING_BYTES, MISC_OFF = LDSCTL_OFF + 320;
constexpr int LDS_BYTES = 147456;

#define GAS __attribute__((address_space(1)))
#define LAS __attribute__((address_space(3)))
typedef unsigned short bf16;
typedef unsigned v4u __attribute__((ext_vector_type(4)));
typedef float f32x4 __attribute__((ext_vector_type(4)));
typedef short bf16x8 __attribute__((ext_vector_type(8)));
typedef GAS unsigned gu32;
typedef GAS unsigned long long gu64;
#define RLX_AGENT __ATOMIC_RELAXED, __HIP_MEMORY_SCOPE_AGENT
#define LDS_WAIT() asm volatile("s_waitcnt lgkmcnt(0)" ::: "memory")
#define VM_WAIT() asm volatile("s_waitcnt vmcnt(0)" ::: "memory")
__device__ __forceinline__ unsigned long long rt() { return __builtin_amdgcn_s_memrealtime(); }
__device__ __forceinline__ unsigned f2bf(float f) { unsigned u = __builtin_bit_cast(unsigned, f); return (u + 0x7fffu + ((u >> 16) & 1u)) >> 16; }
__device__ __forceinline__ unsigned pk2(float lo, float hi) { return f2bf(lo) | (f2bf(hi) << 16); }

#define XB_TMO      128
#define XB_XCNT(j)  (256  + 64 * (j))
#define XB_XSUB(j)  (1280 + 64 * (j))
#define XB_XGEN(j)  (2304 + 64 * (j))
#define XB_TOP      3328
#define XB_TOPGEN   3392
#define XCD_BAR_WORDS 3456
#define XB_SPIN_CAP (1u << 18)

__device__ __forceinline__ unsigned xb_ld(unsigned* p)              { return __hip_atomic_load(p, __ATOMIC_RELAXED, __HIP_MEMORY_SCOPE_AGENT); }
__device__ __forceinline__ unsigned xb_add(unsigned* p, unsigned v) { return __hip_atomic_fetch_add(p, v, __ATOMIC_RELAXED, __HIP_MEMORY_SCOPE_AGENT); }
__device__ __forceinline__ unsigned xb_xcc_id() { return (unsigned)__builtin_amdgcn_s_getreg((3 << 11) | 20) & 0xFu; }
#define XB_SPIN(cond, bar) do { unsigned _sp = 0; while (cond) { __builtin_amdgcn_s_sleep(1); \
    if ((++_sp & 255u) == 0u) { if (xb_ld(&(bar)[XB_TMO])) break; if (_sp > XB_SPIN_CAP) { atomicAdd(&(bar)[XB_TMO], 1u); break; } } } } while (0)

struct XcdBarrier {
    unsigned* bar; unsigned x;
    volatile LAS unsigned* st;
};

__device__ __forceinline__ XcdBarrier xcd_barrier_post(unsigned* bar, volatile LAS unsigned* st) {
    XcdBarrier b; b.bar = bar; b.x = xb_xcc_id(); b.st = st;
    if (threadIdx.x == 0) (void)xb_add(&bar[XB_XCNT(b.x)], 1u);
    return b;
}
__device__ __forceinline__ void xcd_barrier_complete(unsigned* bar, unsigned x, unsigned& nloc, unsigned& nx) {
    const unsigned G = gridDim.x * gridDim.y * gridDim.z;
    unsigned sum, cnt, mine, sp = 0u;
    for (;;) {
        sum = 0u; cnt = 0u; mine = 0u;
#pragma unroll
        for (unsigned j = 0; j < 16; ++j) { const unsigned c = xb_ld(&bar[XB_XCNT(j)]); sum += c; cnt += (c > 0u) ? 1u : 0u; mine = (j == x) ? c : mine; }
        if (sum == G) break;
        __builtin_amdgcn_s_sleep(1);
        if ((++sp & 255u) == 0u) { if (xb_ld(&bar[XB_TMO])) break; if (sp > XB_SPIN_CAP) { atomicAdd(&bar[XB_TMO], 1u); break; } }
    }
    nloc = mine > 0u ? mine : 1u; nx = cnt > 0u ? cnt : 1u;
}

__device__ __forceinline__ void xcd_barrier(const XcdBarrier& b) {
    asm volatile("s_waitcnt vmcnt(0)" ::: "memory");
    __syncthreads();
    if (threadIdx.x == 0) {
        unsigned* bar = b.bar;
        __builtin_amdgcn_s_waitcnt(0);
        unsigned nloc = b.st[0], nx = b.st[1];
        if (nloc == 0u) { xcd_barrier_complete(bar, b.x, nloc, nx); b.st[0] = nloc; b.st[1] = nx; }
        const unsigned old = xb_add(&bar[XB_XSUB(b.x)], 1u);
        const unsigned gen = old / nloc;
        if (old + 1u == (gen + 1u) * nloc) {
            __builtin_amdgcn_fence(__ATOMIC_RELEASE, "agent");
            asm volatile("s_waitcnt vmcnt(0)" ::: "memory");
            const unsigned og = xb_add(&bar[XB_TOP], 1u);
            const unsigned tg = og / nx;
            if (og + 1u == (tg + 1u) * nx) xb_add(&bar[XB_TOPGEN], 1u);
            else XB_SPIN(xb_ld(&bar[XB_TOPGEN]) == tg, bar);
            __builtin_amdgcn_fence(__ATOMIC_ACQUIRE, "agent");
            xb_add(&bar[XB_XGEN(b.x)], 1u);
            asm volatile("s_waitcnt vmcnt(0)" ::: "memory");
        } else {
            XB_SPIN(xb_ld(&bar[XB_XGEN(b.x)]) == gen, bar);
            __builtin_amdgcn_fence(__ATOMIC_ACQUIRE, "agent");
            asm volatile("s_waitcnt vmcnt(0)" ::: "memory");
        }
    }
    __syncthreads();
}

typedef unsigned u32x2 __attribute__((ext_vector_type(2)));
typedef float f32x2v __attribute__((ext_vector_type(2)));
struct Frame {
    LAS unsigned char* lds;
    volatile LAS unsigned* MISC;
    gu32* ctl;
    int tid, lane, wave;
    int vcu, G;
};
struct Args { const float* in[24]; float* out; unsigned char* ws; int ph_lo, ph_hi; };

__device__ __forceinline__ float wave_sum(float v) {
#pragma unroll
    for (int o = 1; o < 64; o <<= 1) v += __shfl_xor(v, o);
    return v;
}
__device__ __forceinline__ float bf_lo(unsigned w) { return __builtin_bit_cast(float, w << 16); }
__device__ __forceinline__ float bf_hi(unsigned w) { return __builtin_bit_cast(float, w & 0xffff0000u); }
__device__ __forceinline__ float sigmoidf_fast(float x) { return __builtin_amdgcn_rcpf(1.0f + __builtin_amdgcn_exp2f(-1.4426950408889634f * x)); }

__device__ __forceinline__ void p0_transpose_item(const float* W, int K, int N, bf16* WT, LAS float* scr, int item, int lane) {
    const int nblk = N / 32, kb = item / nblk, nb = item % nblk, k0 = 64 * kb, n0 = 32 * nb;
    const GAS float* Wg = (const GAS float*)W;
#pragma unroll 8
    for (int i = 0; i < 32; ++i) { const int kk = 2 * i + (lane >> 5); scr[kk * 33 + (lane & 31)] = Wg[(size_t)(k0 + kk) * N + n0 + (lane & 31)]; }
    LDS_WAIT(); asm volatile("" ::: "memory");
    const int c = lane & 7;
#pragma unroll
    for (int j = 0; j < 4; ++j) { const int n = (lane >> 3) + 8 * j; const LAS float* s = scr + (8 * c) * 33 + n;
        v4u o; o.x = pk2(s[0 * 33], s[1 * 33]); o.y = pk2(s[2 * 33], s[3 * 33]); o.z = pk2(s[4 * 33], s[5 * 33]); o.w = pk2(s[6 * 33], s[7 * 33]);
        *(GAS v4u*)(WT + (size_t)(n0 + n) * K + k0 + 8 * c) = o; }
    LDS_WAIT(); asm volatile("" ::: "memory");
}
__device__ __forceinline__ void p0_prologue(const Frame& F, const Args& a) {
    LAS float* scr = (LAS float*)(F.lds + RING_OFF + F.wave * 16384);
    unsigned char* ws = a.ws;
    const int gw = F.vcu * NWAVES + F.wave, NGW = F.G * NWAVES;
    constexpr int I_IN = (DM / 64) * (DIN / 32), I_OUT = (DM / 64) * (DM / 32), I_UP = (DM / 64) * (DFF / 32), I_DN = (DFF / 64) * (DM / 32), I_PW1 = (256 / 64) * (256 / 32), I_PW = 4 * I_PW1;
    constexpr int I_L = I_IN + I_OUT + I_UP + I_DN + I_PW;
    for (int it = gw; it < NLAYER * I_L; it += NGW) {
        const int l = it / I_L; int r = it % I_L;
        if (r < I_IN) { p0_transpose_item(a.in[2] + (size_t)l * DM * DIN, DM, DIN, (bf16*)(ws + WS_WIN) + (size_t)l * DIN * DM, scr, r, F.lane); continue; } r -= I_IN;
        if (r < I_OUT) { p0_transpose_item(a.in[20] + (size_t)l * DM * DM, DM, DM, (bf16*)(ws + WS_WOUT) + (size_t)l * DM * DM, scr, r, F.lane); continue; } r -= I_OUT;
        if (r < I_UP) { p0_transpose_item(a.in[22] + (size_t)l * DM * DFF, DM, DFF, (bf16*)(ws + WS_WUP) + (size_t)l * DFF * DM, scr, r, F.lane); continue; } r -= I_UP;
        if (r < I_DN) { p0_transpose_item(a.in[23] + (size_t)l * DFF * DM, DFF, DM, (bf16*)(ws + WS_WDN) + (size_t)l * DM * DFF, scr, r, F.lane); continue; } r -= I_DN;
        { const int g = r / I_PW1, ri = r % I_PW1; p0_transpose_item(a.in[11] + (size_t)(l * 4 + g) * 65536, 256, 256, (bf16*)(ws + WS_PWT) + (size_t)(l * 4 + g) * 65536, scr, ri, F.lane); }
    }
    const int gt = F.vcu * (NWAVES * 64) + F.tid, NGT = F.G * NWAVES * 64;
    { const GAS float* src = (const GAS float*)a.in[5]; GAS unsigned* dst = (GAS unsigned*)(ws + WS_GWS);
      for (int i = gt; i < NLAYER * 8 * 128 * 128 / 2; i += NGT) dst[i] = pk2(src[2 * i], src[2 * i + 1]); }
    { GAS float* rope = (GAS float*)(ws + WS_ROPE);
      for (int e = gt; e < SEQ * 8; e += NGT) {
          const int pos = e >> 3, i = e & 7;
          const float invf = (i == 0) ? 1.0f : (i == 1) ? 0x1.8d275ep-3f : (i == 2) ? 0x1.341190p-5f : (i == 3) ? 0x1.ddee9cp-8f : (i == 4) ? 0x1.72ba44p-10f : (i == 5) ? 0x1.1f91f0p-12f : (i == 6) ? 0x1.be218ap-15f : 0x1.5a0f50p-17f;
          const float angf = (float)pos * invf;
          const double ad = (double)angf;
          const double kq = __builtin_rint(ad * 0.63661977236758134308);
          const double y = __builtin_fma(-kq, 1.57079632679489661923, ad);
          const double y2 = y * y;
          const double sn = y * (1.0 + y2 * (-1.0 / 6 + y2 * (1.0 / 120 + y2 * (-1.0 / 5040 + y2 * (1.0 / 362880 + y2 * (-1.0 / 39916800))))));
          const double cs = 1.0 + y2 * (-0.5 + y2 * (1.0 / 24 + y2 * (-1.0 / 720 + y2 * (1.0 / 40320 + y2 * (-1.0 / 3628800 + y2 * (1.0 / 479001600))))));
          const int q = ((int)kq) & 3;
          const double c = (q == 0) ? cs : (q == 1) ? -sn : (q == 2) ? -cs : sn;
          const double s = (q == 0) ? sn : (q == 1) ? cs : (q == 2) ? -sn : -cs;
          rope[2 * e] = (float)c; rope[2 * e + 1] = (float)s;
      } }
}

__device__ __forceinline__ void rms_phase(const Frame& F, const float* x, const float* g, bf16* XN) {
    const int gw = F.vcu * NWAVES + F.wave, NGW = F.G * NWAVES;
    const GAS f32x4* gr = (const GAS f32x4*)g + F.lane;
    for (int m = gw; m < M; m += NGW) {
        const GAS f32x4* xr = (const GAS f32x4*)(x + (size_t)m * DM) + F.lane;
        f32x4 v[16]; float s = 0.f;
#pragma unroll
        for (int j = 0; j < 16; ++j) { v[j] = xr[64 * j]; s += (v[j].x * v[j].x + v[j].y * v[j].y) + (v[j].z * v[j].z + v[j].w * v[j].w); }
        const float rstd = 1.0f / sqrtf(wave_sum(s) * (1.f / DM) + 1e-6f);
        GAS u32x2* o8 = (GAS u32x2*)(XN + (size_t)m * DM) + F.lane;
#pragma unroll
        for (int j = 0; j < 16; ++j) { const f32x4 gv = gr[64 * j]; u32x2 w; w.x = pk2(v[j].x * rstd * gv.x, v[j].y * rstd * gv.y); w.y = pk2(v[j].z * rstd * gv.z, v[j].w * rstd * gv.w); o8[64 * j] = w; }
    }
}

__device__ __forceinline__ void qkprep_unit(const Frame& F, bf16* Z, const float* qg, const float* kg, const float* rope, int unit) {
    const int lane = F.lane, sub = lane & 3;
    float gq[16], gk[16];
#pragma unroll
    for (int i = 0; i < 16; ++i) { gq[i] = qg[sub * 16 + i] * QSCALE; gk[i] = kg[sub * 16 + i]; }
    for (int rr = 0; rr < 8; ++rr) {
        const int row = unit * 64 + F.wave * 8 + rr, pos = row & (SEQ - 1);
        GAS v4u* pq = (GAS v4u*)(Z + (size_t)row * DIN + ZC_Q + lane * 16);
        GAS v4u* pk = (GAS v4u*)(Z + (size_t)row * DIN + ZC_K + lane * 16);
        const v4u q0 = pq[0], q1 = pq[1], k0 = pk[0], k1 = pk[1];
        float vq[16], vk[16];
        vq[0] = bf_lo(q0.x); vq[1] = bf_hi(q0.x); vq[2] = bf_lo(q0.y); vq[3] = bf_hi(q0.y); vq[4] = bf_lo(q0.z); vq[5] = bf_hi(q0.z); vq[6] = bf_lo(q0.w); vq[7] = bf_hi(q0.w);
        vq[8] = bf_lo(q1.x); vq[9] = bf_hi(q1.x); vq[10] = bf_lo(q1.y); vq[11] = bf_hi(q1.y); vq[12] = bf_lo(q1.z); vq[13] = bf_hi(q1.z); vq[14] = bf_lo(q1.w); vq[15] = bf_hi(q1.w);
        vk[0] = bf_lo(k0.x); vk[1] = bf_hi(k0.x); vk[2] = bf_lo(k0.y); vk[3] = bf_hi(k0.y); vk[4] = bf_lo(k0.z); vk[5] = bf_hi(k0.z); vk[6] = bf_lo(k0.w); vk[7] = bf_hi(k0.w);
        vk[8] = bf_lo(k1.x); vk[9] = bf_hi(k1.x); vk[10] = bf_lo(k1.y); vk[11] = bf_hi(k1.y); vk[12] = bf_lo(k1.z); vk[13] = bf_hi(k1.z); vk[14] = bf_lo(k1.w); vk[15] = bf_hi(k1.w);
        float sq = 0.f, sk = 0.f;
#pragma unroll
        for (int i = 0; i < 16; ++i) { sq += vq[i] * vq[i]; sk += vk[i] * vk[i]; }
        sq += __shfl_xor(sq, 1); sq += __shfl_xor(sq, 2); sk += __shfl_xor(sk, 1); sk += __shfl_xor(sk, 2);
        const float rq = 1.0f / sqrtf(sq * (1.f / 64.f) + 1e-6f), rk = 1.0f / sqrtf(sk * (1.f / 64.f) + 1e-6f);
#pragma unroll
        for (int i = 0; i < 16; ++i) { vq[i] *= rq * gq[i]; vk[i] *= rk * gk[i]; }
        if (sub == 0) {
            const GAS f32x4* rp = (const GAS f32x4*)(rope + (size_t)pos * 16);
#pragma unroll
            for (int i2 = 0; i2 < 4; ++i2) { const f32x4 cs = rp[i2];
                { const int i = 2 * i2; const float c = cs.x, s = cs.y; float x1 = vq[i], x2 = vq[i + 8]; vq[i] = x1 * c - x2 * s; vq[i + 8] = x2 * c + x1 * s; x1 = vk[i]; x2 = vk[i + 8]; vk[i] = x1 * c - x2 * s; vk[i + 8] = x2 * c + x1 * s; }
                { const int i = 2 * i2 + 1; const float c = cs.z, s = cs.w; float x1 = vq[i], x2 = vq[i + 8]; vq[i] = x1 * c - x2 * s; vq[i + 8] = x2 * c + x1 * s; x1 = vk[i]; x2 = vk[i + 8]; vk[i] = x1 * c - x2 * s; vk[i + 8] = x2 * c + x1 * s; } }
        }
        v4u o0, o1;
        o0.x = pk2(vq[0], vq[1]); o0.y = pk2(vq[2], vq[3]); o0.z = pk2(vq[4], vq[5]); o0.w = pk2(vq[6], vq[7]); o1.x = pk2(vq[8], vq[9]); o1.y = pk2(vq[10], vq[11]); o1.z = pk2(vq[12], vq[13]); o1.w = pk2(vq[14], vq[15]);
        pq[0] = o0; pq[1] = o1;
        o0.x = pk2(vk[0], vk[1]); o0.y = pk2(vk[2], vk[3]); o0.z = pk2(vk[4], vk[5]); o0.w = pk2(vk[6], vk[7]); o1.x = pk2(vk[8], vk[9]); o1.y = pk2(vk[10], vk[11]); o1.z = pk2(vk[12], vk[13]); o1.w = pk2(vk[14], vk[15]);
        pk[0] = o0; pk[1] = o1;
    }
}

__device__ __forceinline__ void gmlp_unit(const Frame& F, const bf16* Z, bf16* YC, const bf16* Wsb, const float* bs, const float* lng, const float* lnb, int unit) {
    const int chunk = unit >> 1, hh = unit & 1, r0 = chunk * 128, tid = F.tid, lane = F.lane;
    const int wr = F.wave >> 2, wc = F.wave & 3, fr = lane & 15, fq = lane >> 4;
    LAS float* st = (LAS float*)(F.lds + RING_OFF);
    LAS bf16* vT = (LAS bf16*)(F.lds + RING_OFF + 1024);
    for (int rr = 0; rr < 16; ++rr) {
        const int row = F.wave * 16 + rr;
        const GAS v4u* p = (const GAS v4u*)(Z + (size_t)(r0 + row) * DIN + ZC_A + 1024 + lane * 16);
        const v4u a = p[0], b = p[1]; float v[16];
        v[0] = bf_lo(a.x); v[1] = bf_hi(a.x); v[2] = bf_lo(a.y); v[3] = bf_hi(a.y); v[4] = bf_lo(a.z); v[5] = bf_hi(a.z); v[6] = bf_lo(a.w); v[7] = bf_hi(a.w);
        v[8] = bf_lo(b.x); v[9] = bf_hi(b.x); v[10] = bf_lo(b.y); v[11] = bf_hi(b.y); v[12] = bf_lo(b.z); v[13] = bf_hi(b.z); v[14] = bf_lo(b.w); v[15] = bf_hi(b.w);
        float s = 0.f;
#pragma unroll
        for (int i = 0; i < 16; ++i) s += v[i];
        const float mean = wave_sum(s) * (1.f / 1024.f); float q = 0.f;
#pragma unroll
        for (int i = 0; i < 16; ++i) { const float d = v[i] - mean; q += d * d; }
        const float rstd = 1.0f / sqrtf(wave_sum(q) * (1.f / 1024.f) + 1e-5f);
        if (lane == 0) { st[row * 2] = mean; st[row * 2 + 1] = rstd; }
    }
    __syncthreads();
    for (int hq = 0; hq < 4; ++hq) {
        const int h = hh * 4 + hq;
        { const int j = tid >> 2, cq = tid & 3; const float mean = st[j * 2], rstd = st[j * 2 + 1];
          const GAS v4u* p = (const GAS v4u*)(Z + (size_t)(r0 + j) * DIN + ZC_A + 1024 + h * 128 + cq * 32);
          const GAS float* gp = (const GAS float*)lng + h * 128 + cq * 32; const GAS float* bp = (const GAS float*)lnb + h * 128 + cq * 32;
#pragma unroll
          for (int k4 = 0; k4 < 4; ++k4) { const v4u a = p[k4]; float v[8];
              v[0] = bf_lo(a.x); v[1] = bf_hi(a.x); v[2] = bf_lo(a.y); v[3] = bf_hi(a.y); v[4] = bf_lo(a.z); v[5] = bf_hi(a.z); v[6] = bf_lo(a.w); v[7] = bf_hi(a.w);
#pragma unroll
              for (int i = 0; i < 8; ++i) { const int c = cq * 32 + k4 * 8 + i; const float y = (v[i] - mean) * rstd * gp[k4 * 8 + i] + bp[k4 * 8 + i]; vT[c * 136 + j] = (bf16)f2bf(y); } } }
        __syncthreads();
        f32x4 acc[4][2];
#pragma unroll
        for (int m = 0; m < 4; ++m)
#pragma unroll
            for (int n = 0; n < 2; ++n) acc[m][n] = (f32x4){0.f, 0.f, 0.f, 0.f};
#pragma unroll
        for (int kk = 0; kk < 4; ++kk) {
            bf16x8 Bf[2], Af[4];
#pragma unroll
            for (int n = 0; n < 2; ++n) Bf[n] = *(const LAS bf16x8*)(vT + (32 * wc + 16 * n + fr) * 136 + 32 * kk + 8 * fq);
#pragma unroll
            for (int m = 0; m < 4; ++m) Af[m] = *(const GAS bf16x8*)(Wsb + (size_t)(h * 128 + 64 * wr + 16 * m + fr) * 128 + 32 * kk + 8 * fq);
#pragma unroll
            for (int m = 0; m < 4; ++m)
#pragma unroll
                for (int n = 0; n < 2; ++n) acc[m][n] = __builtin_amdgcn_mfma_f32_16x16x32_bf16(Bf[n], Af[m], acc[m][n], 0, 0, 0);
        }
#pragma unroll
        for (int m = 0; m < 4; ++m) { const int i = 64 * wr + 16 * m + fr; const float b = bs[h * 128 + i];
#pragma unroll
            for (int n = 0; n < 2; ++n) { const int c = 32 * wc + 16 * n + 4 * fq;
                const u32x2 uu = *(const GAS u32x2*)(Z + (size_t)(r0 + i) * DIN + ZC_A + h * 128 + c);
                u32x2 w; w.x = pk2((acc[m][n][0] + b) * bf_lo(uu.x), (acc[m][n][1] + b) * bf_hi(uu.x)); w.y = pk2((acc[m][n][2] + b) * bf_lo(uu.y), (acc[m][n][3] + b) * bf_hi(uu.y));
                *(GAS u32x2*)(YC + (size_t)(r0 + i) * DM + YC_A + h * 128 + c) = w; } }
        __syncthreads();
    }
}

__device__ __forceinline__ void conv_unit(const Frame& F, const bf16* Z, bf16* YC, const float* cw, const float* cb, const float* lng, const float* lnb, int unit) {
    const int t0 = unit * 32, bstart = (t0 / SEQ) * SEQ, bend = bstart + SEQ, tid = F.tid, lane = F.lane, c0 = 2 * tid;
    LAS float* CV = (LAS float*)(F.lds + RING_OFF);
    f32x2v w[31], acc[31];
#pragma unroll
    for (int k = 0; k < 31; ++k) { w[k] = *(const GAS f32x2v*)(cw + k * GW + c0); acc[k] = (f32x2v){0.f, 0.f}; }
    const f32x2v bias = *(const GAS f32x2v*)(cb + c0);
#pragma unroll 1
    for (int r = 0; r < 62; ++r) {
        const int row = t0 - 15 + r; f32x2v h = (f32x2v){0.f, 0.f};
        if (row >= bstart && row < bend) {
            const unsigned a2 = *(const GAS unsigned*)(Z + (size_t)row * DIN + ZC_B + c0), g2 = *(const GAS unsigned*)(Z + (size_t)row * DIN + ZC_B + 1024 + c0);
            h.x = bf_lo(a2) * sigmoidf_fast(bf_lo(g2)); h.y = bf_hi(a2) * sigmoidf_fast(bf_hi(g2));
        }
#pragma unroll
        for (int k = 0; k < 31; ++k) acc[k] = acc[k] + h * w[k];
        if (r >= 30) *(LAS f32x2v*)(CV + (r - 30) * GW + c0) = acc[30] + bias;
#pragma unroll
        for (int k = 30; k > 0; --k) acc[k] = acc[k - 1];
        acc[0] = (f32x2v){0.f, 0.f};
    }
    __syncthreads();
    for (int oo = 0; oo < 4; ++oo) {
        const int o = F.wave * 4 + oo; f32x4 x[4]; float s = 0.f;
#pragma unroll
        for (int j = 0; j < 4; ++j) { x[j] = *(const LAS f32x4*)(CV + o * GW + lane * 4 + 256 * j); s += (x[j].x + x[j].y) + (x[j].z + x[j].w); }
        const float mean = wave_sum(s) * (1.f / GW); float q = 0.f;
#pragma unroll
        for (int j = 0; j < 4; ++j) { x[j] = x[j] - mean; q += (x[j].x * x[j].x + x[j].y * x[j].y) + (x[j].z * x[j].z + x[j].w * x[j].w); }
        const float rstd = 1.0f / sqrtf(wave_sum(q) * (1.f / GW) + 1e-5f);
#pragma unroll
        for (int j = 0; j < 4; ++j) { const int c = lane * 4 + 256 * j; const f32x4 gv = *(const GAS f32x4*)(lng + c), bv = *(const GAS f32x4*)(lnb + c);
            f32x4 y = x[j] * rstd * gv + bv; y.x *= sigmoidf_fast(y.x); y.y *= sigmoidf_fast(y.y); y.z *= sigmoidf_fast(y.z); y.w *= sigmoidf_fast(y.w);
            u32x2 wv; wv.x = pk2(y.x, y.y); wv.y = pk2(y.z, y.w);
            *(GAS u32x2*)(YC + (size_t)(t0 + o) * DM + YC_B + c) = wv; }
    }
    __syncthreads();
}

__device__ __forceinline__ void pool_unit(const Frame& F, const bf16* Z, bf16* YC, const bf16* PWT, const float* scale, int unit) {
    const int g = unit & 3, tile = unit >> 2, t0 = tile * 64, bstart = (t0 / SEQ) * SEQ, tid = F.tid, lane = F.lane, fr = lane & 15, fq = lane >> 4, w = F.wave;
    const int wh = 1 << g;
    LAS bf16* P = (LAS bf16*)(F.lds + RING_OFF);
    { const int cc = tid & 31, rg = tid >> 5;
      const GAS bf16* zc = (const GAS bf16*)Z + ZC_C + g * 256 + cc * 8;
#pragma unroll 1
      for (int o = 0; o < 4; ++o) { const int t = t0 + 4 * rg + o, pos = t - bstart; const int lo = pos - wh > 0 ? pos - wh : 0, hi = pos + wh < SEQ ? pos + wh : SEQ;
          float s[8];
#pragma unroll
          for (int i = 0; i < 8; ++i) s[i] = 0.f;
          for (int r = lo; r < hi; ++r) { const v4u a = *(const GAS v4u*)(zc + (size_t)(bstart + r) * DIN);
              s[0] += bf_lo(a.x); s[1] += bf_hi(a.x); s[2] += bf_lo(a.y); s[3] += bf_hi(a.y); s[4] += bf_lo(a.z); s[5] += bf_hi(a.z); s[6] += bf_lo(a.w); s[7] += bf_hi(a.w); }
          const v4u a = *(const GAS v4u*)(zc + (size_t)t * DIN); const float inv = 1.0f / (float)(hi - lo);
          v4u ov; ov.x = pk2(s[0] * inv - bf_lo(a.x), s[1] * inv - bf_hi(a.x)); ov.y = pk2(s[2] * inv - bf_lo(a.y), s[3] * inv - bf_hi(a.y));
          ov.z = pk2(s[4] * inv - bf_lo(a.z), s[5] * inv - bf_hi(a.z)); ov.w = pk2(s[6] * inv - bf_lo(a.w), s[7] * inv - bf_hi(a.w));
          *(LAS v4u*)(P + (4 * rg + o) * 264 + cc * 8) = ov; } }
    __syncthreads();
    f32x4 acc[4][2];
#pragma unroll
    for (int m = 0; m < 4; ++m)
#pragma unroll
        for (int n = 0; n < 2; ++n) acc[m][n] = (f32x4){0.f, 0.f, 0.f, 0.f};
    const GAS bf16* pw = (const GAS bf16*)PWT + (size_t)g * 65536;
#pragma unroll
    for (int kk = 0; kk < 8; ++kk) {
        bf16x8 Bf[2], Af[4];
#pragma unroll
        for (int n = 0; n < 2; ++n) Bf[n] = *(const GAS bf16x8*)(pw + (size_t)(32 * w + 16 * n + fr) * 256 + 32 * kk + 8 * fq);
#pragma unroll
        for (int m = 0; m < 4; ++m) Af[m] = *(const LAS bf16x8*)(P + (16 * m + fr) * 264 + 32 * kk + 8 * fq);
#pragma unroll
        for (int m = 0; m < 4; ++m)
#pragma unroll
            for (int n = 0; n < 2; ++n) acc[m][n] = __builtin_amdgcn_mfma_f32_16x16x32_bf16(Bf[n], Af[m], acc[m][n], 0, 0, 0);
    }
#pragma unroll
    for (int n = 0; n < 2; ++n) { const int d = 32 * w + 16 * n + 4 * fq; const f32x4 sc = *(const GAS f32x4*)(scale + g * 256 + d);
#pragma unroll
        for (int m = 0; m < 4; ++m) { const f32x4 v = acc[m][n] * sc; u32x2 wv; wv.x = pk2(v[0], v[1]); wv.y = pk2(v[2], v[3]);
            *(GAS u32x2*)(YC + (size_t)(t0 + 16 * m + fr) * DM + YC_C + g * 256 + d) = wv; } }
    __syncthreads();
}

namespace att {
typedef __attribute__((ext_vector_type(8))) short bf16x8;
typedef __attribute__((ext_vector_type(4))) short s16x4;
typedef __attribute__((ext_vector_type(16))) float f32x16;
typedef __attribute__((ext_vector_type(4))) unsigned u32x4;
constexpr int QBLK = 32, KVBLK = 64, NW = 8, LD = DIN;
constexpr int SHM_V = KVBLK * 128 * 2, SHM_K = KVBLK * 64 * 2;
constexpr int OFF_V = 0, OFF_K = 2 * SHM_V, OFF_WS = OFF_K + 2 * SHM_K, ATT_LDS = OFF_WS + NW * 64 * 4;
constexpr float THR = 8.0f;
#define KSWZ(row, colB) ((row) * 128 + ((colB) ^ ((((row) >> 1) & 7) << 4)))
#define SBAR() __builtin_amdgcn_sched_barrier(0)
__device__ __forceinline__ int crow(int r, int hi) { return (r & 3) + 8 * (r >> 2) + 4 * hi; }
__device__ __forceinline__ unsigned cvtpk(float lo, float hi) { unsigned r; asm volatile("v_cvt_pk_bf16_f32 %0, %1, %2" : "=v"(r) : "v"(lo), "v"(hi)); return r; }

__device__ __forceinline__ void partialSM(f32x16& p0, f32x16& p1, float& m_reg, float& alpha) {
    float pmax = p0[0];
#pragma unroll
    for (int r = 1; r < 16; ++r) pmax = fmaxf(pmax, p0[r]);
#pragma unroll
    for (int r = 0; r < 16; ++r) pmax = fmaxf(pmax, p1[r]);
    { auto rr = __builtin_amdgcn_permlane32_swap(__float_as_uint(pmax), __float_as_uint(pmax), false, false);
      pmax = fmaxf(__uint_as_float(rr[0]), __uint_as_float(rr[1])); }
    if (__builtin_expect(__all(pmax - m_reg <= THR), 1)) { alpha = 1.f; }
    else { const float mn = fmaxf(m_reg, pmax); alpha = __builtin_amdgcn_exp2f(m_reg - mn); m_reg = mn; }
    const float mm = m_reg;
#pragma unroll
    for (int r = 0; r < 16; ++r) { p0[r] -= mm; p1[r] -= mm; }
#pragma unroll
    for (int r = 0; r < 16; ++r) p0[r] = __builtin_amdgcn_exp2f(p0[r]);
}
__device__ __forceinline__ void finishSM(f32x16& p0, f32x16& p1, float alpha, float& l_reg, bf16x8& pa0, bf16x8& pa1, bf16x8& pa2, bf16x8& pa3) {
#pragma unroll
    for (int r = 0; r < 16; ++r) p1[r] = __builtin_amdgcn_exp2f(p1[r]);
    float ps = 0.f;
#pragma unroll
    for (int r = 0; r < 16; ++r) ps += p0[r];
#pragma unroll
    for (int r = 0; r < 16; ++r) ps += p1[r];
    { auto rr = __builtin_amdgcn_permlane32_swap(__float_as_uint(ps), __float_as_uint(ps), false, false);
      ps = __uint_as_float(rr[0]) + __uint_as_float(rr[1]); }
    l_reg = l_reg * alpha + ps;
#define PK4(P, BASE, OUT) do { unsigned a0 = cvtpk(P[BASE + 0], P[BASE + 1]), a1 = cvtpk(P[BASE + 2], P[BASE + 3]);   \
    unsigned b0 = cvtpk(P[BASE + 4], P[BASE + 5]), b1 = cvtpk(P[BASE + 6], P[BASE + 7]);                              \
    auto r0 = __builtin_amdgcn_permlane32_swap(a0, b0, false, false); auto r1 = __builtin_amdgcn_permlane32_swap(a1, b1, false, false); \
    u32x4 w = {r0[0], r1[0], r0[1], r1[1]}; OUT = *reinterpret_cast<bf16x8*>(&w); } while (0)
    PK4(p0, 0, pa0); PK4(p0, 8, pa1); PK4(p1, 0, pa2); PK4(p1, 8, pa3);
#undef PK4
}
__device__ __forceinline__ void qkt(f32x16& p0, f32x16& p1, const char* Ks, const bf16x8* qr, int r32, int hi) {
    p0 = f32x16{}; p1 = f32x16{};
#pragma unroll
    for (int d0 = 0; d0 < 4; ++d0) { const int cb = (d0 * 16 + hi * 8) * 2;
        const bf16x8 b0 = *reinterpret_cast<const bf16x8*>(Ks + KSWZ(r32, cb));
        const bf16x8 b1 = *reinterpret_cast<const bf16x8*>(Ks + KSWZ(32 + r32, cb));
        p0 = __builtin_amdgcn_mfma_f32_32x32x16_bf16(b0, qr[d0], p0, 0, 0, 0);
        p1 = __builtin_amdgcn_mfma_f32_32x32x16_bf16(b1, qr[d0], p1, 0, 0, 0); }
}
__device__ __forceinline__ int v_st(int k, int c) { const int kk = (k & ~0xC) | ((k & 4) << 1) | ((k & 8) >> 1); return ((kk >> 3) * 4 + (c >> 5)) * 512 + ((kk & 7) * 32 + (c & 31)) * 2; }
__device__ __forceinline__ int v_rd_base(int lane) { return ((lane & 3) << 3) | (((lane >> 2) & 3) << 6) | (((lane >> 4) & 1) << 5) | (((lane >> 5) & 1) << 8); }
constexpr int v_rd_off(int d0, int ks, int half) { return d0 * 512 + ks * 4096 + half * 2048; }
template <int OFF> __device__ __forceinline__ s16x4 tr_read(int vb) {
    s16x4 r; asm volatile("ds_read_b64_tr_b16 %0, %1 offset:%2" : "=&v"(r) : "v"(vb), "i"(OFF) : "memory"); return r;
}
template <int D0> __device__ __forceinline__ void pv_one(f32x16& od, int vb, bf16x8 pa0, bf16x8 pa1, bf16x8 pa2, bf16x8 pa3) {
    const s16x4 l0 = tr_read<v_rd_off(D0, 0, 0)>(vb), h0 = tr_read<v_rd_off(D0, 0, 1)>(vb), l1 = tr_read<v_rd_off(D0, 1, 0)>(vb), h1 = tr_read<v_rd_off(D0, 1, 1)>(vb);
    const s16x4 l2 = tr_read<v_rd_off(D0, 2, 0)>(vb), h2 = tr_read<v_rd_off(D0, 2, 1)>(vb), l3 = tr_read<v_rd_off(D0, 3, 0)>(vb), h3 = tr_read<v_rd_off(D0, 3, 1)>(vb);
    asm volatile("s_waitcnt lgkmcnt(0)" ::: "memory"); SBAR();
#define PK(L, H) (bf16x8){L[0], L[1], L[2], L[3], H[0], H[1], H[2], H[3]}
    od = __builtin_amdgcn_mfma_f32_32x32x16_bf16(pa0, PK(l0, h0), od, 0, 0, 0);
    od = __builtin_amdgcn_mfma_f32_32x32x16_bf16(pa1, PK(l1, h1), od, 0, 0, 0);
    od = __builtin_amdgcn_mfma_f32_32x32x16_bf16(pa2, PK(l2, h2), od, 0, 0, 0);
    od = __builtin_amdgcn_mfma_f32_32x32x16_bf16(pa3, PK(l3, h3), od, 0, 0, 0);
#undef PK
}
__device__ __forceinline__ void pv_d0(f32x16* o, int vb, bf16x8 pa0, bf16x8 pa1, bf16x8 pa2, bf16x8 pa3) {
    pv_one<0>(o[0], vb, pa0, pa1, pa2, pa3); pv_one<1>(o[1], vb, pa0, pa1, pa2, pa3); pv_one<2>(o[2], vb, pa0, pa1, pa2, pa3); pv_one<3>(o[3], vb, pa0, pa1, pa2, pa3);
}

__device__ __forceinline__ void attn_pass(const bf16* __restrict__ Qb, const bf16* __restrict__ Kh, const bf16* __restrict__ Vh, char* lds, f32x16 (&o)[4], float& l_out) {
    int tid_ = threadIdx.x; asm volatile("" : "+v"(tid_));
    const int tid = tid_, wid = tid >> 6, lane = tid & 63, r32 = lane & 31, hi = lane >> 5;
    char* V_lds = lds + OFF_V; char* K_lds = lds + OFF_K;
    float* ws = (float*)(lds + OFF_WS) + wid * 64; float* al_l = ws + 32;
    float m_reg = -1e30f, l_reg = 0.f; bf16x8 qr[4];
#pragma unroll
    for (int d = 0; d < 4; ++d) o[d] = f32x16{};
    const GAS bf16* Qw = (const GAS bf16*)Qb + (size_t)(wid * QBLK + r32) * LD + hi * 8;
#pragma unroll
    for (int d0 = 0; d0 < 4; ++d0) qr[d0] = *(const GAS bf16x8*)(Qw + d0 * 16);
    const int sr = tid >> 4, sc = (tid & 15) * 8, vst0 = v_st(sr, sc), vst1 = v_st(32 + sr, sc);
    const int kr = tid >> 3, kc = (tid & 7) * 16, kst = KSWZ(kr, kc);
    const int vb0 = (int)(uintptr_t)V_lds + v_rd_base(lane);
    const GAS bf16* Kg = (const GAS bf16*)Kh + (size_t)kr * LD + (tid & 7) * 8;
    const GAS bf16* Vg = (const GAS bf16*)Vh + (size_t)sr * LD + sc;
    struct { bf16x8 vs0, vs1, ks0; } sr_[2];
#define SLOAD(i, k0) do { sr_[i].vs0 = *(const GAS bf16x8*)(Vg + (size_t)(k0) * LD); sr_[i].vs1 = *(const GAS bf16x8*)(Vg + (size_t)((k0) + 32) * LD); \
    sr_[i].ks0 = *(const GAS bf16x8*)(Kg + (size_t)(k0) * LD); } while (0)
#define SWRITE(b, i) do { *(bf16x8*)(V_lds + (b) * SHM_V + vst0) = sr_[i].vs0; *(bf16x8*)(V_lds + (b) * SHM_V + vst1) = sr_[i].vs1; \
    *(bf16x8*)(K_lds + (b) * SHM_K + kst) = sr_[i].ks0; } while (0)
#define SWAIT() asm volatile("s_waitcnt vmcnt(3)" ::: "memory")
#define RESC(a) do { if (__any((a) < 1.f)) { if (hi == 0) al_l[r32] = (a); asm volatile("s_waitcnt lgkmcnt(0)" ::: "memory"); \
    _Pragma("unroll") for (int d = 0; d < 4; ++d) _Pragma("unroll") for (int r = 0; r < 16; ++r) o[d][r] *= al_l[crow(r, hi)]; } } while (0)
    f32x16 pA0, pA1, pB0, pB1; float alA, alB; bf16x8 pa0, pa1, pa2, pa3; constexpr int NT = SEQ / KVBLK;
    constexpr int SE = 0, SO = 1;
    SLOAD(SE, 0); asm volatile("s_waitcnt vmcnt(0)" ::: "memory"); SWRITE(0, SE); __syncthreads();
    qkt(pA0, pA1, K_lds, qr, r32, hi); partialSM(pA0, pA1, m_reg, alA);
    SLOAD(SO, KVBLK); SLOAD(SE, 2 * KVBLK);
    SWAIT(); SWRITE(1, SO); __syncthreads();
    for (int j = 1; j + 1 < NT; j += 2) {
        SBAR(); qkt(pB0, pB1, K_lds + SHM_K, qr, r32, hi);
        finishSM(pA0, pA1, alA, l_reg, pa0, pa1, pa2, pa3); SBAR();
        SLOAD(SO, (j + 2) * KVBLK); SBAR();
        pv_d0(o, vb0, pa0, pa1, pa2, pa3); partialSM(pB0, pB1, m_reg, alB);
        __syncthreads(); SWAIT(); SWRITE(0, SE);
        RESC(alB); __syncthreads();
        SBAR(); qkt(pA0, pA1, K_lds, qr, r32, hi);
        finishSM(pB0, pB1, alB, l_reg, pa0, pa1, pa2, pa3); SBAR();
        if (j + 3 < NT) SLOAD(SE, (j + 3) * KVBLK); SBAR();
        pv_d0(o, vb0 + SHM_V, pa0, pa1, pa2, pa3); partialSM(pA0, pA1, m_reg, alA);
        __syncthreads(); SWAIT(); SWRITE(1, SO);
        RESC(alA); __syncthreads();
    }
    SBAR(); qkt(pB0, pB1, K_lds + SHM_K, qr, r32, hi);
    finishSM(pA0, pA1, alA, l_reg, pa0, pa1, pa2, pa3); SBAR();
    pv_d0(o, vb0, pa0, pa1, pa2, pa3); partialSM(pB0, pB1, m_reg, alB);
    __syncthreads(); RESC(alB);
    finishSM(pB0, pB1, alB, l_reg, pa0, pa1, pa2, pa3); SBAR();
    pv_d0(o, vb0 + SHM_V, pa0, pa1, pa2, pa3);
    l_out = l_reg;
    __syncthreads();
#undef SLOAD
#undef SWRITE
#undef SWAIT
#undef RESC
}

__device__ __forceinline__ void attn_unit(int b, int h, int qb, const bf16* Z, bf16* YC, float* OS, const float* subg, float lam, float oscale, char* lds) {
    int tid_ = threadIdx.x; asm volatile("" : "+v"(tid_));
    const int tid = tid_, wid = tid >> 6, lane = tid & 63, r32 = lane & 31, hi = lane >> 5;
    const size_t rowbase = (size_t)b * SEQ, q0 = rowbase + (size_t)qb * 256;
    float* wsf = (float*)(lds + OFF_WS) + wid * 64;
#pragma unroll 1
    for (int c = 0; c < 2; ++c) {
        f32x16 o[4]; float l;
        attn_pass(Z + q0 * LD + ZC_Q + h * 128 + c * 64, Z + rowbase * LD + ZC_K + h * 128 + c * 64, Z + rowbase * LD + ZC_V + h * 128, lds, o, l);
        if (hi == 0) wsf[r32] = l; asm volatile("s_waitcnt lgkmcnt(0)" ::: "memory");
        float rli[16];
#pragma unroll
        for (int r = 0; r < 16; ++r) rli[r] = 1.0f / wsf[crow(r, hi)];
        GAS float* os = (GAS float*)OS + (q0 + wid * QBLK + 4 * hi) * GW + h * 128 + r32;
        asm volatile("" : "+v"(os));
        if (c == 0) {
#pragma unroll
            for (int r = 0; r < 16; ++r) { GAS float* p = os + ((r & 3) + 8 * (r >> 2)) * GW;
#pragma unroll
                for (int d0 = 0; d0 < 4; ++d0) p[d0 * 32] = o[d0][r] * rli[r]; }
        } else {
            float ssq[16];
#pragma unroll
            for (int r = 0; r < 16; ++r) { const GAS float* p = os + ((r & 3) + 8 * (r >> 2)) * GW; float s = 0.f;
#pragma unroll
                for (int d0 = 0; d0 < 4; ++d0) { const float v = p[d0 * 32] - lam * (o[d0][r] * rli[r]); o[d0][r] = v; s += v * v; }
                ssq[r] = s; }
#pragma unroll
            for (int r = 0; r < 16; ++r) { float s = ssq[r]; s += __shfl_xor(s, 1); s += __shfl_xor(s, 2); s += __shfl_xor(s, 4); s += __shfl_xor(s, 8); s += __shfl_xor(s, 16);
                ssq[r] = oscale / sqrtf(s * (1.f / 128.f) + 1e-6f); }
            GAS bf16* yo = (GAS bf16*)YC + (q0 + wid * QBLK + 4 * hi) * DM + YC_D + h * 128 + r32;
            asm volatile("" : "+v"(yo));
#pragma unroll
            for (int r = 0; r < 16; ++r) { GAS bf16* p = yo + ((r & 3) + 8 * (r >> 2)) * DM;
#pragma unroll
                for (int d0 = 0; d0 < 4; ++d0) p[d0 * 32] = (bf16)f2bf(o[d0][r] * ssq[r] * subg[d0 * 32 + r32]); }
        }
        asm volatile("s_waitcnt vmcnt(0) lgkmcnt(0)" ::: "memory");
    }
}
#undef KSWZ
#undef SBAR
}

__global__ void __launch_bounds__(NWAVES * 64, 2) hybrid_fwd(Args args) {
    extern __shared__ __attribute__((aligned(16))) unsigned char lds[];
    Frame F;
    F.lds = (LAS unsigned char*)lds;
    F.MISC = (volatile LAS unsigned*)(F.lds + MISC_OFF);
    F.tid = threadIdx.x; F.lane = F.tid & 63; F.wave = __builtin_amdgcn_readfirstlane(F.tid >> 6);
    F.G = gridDim.x; { const int bx = blockIdx.x; F.vcu = (F.G % 8 == 0) ? (bx % 8) * (F.G / 8) + bx / 8 : bx; }
    unsigned char* ws = args.ws;
    F.ctl = (gu32*)(ws + WS_CTL);
    for (int u = F.tid; u < (LDS_BYTES - LDSCTL_OFF) / 4; u += NWAVES * 64) ((LAS unsigned*)(F.lds + LDSCTL_OFF))[u] = 0u;
    __syncthreads();
#if MK_SPLIT
#define GRID_BAR() do { } while (0)
#else
    XcdBarrier bar = xcd_barrier_post((unsigned*)(F.ctl + CW_BAR), F.MISC + 8);
#define GRID_BAR() xcd_barrier(bar)
#endif
    const int lo = args.ph_lo, hi = args.ph_hi;
#ifndef PH_MASK
#define PH_MASK 0x1FF
#endif
#define IN(k) (lo <= (k) && (k) < hi)
#define PM(b) ((PH_MASK >> (b)) & 1)
#ifndef LM
#define LM 15
#endif
#define SEAM(k) do { if ((k) + 1 < hi) GRID_BAR(); } while (0)

    bf16* const XN = (bf16*)(ws + WS_XN); bf16* const Z = (bf16*)(ws + WS_Z); bf16* const YC = (bf16*)(ws + WS_YC); bf16* const HB = (bf16*)(ws + WS_HB);
    float* const OS = (float*)(ws + WS_OS); const float* const rope = (const float*)(ws + WS_ROPE);
    const float* const x_in = args.in[0]; float* const out = args.out;

    if (PM(8) && IN(0)) { p0_prologue(F, args); SEAM(0); }

#define FRESH() do { int t_ = threadIdx.x; asm volatile("" : "+v"(t_)); F.tid = t_; F.lane = t_ & 63; F.wave = __builtin_amdgcn_readfirstlane(t_ >> 6); } while (0)
    for (int l = 0; l < NLAYER; ++l) {
        const int pb = 1 + 8 * l;
        const float* xcur = (l == 0) ? x_in : out;
        if (PM(0) && IN(pb + 0)) { FRESH(); rms_phase(F, xcur, args.in[1] + (size_t)l * DM, XN); SEAM(pb + 0); }
        if (PM(1) && IN(pb + 1)) { FRESH();
            pg8::Gemm g{XN, (const bf16*)(ws + WS_WIN) + (size_t)l * DIN * DM, M, DIN, DM}; pg8::StaticOrder S; S.init(M, DIN, F.G, (int)blockIdx.x);
            pg8::EpiZ E{Z, DIN, 2048};
            pg8::gemm_phase<pg8::EpiZ, pg8::StaticOrder, true, true>(F.lds + RING_OFF, g, S, E);
            SEAM(pb + 1);
        }
        if (PM(2) && IN(pb + 2)) { FRESH();
            if (LM & 1) for (int u = F.vcu; u < M / 64; u += F.G) qkprep_unit(F, Z, args.in[13] + l * 64, args.in[14] + l * 64, rope, u);
            if (LM & 2) for (int u = F.vcu; u < (M / 128) * 2; u += F.G) gmlp_unit(F, Z, YC, (const bf16*)(ws + WS_GWS) + (size_t)l * 8 * 128 * 128, args.in[6] + l * 8 * 128, args.in[3] + l * GW, args.in[4] + l * GW, u);
            if (LM & 4) for (int u = F.vcu; u < M / 32; u += F.G) conv_unit(F, Z, YC, args.in[7] + (size_t)l * 31 * GW, args.in[8] + l * GW, args.in[9] + l * GW, args.in[10] + l * GW, u);
            if (LM & 8) for (int u = F.vcu; u < (M / 64) * 4; u += F.G) pool_unit(F, Z, YC, (const bf16*)(ws + WS_PWT) + (size_t)l * 4 * 65536, args.in[12] + l * GW, u);
            SEAM(pb + 2);
        }
        if (PM(3) && IN(pb + 3)) { FRESH();
            float s1 = 0.f, s2 = 0.f;
            for (int i = 0; i < 64; ++i) { s1 += args.in[15][l * 64 + i] * args.in[16][l * 64 + i]; s2 += args.in[17][l * 64 + i] * args.in[18][l * 64 + i]; }
            const float lam_init = (l == 0) ? 0.2f : 0.35550907f;
            const float lam = expf(s1) - expf(s2) + lam_init;
            for (int U = F.vcu; U < BATCH * 8 * (SEQ / 256); U += F.G) {
                const int xg = (U % 256) / 32, i = U / 256, qb = U % 32, bh = xg * 2 + i;
                att::attn_unit(bh >> 3, bh & 7, qb, Z, YC, OS, args.in[19] + l * 128, lam, 1.0f - lam_init, (char*)lds + RING_OFF);
            }
            SEAM(pb + 3);
        }
        if (PM(4) && IN(pb + 4)) { FRESH();
            pg8::Gemm g{YC, (const bf16*)(ws + WS_WOUT) + (size_t)l * DM * DM, M, DM, DM}; pg8::StaticOrder S; S.init(M, DM, F.G, (int)blockIdx.x);
            pg8::EpiRes E{xcur, out, DM};
            pg8::gemm_phase<pg8::EpiRes, pg8::StaticOrder, true, true>(F.lds + RING_OFF, g, S, E);
            SEAM(pb + 4);
        }
        if (PM(5) && IN(pb + 5)) { FRESH(); rms_phase(F, out, args.in[21] + (size_t)l * DM, XN); SEAM(pb + 5); }
        if (PM(6) && IN(pb + 6)) { FRESH();
            pg8::Gemm g{XN, (const bf16*)(ws + WS_WUP) + (size_t)l * DFF * DM, M, DFF, DM}; pg8::StaticOrder S; S.init(M, DFF, F.G, (int)blockIdx.x);
            pg8::EpiRelu2 E{HB, DFF};
            pg8::gemm_phase<pg8::EpiRelu2, pg8::StaticOrder, true, true>(F.lds + RING_OFF, g, S, E);
            SEAM(pb + 6);
        }
        if (PM(7) && IN(pb + 7)) { FRESH();
            pg8::Gemm g{HB, (const bf16*)(ws + WS_WDN) + (size_t)l * DM * DFF, M, DM, DFF}; pg8::StaticOrder S; S.init(M, DM, F.G, (int)blockIdx.x);
            pg8::EpiRes E{out, out, DM};
            pg8::gemm_phase<pg8::EpiRes, pg8::StaticOrder, true, true>(F.lds + RING_OFF, g, S, E);
            SEAM(pb + 7);
        }
    }
#undef IN
#undef SEAM
}

constexpr int N_PHASES = 1 + 8 * NLAYER;
extern "C" void kernel_launch(void* const* d_in, const int* in_sizes, int n_in, void* d_out, int out_size, void* d_ws, size_t ws_size, hipStream_t stream) {
    static int grid = 0;
    if (grid == 0) {
        if (n_in != 24 || in_sizes[0] != M * DM || out_size != M * DM || ws_size < WS_END) { fprintf(stderr, "kernel_launch: unexpected shapes (n_in %d, in0 %d, out %d, ws %zu; need ws >= %zu); nothing launched\n", n_in, n_in > 0 ? in_sizes[0] : -1, out_size, ws_size, (size_t)WS_END); grid = -1; return; }
        int dev = 0, cus = 0, per_cu = 0;
        if (hipGetDevice(&dev) != hipSuccess || hipDeviceGetAttribute(&cus, hipDeviceAttributeMultiprocessorCount, dev) != hipSuccess) { fprintf(stderr, "kernel_launch: device query failed\n"); grid = -1; return; }
        if (hipFuncSetAttribute((const void*)hybrid_fwd, hipFuncAttributeMaxDynamicSharedMemorySize, LDS_BYTES) != hipSuccess) { fprintf(stderr, "kernel_launch: hipFuncSetAttribute failed\n"); grid = -1; return; }
        if (hipOccupancyMaxActiveBlocksPerMultiprocessor(&per_cu, (const void*)hybrid_fwd, NWAVES * 64, LDS_BYTES) != hipSuccess || per_cu < 1)
            fprintf(stderr, "kernel_launch: note: occupancy query reports %d workgroups per CU\n", per_cu);
        (void)hipGetLastError();
        grid = cus;
    }
    if (grid < 0) return;
    if (hipMemsetAsync((char*)d_ws + WS_CTL, 0, CTL_ZERO_BYTES, stream) != hipSuccess) { fprintf(stderr, "kernel_launch: memset failed\n"); return; }
    Args a{};
    for (int i = 0; i < 24; ++i) a.in[i] = (const float*)d_in[i];
    a.out = (float*)d_out; a.ws = (unsigned char*)d_ws;
#if MK_SPLIT
    for (int p = 0; p < N_PHASES; ++p) { a.ph_lo = p; a.ph_hi = p + 1; hipLaunchKernelGGL(hybrid_fwd, dim3(grid), dim3(NWAVES * 64), LDS_BYTES, stream, a); }
#else
    a.ph_lo = 0; a.ph_hi = N_PHASES; hipLaunchKernelGGL(hybrid_fwd, dim3(grid), dim3(NWAVES * 64), LDS_BYTES, stream, a);
#endif
    const hipError_t le = hipPeekAtLastError();
    if (le != hipSuccess) fprintf(stderr, "kernel_launch: launch failed: %s\n", hipGetErrorName(le));
}
```

```cpp
#include <hip/hip_runtime.h>
#include <cstdio>
#include <cstdint>
#include <type_traits>
namespace pg8 {
#define PG8_LAS __attribute__((address_space(3)))
typedef unsigned short bf16_t;
typedef short bf16x8 __attribute__((ext_vector_type(8)));
typedef float f32x4 __attribute__((ext_vector_type(4)));
typedef unsigned u32x4 __attribute__((ext_vector_type(4)));
constexpr int BM = 256, BK = 64, HALF = 128, HTB = HALF * BK * 2  , STAGE_BYTES = 8 * HTB, NXCD = 8, WGM = 8;

__host__ __device__ __forceinline__ int lds_byte(int r, int c) { const int st = (r >> 4) * 2 + (c >> 5), rr = r & 15, cc = c & 31, ob = rr * 64 + cc * 2; return st * 1024 + (ob ^ (((ob >> 9) & 1) << 5)); }
__host__ __device__ __forceinline__ void stage_rc(int b, int& R, int& C) { const int st = b / 1024, sb = b % 1024, swz = sb ^ (((sb >> 9) & 1) << 5); R = (st >> 1) * 16 + swz / 64; C = (st & 1) * 32 + (swz % 64) / 2; }
__host__ __device__ __forceinline__ int perm32(int rho) { const int n = rho >> 4, i = rho & 15; return 8 * (i >> 2) + 4 * n + (i & 3); }

struct Unit { int pm, pn; };
struct Gemm { const bf16_t* A; const bf16_t* Bt; int M, N, K; };

struct StaticOrder {
    int nM, nN, nwg, G, c, i0 = 0, i1 = 1 << 30;
    __host__ __device__ __forceinline__ void init(int M, int N, int G_, int c_) { nM = M / BM; nN = N / BM; nwg = nM * nN; G = G_; c = c_; }
    __host__ __device__ __forceinline__ bool next(int i_, Unit& u) const {
        const int i = i_ + i0; if (i >= i1) return false;
        const long L = (long)i * G + c; if (L >= nwg) return false;
        int wgid = (int)L; { const int q = nwg / NXCD, r = nwg % NXCD, xcd = wgid % NXCD, off = wgid / NXCD; wgid = (xcd < r ? xcd * (q + 1) : r * (q + 1) + (xcd - r) * q) + off; }
        const int nig = WGM * nN, gid = wgid / nig, fm = gid * WGM, gsz = (nM - fm) < WGM ? (nM - fm) : WGM;
        u.pm = fm + ((wgid % nig) % gsz); u.pn = (wgid % nig) / gsz; return true;
    }
    __device__ __forceinline__ void a_ready(const Unit&) const {}
    __device__ __forceinline__ void done(const Unit&) const {}
};

__device__ __forceinline__ unsigned cvt_pk_bf16(float lo, float hi) { unsigned r; asm volatile("v_cvt_pk_bf16_f32 %0, %1, %2" : "=v"(r) : "v"(lo), "v"(hi)); return r; }
typedef float f32x2 __attribute__((ext_vector_type(2)));
__device__ __forceinline__ f32x2 gelu_pk(f32x2 v) {
    const f32x2 av = __builtin_elementwise_abs(v), d = av * 0.2316418882f + 1.0f;
    f32x2 t; t.x = __builtin_amdgcn_rcpf(d.x); t.y = __builtin_amdgcn_rcpf(d.y);
    f32x2 q = t * 0.5307027145f + (-0.7265760135f); q = q * t + 0.7107068705f; q = q * t + (-0.142248368f); q = q * t + 0.127414796f; q = q * t;
    const f32x2 s = (v * v) * (-0.72134752044f);
    f32x2 e; e.x = __builtin_amdgcn_exp2f(s.x); e.y = __builtin_amdgcn_exp2f(s.y);
    const f32x2 m = v * (q * e), r = v - m;
    f32x2 o; o.x = v.x < 0.f ? m.x : r.x; o.y = v.y < 0.f ? m.y : r.y; return o;
}

template <int ACT  > struct EpiBf16 {
    static constexpr bool PERM = true, AFTER_DRAIN = false; static_assert(ACT == 0 || ACT == 1, "EpiBf16: ACT is 0 (none) or 1 (gelu_pk)");
    bf16_t* O; int ldc; const float* bias; int split_cols; size_t split_stride; float scale0;
    __device__ __forceinline__ void operator()(const f32x4 (&acc)[2][2][4][2], const Unit& u, int wr, int wc, int fr, int fq) const {
        const int row0 = u.pm * BM + wr * 64 + fr; int colt = u.pn * BM; bf16_t* base = O;
        float sc = 1.f; if (split_cols) { const int t = colt / split_cols; base += (size_t)t * split_stride; colt -= t * split_cols; if (t == 0) sc = scale0; }
        const int col0 = colt + wc * 32 + 8 * fq, bcol0 = u.pn * BM + wc * 32 + 8 * fq;
        f32x4 bv[2][2];
#pragma unroll
        for (int bj = 0; bj < 2; ++bj)
#pragma unroll
            for (int n = 0; n < 2; ++n) bv[bj][n] = bias ? *(const f32x4*)(bias + bcol0 + bj * HALF + 4 * n) : (f32x4){0.f, 0.f, 0.f, 0.f};
#pragma unroll
        for (int ai = 0; ai < 2; ++ai)
#pragma unroll
            for (int m = 0; m < 4; ++m) { bf16_t* rowp = base + (size_t)(row0 + ai * HALF + m * 16) * ldc + col0;
#pragma unroll
                for (int bj = 0; bj < 2; ++bj) { f32x4 v0 = acc[ai][bj][m][0] + bv[bj][0], v1 = acc[ai][bj][m][1] + bv[bj][1];
                    if (ACT == 1) { f32x2 a = gelu_pk((f32x2){v0[0], v0[1]}), b = gelu_pk((f32x2){v0[2], v0[3]}), c = gelu_pk((f32x2){v1[0], v1[1]}), d = gelu_pk((f32x2){v1[2], v1[3]});
                        v0 = (f32x4){a.x, a.y, b.x, b.y}; v1 = (f32x4){c.x, c.y, d.x, d.y}; }
                    v0 = v0 * sc; v1 = v1 * sc; u32x4 w; w.x = cvt_pk_bf16(v0[0], v0[1]); w.y = cvt_pk_bf16(v0[2], v0[3]); w.z = cvt_pk_bf16(v1[0], v1[1]); w.w = cvt_pk_bf16(v1[2], v1[3]);
                    *(u32x4*)(rowp + bj * HALF) = w; } }
    }
};

struct EpiZ {
    static constexpr bool PERM = true, AFTER_DRAIN = false;
    bf16_t* O; int ldc; const PG8_LAS float* rs; float* sv; const float* qg; const float* kg; const float* rope; float qscale; int seqmask, seqshift; bf16_t* qh; bf16_t* kh; bf16_t* vh;
    __device__ __forceinline__ void operator()(const f32x4 (&acc)[2][2][4][2], const Unit& u, int wr, int wc, int fr, int fq) const {
        const int pn = u.pn, row0 = u.pm * BM + wr * 64 + fr;
        if (pn < 8) {
            const int col0 = pn * BM + wc * 32 + 8 * fq; const bool st = pn >= 4;
#pragma unroll
            for (int ai = 0; ai < 2; ++ai)
#pragma unroll
                for (int m = 0; m < 4; ++m) { const int row = row0 + ai * HALF + m * 16; bf16_t* rowp = O + (size_t)row * ldc + col0; const float rsv = rs[ai * HALF + wr * 64 + m * 16 + fr]; float s1 = 0.f, s2 = 0.f;
#pragma unroll
                    for (int bj = 0; bj < 2; ++bj) { f32x4 v0 = acc[ai][bj][m][0] * rsv, v1 = acc[ai][bj][m][1] * rsv;
                        { f32x2 a = gelu_pk((f32x2){v0[0], v0[1]}), b = gelu_pk((f32x2){v0[2], v0[3]}), c = gelu_pk((f32x2){v1[0], v1[1]}), d = gelu_pk((f32x2){v1[2], v1[3]});
                          v0 = (f32x4){a.x, a.y, b.x, b.y}; v1 = (f32x4){c.x, c.y, d.x, d.y}; }
                        s1 += ((v0[0] + v0[1]) + (v0[2] + v0[3])) + ((v1[0] + v1[1]) + (v1[2] + v1[3]));
                        s2 += ((v0[0] * v0[0] + v0[1] * v0[1]) + (v0[2] * v0[2] + v0[3] * v0[3])) + ((v1[0] * v1[0] + v1[1] * v1[1]) + (v1[2] * v1[2] + v1[3] * v1[3]));
                        u32x4 w; w.x = cvt_pk_bf16(v0[0], v0[1]); w.y = cvt_pk_bf16(v0[2], v0[3]); w.z = cvt_pk_bf16(v1[0], v1[1]); w.w = cvt_pk_bf16(v1[2], v1[3]);
                        *(u32x4*)(rowp + bj * HALF) = w; }
                    if (st) { s1 += __shfl_xor(s1, 16); s2 += __shfl_xor(s2, 16); s1 += __shfl_xor(s1, 32); s2 += __shfl_xor(s2, 32);
                        if (fq == 0) *(f32x2*)(sv + ((size_t)row * 16 + (pn - 4) * 4 + wc) * 2) = (f32x2){s1, s2}; } }
        } else if (pn < 16) {
            const int col0 = 2048 + (pn - 8) * HALF + wc * 32 + 8 * fq;
#pragma unroll
            for (int ai = 0; ai < 2; ++ai)
#pragma unroll
                for (int m = 0; m < 4; ++m) { bf16_t* rowp = O + (size_t)(row0 + ai * HALF + m * 16) * ldc + col0; const float rsv = rs[ai * HALF + wr * 64 + m * 16 + fr], nrs = -1.4426950408889634f * rsv;
                    float h[8];
#pragma unroll
                    for (int n = 0; n < 2; ++n)
#pragma unroll
                        for (int e = 0; e < 4; ++e) h[n * 4 + e] = acc[ai][0][m][n][e] * rsv * __builtin_amdgcn_rcpf(1.0f + __builtin_amdgcn_exp2f(acc[ai][1][m][n][e] * nrs));
                    u32x4 w; w.x = cvt_pk_bf16(h[0], h[1]); w.y = cvt_pk_bf16(h[2], h[3]); w.z = cvt_pk_bf16(h[4], h[5]); w.w = cvt_pk_bf16(h[6], h[7]);
                    *(u32x4*)rowp = w; }
        } else if (pn < 20) {
            const int col0 = pn * BM + wc * 32 + 8 * fq;
#pragma unroll
            for (int ai = 0; ai < 2; ++ai)
#pragma unroll
                for (int m = 0; m < 4; ++m) { bf16_t* rowp = O + (size_t)(row0 + ai * HALF + m * 16) * ldc + col0; const float rsv = rs[ai * HALF + wr * 64 + m * 16 + fr];
#pragma unroll
                    for (int bj = 0; bj < 2; ++bj) { const f32x4 v0 = acc[ai][bj][m][0] * rsv, v1 = acc[ai][bj][m][1] * rsv;
                        u32x4 w; w.x = cvt_pk_bf16(v0[0], v0[1]); w.y = cvt_pk_bf16(v0[2], v0[3]); w.z = cvt_pk_bf16(v1[0], v1[1]); w.w = cvt_pk_bf16(v1[2], v1[3]);
                        *(u32x4*)(rowp + bj * HALF) = w; } }
        } else if (pn >= 28) {
#pragma unroll
            for (int ai = 0; ai < 2; ++ai)
#pragma unroll
                for (int m = 0; m < 4; ++m) { const int row = row0 + ai * HALF + m * 16, b = row >> seqshift, t = row & seqmask; const float rsv = rs[ai * HALF + wr * 64 + m * 16 + fr];
#pragma unroll
                    for (int bj = 0; bj < 2; ++bj) { const f32x4 v0 = acc[ai][bj][m][0] * rsv, v1 = acc[ai][bj][m][1] * rsv;
                        u32x4 w; w.x = cvt_pk_bf16(v0[0], v0[1]); w.y = cvt_pk_bf16(v0[2], v0[3]); w.z = cvt_pk_bf16(v1[0], v1[1]); w.w = cvt_pk_bf16(v1[2], v1[3]);
                        *(u32x4*)(vh + ((size_t)((b * 8 + (pn - 28) * 2 + bj)) << seqshift | (size_t)t) * 128 + wc * 32 + 8 * fq) = w; } }
        } else {
            const bool isq = pn < 24; const int hc = (pn - (isq ? 20 : 24)) * 4 + wc; bf16_t* const dst = isq ? qh : kh;
            const float* gp = isq ? qg : kg; const float sc = isq ? qscale : 1.0f;
            f32x4 g[2][2];
#pragma unroll
            for (int n = 0; n < 2; ++n) { g[0][n] = *(const f32x4*)(gp + (fq < 2 ? 4 * fq + 8 * n : 8 * fq + 4 * n)) * sc; g[1][n] = *(const f32x4*)(gp + 32 + 8 * fq + 4 * n) * sc; }
#pragma unroll
            for (int ai = 0; ai < 2; ++ai)
#pragma unroll
                for (int m = 0; m < 4; ++m) { const int row = row0 + ai * HALF + m * 16; bf16_t* rowp = dst + (((size_t)((row >> seqshift) * 16 + hc)) << seqshift | (size_t)(row & seqmask)) * 64 + 8 * fq; const float rsv = rs[ai * HALF + wr * 64 + m * 16 + fr];
                    f32x4 v[2][2]; float s = 0.f;
#pragma unroll
                    for (int bj = 0; bj < 2; ++bj)
#pragma unroll
                        for (int n = 0; n < 2; ++n) { v[bj][n] = acc[ai][bj][m][n] * rsv; s += (v[bj][n][0] * v[bj][n][0] + v[bj][n][1] * v[bj][n][1]) + (v[bj][n][2] * v[bj][n][2] + v[bj][n][3] * v[bj][n][3]); }
                    s += __shfl_xor(s, 16); s += __shfl_xor(s, 32);
                    const float rn = 1.0f / sqrtf(s * (1.f / 64.f) + 1e-6f);
#pragma unroll
                    for (int bj = 0; bj < 2; ++bj)
#pragma unroll
                        for (int n = 0; n < 2; ++n) v[bj][n] = v[bj][n] * rn * g[bj][n];
                    if (fq < 2) {
                        const float* rp = rope + (size_t)(row & seqmask) * 16 + fq * 8; const f32x4 cs0 = *(const f32x4*)rp, cs1 = *(const f32x4*)(rp + 4);
                        const f32x4 x1 = v[0][0], x2 = v[0][1]; const f32x4 cc = (f32x4){cs0[0], cs0[2], cs1[0], cs1[2]}, sn = (f32x4){cs0[1], cs0[3], cs1[1], cs1[3]};
                        v[0][0] = x1 * cc - x2 * sn; v[0][1] = x2 * cc + x1 * sn; }
#pragma unroll
                    for (int bj = 0; bj < 2; ++bj) { u32x4 w; w.x = cvt_pk_bf16(v[bj][0][0], v[bj][0][1]); w.y = cvt_pk_bf16(v[bj][0][2], v[bj][0][3]); w.z = cvt_pk_bf16(v[bj][1][0], v[bj][1][1]); w.w = cvt_pk_bf16(v[bj][1][2], v[bj][1][3]);
                        *(u32x4*)(rowp + bj * 32) = w; } }
        }
    }
};
template <bool NOSTORE = false> struct EpiRelu2T {
    static constexpr bool PERM = true, AFTER_DRAIN = false;
    bf16_t* O; int ldc; const PG8_LAS float* rs;
    __device__ __forceinline__ void operator()(const f32x4 (&acc)[2][2][4][2], const Unit& u, int wr, int wc, int fr, int fq) const {
        const int row0 = u.pm * BM + wr * 64 + fr; const int col0 = u.pn * BM + wc * 32 + 8 * fq;
#pragma unroll
        for (int ai = 0; ai < 2; ++ai)
#pragma unroll
            for (int m = 0; m < 4; ++m) { bf16_t* rowp = O + (size_t)(row0 + ai * HALF + m * 16) * ldc + col0; const float rsv = rs[ai * HALF + wr * 64 + m * 16 + fr];
#pragma unroll
                for (int bj = 0; bj < 2; ++bj) { f32x4 v0 = acc[ai][bj][m][0] * rsv, v1 = acc[ai][bj][m][1] * rsv;
                    v0 = __builtin_elementwise_max(v0, (f32x4){0.f, 0.f, 0.f, 0.f}); v1 = __builtin_elementwise_max(v1, (f32x4){0.f, 0.f, 0.f, 0.f}); v0 = v0 * v0; v1 = v1 * v1;
                    u32x4 w; w.x = cvt_pk_bf16(v0[0], v0[1]); w.y = cvt_pk_bf16(v0[2], v0[3]); w.z = cvt_pk_bf16(v1[0], v1[1]); w.w = cvt_pk_bf16(v1[2], v1[3]);
                    if (!NOSTORE || w.x == 0x12345678u) *(u32x4*)(rowp + bj * HALF) = w; } }
    }
};
typedef EpiRelu2T<false> EpiRelu2;
template <bool BASE_BF16, bool OUT_F32> struct EpiRes {
    static constexpr bool PERM = true, AFTER_DRAIN = false;
    const void* base; float* out; int ldc; bf16_t* xb; float* ss;
    __device__ __forceinline__ void operator()(const f32x4 (&acc)[2][2][4][2], const Unit& u, int wr, int wc, int fr, int fq) const {
        const int row0 = u.pm * BM + wr * 64 + fr, col0 = u.pn * BM + wc * 32 + 8 * fq;
        if constexpr (BASE_BF16) {
            u32x4 bw[2][4][2];
#pragma unroll
            for (int ai = 0; ai < 2; ++ai)
#pragma unroll
                for (int m = 0; m < 4; ++m) { const size_t off = (size_t)(row0 + ai * HALF + m * 16) * ldc + col0;
#pragma unroll
                    for (int bj = 0; bj < 2; ++bj) bw[ai][m][bj] = *(const u32x4*)((const bf16_t*)base + off + bj * HALF); }
#pragma unroll
            for (int ai = 0; ai < 2; ++ai) {
                float sq[4];
#pragma unroll
                for (int m = 0; m < 4; ++m) { const size_t off = (size_t)(row0 + ai * HALF + m * 16) * ldc + col0; float s = 0.f;
#pragma unroll
                    for (int bj = 0; bj < 2; ++bj) { const u32x4 w0 = bw[ai][m][bj];
                        const f32x4 b0 = (f32x4){__builtin_bit_cast(float, w0.x << 16), __builtin_bit_cast(float, w0.x & 0xffff0000u), __builtin_bit_cast(float, w0.y << 16), __builtin_bit_cast(float, w0.y & 0xffff0000u)};
                        const f32x4 b1 = (f32x4){__builtin_bit_cast(float, w0.z << 16), __builtin_bit_cast(float, w0.z & 0xffff0000u), __builtin_bit_cast(float, w0.w << 16), __builtin_bit_cast(float, w0.w & 0xffff0000u)};
                        const f32x4 o0 = b0 + acc[ai][bj][m][0], o1 = b1 + acc[ai][bj][m][1];
                        if constexpr (OUT_F32) { *(f32x4*)(out + off + bj * HALF) = o0; *(f32x4*)(out + off + bj * HALF + 4) = o1; }
                        else { u32x4 w; w.x = cvt_pk_bf16(o0[0], o0[1]); w.y = cvt_pk_bf16(o0[2], o0[3]); w.z = cvt_pk_bf16(o1[0], o1[1]); w.w = cvt_pk_bf16(o1[2], o1[3]); *(u32x4*)(xb + off + bj * HALF) = w;
                            s += ((o0[0] * o0[0] + o0[1] * o0[1]) + (o0[2] * o0[2] + o0[3] * o0[3])) + ((o1[0] * o1[0] + o1[1] * o1[1]) + (o1[2] * o1[2] + o1[3] * o1[3])); } }
                    sq[m] = s; }
                if constexpr (!OUT_F32) {
#pragma unroll
                    for (int m = 0; m < 4; ++m) { float s = sq[m]; s += __shfl_xor(s, 16); s += __shfl_xor(s, 32); if (fq == 0) ss[(size_t)(row0 + ai * HALF + m * 16) * 64 + u.pn * 4 + wc] = s; } }
            }
        } else {
#pragma unroll
        for (int ai = 0; ai < 2; ++ai) {
            f32x4 bs[4][2][2];
#pragma unroll
            for (int m = 0; m < 4; ++m) { const size_t off = (size_t)(row0 + ai * HALF + m * 16) * ldc + col0;
#pragma unroll
                for (int bj = 0; bj < 2; ++bj) { bs[m][bj][0] = *(const f32x4*)((const float*)base + off + bj * HALF); bs[m][bj][1] = *(const f32x4*)((const float*)base + off + bj * HALF + 4); } }
            float sq[4];
#pragma unroll
            for (int m = 0; m < 4; ++m) { const size_t off = (size_t)(row0 + ai * HALF + m * 16) * ldc + col0; float s = 0.f;
#pragma unroll
                for (int bj = 0; bj < 2; ++bj) { const f32x4 o0 = bs[m][bj][0] + acc[ai][bj][m][0], o1 = bs[m][bj][1] + acc[ai][bj][m][1];
                    if constexpr (OUT_F32) { *(f32x4*)(out + off + bj * HALF) = o0; *(f32x4*)(out + off + bj * HALF + 4) = o1; }
                    else { u32x4 w; w.x = cvt_pk_bf16(o0[0], o0[1]); w.y = cvt_pk_bf16(o0[2], o0[3]); w.z = cvt_pk_bf16(o1[0], o1[1]); w.w = cvt_pk_bf16(o1[2], o1[3]); *(u32x4*)(xb + off + bj * HALF) = w;
                        s += ((o0[0] * o0[0] + o0[1] * o0[1]) + (o0[2] * o0[2] + o0[3] * o0[3])) + ((o1[0] * o1[0] + o1[1] * o1[1]) + (o1[2] * o1[2] + o1[3] * o1[3])); } }
                sq[m] = s; }
            if constexpr (!OUT_F32) {
#pragma unroll
                for (int m = 0; m < 4; ++m) { float s = sq[m]; s += __shfl_xor(s, 16); s += __shfl_xor(s, 32); if (fq == 0) ss[(size_t)(row0 + ai * HALF + m * 16) * 64 + u.pn * 4 + wc] = s; } }
            asm volatile("" ::: "memory");
        }
        }
    }
};
template <class Epi, class Sched, bool ALIGN_EPI = false, bool SP2 = false>
__device__ __forceinline__ void gemm_phase(PG8_LAS unsigned char* lds, const Gemm g, const Sched& S, const Epi& E) {
    int tid_ = threadIdx.x; asm volatile("" : "+v"(tid_));
    const int tid = tid_, wid = __builtin_amdgcn_readfirstlane(tid >> 6), lane = tid & 63, wr = wid >> 2, wc = wid & 3, fr = lane & 15, fq = lane >> 4;
    const int K = g.K, nt = K / BK;
    unsigned voffA[2], voffB[2];
#pragma unroll
    for (int i = 0; i < 2; ++i) { int R, C; stage_rc(tid * 16 + i * 8192, R, C); const int Rb = Epi::PERM ? ((R & ~31) + perm32(R & 31)) : R;
        voffA[i] = (unsigned)(R * K + C) * 2u; voffB[i] = (unsigned)(Rb * K + C) * 2u; }
    const size_t kstep = (size_t)(BK * 2);
    const size_t hstep = (size_t)HALF * K * 2;
    const size_t tstep = 2 * hstep;
    const unsigned ldsw = (unsigned)wid * 1024u;
    const int aoff = lds_byte(wr * 64 + fr, fq * 8), boff = lds_byte(wc * 32 + fr, fq * 8);
#define PG8_SA(b, h) (((b) * 2 + (h)) * HTB)
#define PG8_SB(b, h) ((4 + (b) * 2 + (h)) * HTB)
#define PG8_STAGE(bufoff, gbase, voff) do { _Pragma("unroll") for (int _i = 0; _i < 2; ++_i) \
        __builtin_amdgcn_global_load_lds((const unsigned*)((const char*)(gbase) + (voff)[_i]), (PG8_LAS unsigned*)(lds + (bufoff) + ldsw + _i * 8192), 16, 0, 0); } while (0)
#define PG8_LDA(dst, b, h) do { _Pragma("unroll") for (int m = 0; m < 4; ++m) _Pragma("unroll") for (int k = 0; k < 2; ++k) dst[m][k] = *(const PG8_LAS bf16x8*)(lds + PG8_SA(b, h) + aoff + m * 2048 + k * 1024); } while (0)
#define PG8_LDB(dst, b, h) do { _Pragma("unroll") for (int n = 0; n < 2; ++n) _Pragma("unroll") for (int k = 0; k < 2; ++k) dst[n][k] = *(const PG8_LAS bf16x8*)(lds + PG8_SB(b, h) + boff + n * 2048 + k * 1024); } while (0)
#define PG8_MMA(ai, bj, At, Bt) do { __builtin_amdgcn_s_setprio(PG8_PRIO_MMA); _Pragma("unroll") for (int m = 0; m < 4; ++m) _Pragma("unroll") for (int n = 0; n < 2; ++n) _Pragma("unroll") for (int k = 0; k < 2; ++k) \
        acc[ai][bj][m][n] = __builtin_amdgcn_mfma_f32_16x16x32_bf16(Bt[n][k], At[m][k], acc[ai][bj][m][n], 0, 0, 0); __builtin_amdgcn_s_setprio(PG8_PRIO_LOAD); } while (0)
#ifndef PG8_PRIO_MMA
#define PG8_PRIO_MMA 1
#define PG8_PRIO_LOAD 0
#endif
#define PG8_WAIT_V(n) asm volatile("s_waitcnt vmcnt(" #n ")" ::: "memory")
#define PG8_WAIT_L(n) asm volatile("s_waitcnt lgkmcnt(" #n ")" ::: "memory")
#define PG8_BAR __builtin_amdgcn_s_barrier()
#define PG8_SCHED __builtin_amdgcn_sched_barrier(0)
    Unit cur, nxt; int ui = 0;
    if (!S.next(0, cur)) return;
    f32x4 acc[2][2][4][2];
#pragma unroll
    for (int a = 0; a < 2; ++a)
#pragma unroll
        for (int b = 0; b < 2; ++b)
#pragma unroll
            for (int m = 0; m < 4; ++m)
#pragma unroll
                for (int n = 0; n < 2; ++n) acc[a][b][m][n] = (f32x4){0.f, 0.f, 0.f, 0.f};
    bf16x8 At[4][2], B0[2][2], B1[2][2];
    const char* cA = (const char*)g.A + (size_t)cur.pm * tstep; const char* cB = (const char*)g.Bt + (size_t)cur.pn * tstep;
    S.a_ready(cur);
    if constexpr (SP2) {
        PG8_STAGE(PG8_SB(0, 0), cB, voffB); PG8_STAGE(PG8_SB(0, 1), cB + hstep, voffB); PG8_STAGE(PG8_SA(0, 0), cA, voffA); PG8_STAGE(PG8_SA(0, 1), cA + hstep, voffA);
        if (wr == 1) PG8_BAR;
        PG8_WAIT_V(2); PG8_BAR;
        PG8_STAGE(PG8_SB(1, 0), cB + kstep, voffB); PG8_STAGE(PG8_SA(1, 0), cA + kstep, voffA); PG8_STAGE(PG8_SB(1, 1), cB + hstep + kstep, voffB);
        PG8_WAIT_V(6); PG8_BAR;
    } else {
        PG8_STAGE(PG8_SB(0, 0), cB, voffB); PG8_STAGE(PG8_SA(0, 0), cA, voffA); PG8_STAGE(PG8_SB(0, 1), cB + hstep, voffB); PG8_STAGE(PG8_SA(0, 1), cA + hstep, voffA);
        if (wr == 1) PG8_BAR;
        PG8_WAIT_V(4); PG8_BAR;
        PG8_STAGE(PG8_SB(1, 0), cB + kstep, voffB); PG8_STAGE(PG8_SA(1, 0), cA + kstep, voffA); PG8_STAGE(PG8_SB(1, 1), cB + hstep + kstep, voffB);
        PG8_WAIT_V(6); PG8_BAR;
    }
    for (;;) {
        const bool has_next = S.next(ui + 1, nxt);
        const char* nA = has_next ? (const char*)g.A + (size_t)nxt.pm * tstep : cA; const char* nB = has_next ? (const char*)g.Bt + (size_t)nxt.pn * tstep : cB;
        for (int t = 0; t < nt; t += 2) {
            const bool last = (t == nt - 2);
            const char* a1 = cA + (size_t)(t + 1) * kstep;
            const char* a2 = last ? nA : cA + (size_t)(t + 2) * kstep; const char* b2 = last ? nB : cB + (size_t)(t + 2) * kstep;
            const char* a3 = a2 + kstep; const char* b3 = b2 + kstep;
            if (last && has_next) S.a_ready(nxt);
            if constexpr (SP2) {
            PG8_LDB(B0, 0, 0); PG8_LDB(B1, 0, 1); PG8_SCHED; PG8_LDA(At, 0, 0); PG8_STAGE(PG8_SA(1, 1), a1 + hstep, voffA);
            PG8_WAIT_V(8); PG8_WAIT_L(0); PG8_BAR; PG8_MMA(0, 0, At, B0); PG8_MMA(0, 1, At, B1); PG8_BAR; PG8_SCHED;
            PG8_LDA(At, 0, 1); PG8_STAGE(PG8_SB(0, 0), b2, voffB); PG8_STAGE(PG8_SB(0, 1), b2 + hstep, voffB); PG8_STAGE(PG8_SA(0, 0), a2, voffA);
            PG8_WAIT_V(8); PG8_WAIT_L(0); PG8_BAR; PG8_MMA(1, 0, At, B0); PG8_MMA(1, 1, At, B1); PG8_BAR; PG8_SCHED;
            PG8_LDB(B0, 1, 0); PG8_LDB(B1, 1, 1); PG8_SCHED; PG8_LDA(At, 1, 0); PG8_STAGE(PG8_SA(0, 1), a2 + hstep, voffA);
            PG8_WAIT_V(8); PG8_WAIT_L(0); PG8_BAR; PG8_MMA(0, 0, At, B0); PG8_MMA(0, 1, At, B1); PG8_BAR; PG8_SCHED;
            PG8_LDA(At, 1, 1); PG8_STAGE(PG8_SB(1, 0), b3, voffB); PG8_STAGE(PG8_SB(1, 1), b3 + hstep, voffB); PG8_STAGE(PG8_SA(1, 0), a3, voffA);
            PG8_WAIT_V(8); PG8_WAIT_L(0); PG8_BAR; PG8_MMA(1, 0, At, B0); PG8_MMA(1, 1, At, B1); PG8_BAR; PG8_SCHED;
            } else {
            PG8_LDB(B0, 0, 0); PG8_SCHED; PG8_LDA(At, 0, 0); PG8_STAGE(PG8_SA(1, 1), a1 + hstep, voffA);
            PG8_WAIT_L(8); PG8_BAR; PG8_WAIT_L(0); PG8_MMA(0, 0, At, B0); PG8_BAR; PG8_SCHED;
            PG8_LDB(B1, 0, 1); PG8_STAGE(PG8_SB(0, 0), b2, voffB);
            PG8_BAR; PG8_WAIT_L(0); PG8_MMA(0, 1, At, B1); PG8_BAR;
            PG8_LDA(At, 0, 1); PG8_STAGE(PG8_SA(0, 0), a2, voffA);
            PG8_BAR; PG8_WAIT_L(0); PG8_MMA(1, 0, At, B0); PG8_BAR; PG8_SCHED;
            PG8_STAGE(PG8_SB(0, 1), b2 + hstep, voffB);
            PG8_WAIT_V(6); PG8_BAR; PG8_MMA(1, 1, At, B1); PG8_BAR;
            PG8_LDB(B0, 1, 0); PG8_SCHED; PG8_LDA(At, 1, 0); PG8_STAGE(PG8_SA(0, 1), a2 + hstep, voffA);
            PG8_WAIT_L(8); PG8_BAR; PG8_WAIT_L(0); PG8_MMA(0, 0, At, B0); PG8_BAR; PG8_SCHED;
            PG8_LDB(B1, 1, 1); PG8_STAGE(PG8_SB(1, 0), b3, voffB);
            PG8_BAR; PG8_WAIT_L(0); PG8_MMA(0, 1, At, B1); PG8_BAR;
            PG8_LDA(At, 1, 1); PG8_STAGE(PG8_SA(1, 0), a3, voffA);
            PG8_BAR; PG8_WAIT_L(0); PG8_MMA(1, 0, At, B0); PG8_BAR; PG8_SCHED;
            PG8_STAGE(PG8_SB(1, 1), b3 + hstep, voffB);
            PG8_WAIT_V(6); PG8_BAR; PG8_MMA(1, 1, At, B1); PG8_BAR;
            }
        }
        if constexpr (ALIGN_EPI) { if (wr == 0) PG8_BAR; }
        if constexpr (!Epi::AFTER_DRAIN) { E(acc, cur, wr, wc, fr, fq); S.done(cur); }
        if (!has_next) break;
#pragma unroll
        for (int a = 0; a < 2; ++a)
#pragma unroll
            for (int b = 0; b < 2; ++b)
#pragma unroll
                for (int m = 0; m < 4; ++m)
#pragma unroll
                    for (int n = 0; n < 2; ++n) acc[a][b][m][n] = (f32x4){0.f, 0.f, 0.f, 0.f};
        cur = nxt; cA = nA; cB = nB; ++ui;
        if constexpr (ALIGN_EPI) { if (wr == 1) PG8_BAR; }
    }
    PG8_WAIT_V(0);
    if constexpr (!ALIGN_EPI) { if (wr == 0) PG8_BAR; }
    PG8_BAR;
    if constexpr (Epi::AFTER_DRAIN) { E.fused(acc, cur, wr, wc, fr, fq, lds, wid, lane); S.done(cur); }
#undef PG8_SA
#undef PG8_SB
#undef PG8_STAGE
#undef PG8_LDA
#undef PG8_LDB
#undef PG8_MMA
#undef PG8_WAIT_V
#undef PG8_WAIT_L
#undef PG8_BAR
#undef PG8_SCHED
}
}

constexpr int NWAVES = 8;
constexpr int BATCH = 2, SEQ = 8192, DM = 4096, NLAYER = 2, GW = 1024, DIN = 8192, DFF = 16384;
constexpr int M = BATCH * SEQ;
constexpr int ZC_A = 0, ZC_B = 2048, ZC_C = 4096, ZC_Q = 5120, ZC_K = 6144, ZC_V = 7168;
constexpr int YC_A = 0, YC_B = 1024, YC_C = 2048, YC_D = 3072;
constexpr float QSCALE = 0.125f * 1.4426950408889634f;
#ifndef MK_SPLIT
#define MK_SPLIT 0
#endif

constexpr size_t MiB = 1u << 20;
constexpr size_t WS_CTL = 0, CTL_ZERO_BYTES = 64 * 1024;
constexpr size_t WS_ROPE = 1 * MiB;
constexpr size_t WS_PWT = 2 * MiB;
constexpr size_t WS_GWS = 3 * MiB;
constexpr size_t WS_SS = 4 * MiB;
constexpr size_t WS_SV = 8 * MiB;
constexpr size_t WS_WIN = 16 * MiB;
constexpr size_t WS_WOUT = 144 * MiB;
constexpr size_t WS_WUP = 208 * MiB;
constexpr size_t WS_WDN = 464 * MiB;
constexpr size_t WS_XN = 720 * MiB;
constexpr size_t WS_Z = 848 * MiB;
constexpr size_t WS_YC = 1104 * MiB;
constexpr size_t WS_HB = 1232 * MiB;
constexpr size_t WS_OS = 1744 * MiB;
constexpr size_t WS_QH = 1808 * MiB;
constexpr size_t WS_KH = 1840 * MiB;
constexpr size_t WS_VH = 1872 * MiB;
constexpr size_t WS_END = 1904 * MiB;
constexpr int CW_BAR = 1024;

constexpr int RING_OFF = 0, RING_BYTES = 131072;
constexpr int LDSCTL_OFF = RING_BYTES, MISC_OFF = LDSCTL_OFF + 320;
constexpr int RSTAB_OFF = RING_BYTES + 1024;
constexpr int LDS_BYTES = 147456;

#define GAS __attribute__((address_space(1)))
#define LAS __attribute__((address_space(3)))
typedef unsigned short bf16;
typedef unsigned v4u __attribute__((ext_vector_type(4)));
typedef float f32x4 __attribute__((ext_vector_type(4)));
typedef short bf16x8 __attribute__((ext_vector_type(8)));
typedef GAS unsigned gu32;
typedef GAS unsigned long long gu64;
#define RLX_AGENT __ATOMIC_RELAXED, __HIP_MEMORY_SCOPE_AGENT
#define LDS_WAIT() asm volatile("s_waitcnt lgkmcnt(0)" ::: "memory")
#define VM_WAIT() asm volatile("s_waitcnt vmcnt(0)" ::: "memory")
__device__ __forceinline__ unsigned long long rt() { return __builtin_amdgcn_s_memrealtime(); }
__device__ __forceinline__ unsigned f2bf(float f) { unsigned u = __builtin_bit_cast(unsigned, f); return (u + 0x7fffu + ((u >> 16) & 1u)) >> 16; }
__device__ __forceinline__ unsigned pk2(float lo, float hi) { return f2bf(lo) | (f2bf(hi) << 16); }

#define XB_TMO      128
#define XB_XCNT(j)  (256  + 64 * (j))
#define XB_XSUB(j)  (1280 + 64 * (j))
#define XB_XGEN(j)  (2304 + 64 * (j))
#define XB_TOP      3328
#define XB_TOPGEN   3392
#define XCD_BAR_WORDS 3456
#define XB_SPIN_CAP (1u << 18)

__device__ __forceinline__ unsigned xb_ld(unsigned* p)              { return __hip_atomic_load(p, __ATOMIC_RELAXED, __HIP_MEMORY_SCOPE_AGENT); }
__device__ __forceinline__ unsigned xb_add(unsigned* p, unsigned v) { return __hip_atomic_fetch_add(p, v, __ATOMIC_RELAXED, __HIP_MEMORY_SCOPE_AGENT); }
__device__ __forceinline__ unsigned xb_xcc_id() { return (unsigned)__builtin_amdgcn_s_getreg((3 << 11) | 20) & 0xFu; }
#define XB_SPIN(cond, bar) do { unsigned _sp = 0; while (cond) { __builtin_amdgcn_s_sleep(1); \
    if ((++_sp & 255u) == 0u) { if (xb_ld(&(bar)[XB_TMO])) break; if (_sp > XB_SPIN_CAP) { atomicAdd(&(bar)[XB_TMO], 1u); break; } } } } while (0)

struct XcdBarrier {
    unsigned* bar; unsigned x;
    volatile LAS unsigned* st;
};

__device__ __forceinline__ XcdBarrier xcd_barrier_post(unsigned* bar, volatile LAS unsigned* st) {
    XcdBarrier b; b.bar = bar; b.x = xb_xcc_id(); b.st = st;
    if (threadIdx.x == 0) (void)xb_add(&bar[XB_XCNT(b.x)], 1u);
    return b;
}
__device__ __forceinline__ void xcd_barrier_complete(unsigned* bar, unsigned x, unsigned& nloc, unsigned& nx) {
    const unsigned G = gridDim.x * gridDim.y * gridDim.z;
    unsigned sum, cnt, mine, sp = 0u;
    for (;;) {
        sum = 0u; cnt = 0u; mine = 0u;
#pragma unroll
        for (unsigned j = 0; j < 16; ++j) { const unsigned c = xb_ld(&bar[XB_XCNT(j)]); sum += c; cnt += (c > 0u) ? 1u : 0u; mine = (j == x) ? c : mine; }
        if (sum == G) break;
        __builtin_amdgcn_s_sleep(1);
        if ((++sp & 255u) == 0u) { if (xb_ld(&bar[XB_TMO])) break; if (sp > XB_SPIN_CAP) { atomicAdd(&bar[XB_TMO], 1u); break; } }
    }
    nloc = mine > 0u ? mine : 1u; nx = cnt > 0u ? cnt : 1u;
}

__device__ __forceinline__ void xcd_barrier_leader(const XcdBarrier& b) {
        unsigned* bar = b.bar;
        __builtin_amdgcn_s_waitcnt(0);
        unsigned nloc = b.st[0], nx = b.st[1];
        if (nloc == 0u) { xcd_barrier_complete(bar, b.x, nloc, nx); b.st[0] = nloc; b.st[1] = nx; }
        const unsigned old = xb_add(&bar[XB_XSUB(b.x)], 1u);
        const unsigned gen = old / nloc;
        if (old + 1u == (gen + 1u) * nloc) {
            __builtin_amdgcn_fence(__ATOMIC_RELEASE, "agent");
            asm volatile("s_waitcnt vmcnt(0)" ::: "memory");
            const unsigned og = xb_add(&bar[XB_TOP], 1u);
            const unsigned tg = og / nx;
            if (og + 1u == (tg + 1u) * nx) xb_add(&bar[XB_TOPGEN], 1u);
            else XB_SPIN(xb_ld(&bar[XB_TOPGEN]) == tg, bar);
            __builtin_amdgcn_fence(__ATOMIC_ACQUIRE, "agent");
            xb_add(&bar[XB_XGEN(b.x)], 1u);
            asm volatile("s_waitcnt vmcnt(0)" ::: "memory");
        } else {
            XB_SPIN(xb_ld(&bar[XB_XGEN(b.x)]) == gen, bar);
            __builtin_amdgcn_fence(__ATOMIC_ACQUIRE, "agent");
            asm volatile("s_waitcnt vmcnt(0)" ::: "memory");
        }
}
__device__ __forceinline__ void xcd_barrier(const XcdBarrier& b) {
    asm volatile("s_waitcnt vmcnt(0)" ::: "memory");
    __syncthreads();
    if (threadIdx.x == 0) xcd_barrier_leader(b);
    __syncthreads();
}

typedef unsigned u32x2 __attribute__((ext_vector_type(2)));
typedef float f32x2v __attribute__((ext_vector_type(2)));
struct Frame {
    LAS unsigned char* lds;
    volatile LAS unsigned* MISC;
    gu32* ctl;
    int tid, lane, wave;
    int vcu, G;
};
struct Args { const float* in[24]; float* out; unsigned char* ws; int ph_lo, ph_hi; };

__device__ __forceinline__ float wave_sum(float v) {
#pragma unroll
    for (int o = 1; o < 64; o <<= 1) v += __shfl_xor(v, o);
    return v;
}
__device__ __forceinline__ float bf_lo(unsigned w) { return __builtin_bit_cast(float, w << 16); }
__device__ __forceinline__ float bf_hi(unsigned w) { return __builtin_bit_cast(float, w & 0xffff0000u); }
__device__ __forceinline__ float sigmoidf_fast(float x) { return __builtin_amdgcn_rcpf(1.0f + __builtin_amdgcn_exp2f(-1.4426950408889634f * x)); }

__device__ __forceinline__ int zin_dest(int n) {
    if (n < 2048 || (n >= 4096 && n < 5120) || n >= 7168) return n;
    if (n < 4096) { const int j = n - 2048, half = j >> 10, c = j & 1023; return 2048 + 256 * (c >> 7) + 128 * half + (c & 127); }
    const int base = (n < 6144) ? 5120 : 6144, j = n - base, hc = j >> 6, d = j & 63;
    const int pos = (d < 16) ? ((d & 3) | ((d & 4) << 1) | ((d & 8) >> 1)) : d;
    return base + 256 * (hc >> 2) + 32 * (hc & 3) + (d < 32 ? pos : 128 + (d - 32));
}
template <bool PERMZ>
__device__ __forceinline__ void p0_transpose_item(const float* W, int K, int N, bf16* WT, LAS float* scr, int item, int lane, const float* gain = nullptr) {
    const int nblk = N / 32, kb = item / nblk, nb = item % nblk, k0 = 64 * kb, n0 = 32 * nb;
    const GAS float* Wg = (const GAS float*)W;
    const int c = lane & 7;
    f32x4 g0 = (f32x4){1.f, 1.f, 1.f, 1.f}, g1 = g0;
    if (gain) { g0 = *(const GAS f32x4*)(gain + k0 + 8 * c); g1 = *(const GAS f32x4*)(gain + k0 + 8 * c + 4); }
    float tv[32];
#pragma unroll
    for (int i = 0; i < 32; ++i) { const int kk = 2 * i + (lane >> 5); tv[i] = Wg[(size_t)(k0 + kk) * N + n0 + (lane & 31)]; }
#pragma unroll
    for (int i = 0; i < 32; ++i) { const int kk = 2 * i + (lane >> 5); scr[kk * 33 + (lane & 31)] = tv[i]; }
    LDS_WAIT(); asm volatile("" ::: "memory");
#pragma unroll
    for (int j = 0; j < 4; ++j) { const int n = (lane >> 3) + 8 * j; const LAS float* s = scr + (8 * c) * 33 + n;
        v4u o; o.x = pk2(s[0 * 33] * g0.x, s[1 * 33] * g0.y); o.y = pk2(s[2 * 33] * g0.z, s[3 * 33] * g0.w); o.z = pk2(s[4 * 33] * g1.x, s[5 * 33] * g1.y); o.w = pk2(s[6 * 33] * g1.z, s[7 * 33] * g1.w);
        const int dn = PERMZ ? zin_dest(n0 + n) : n0 + n;
        *(GAS v4u*)(WT + (size_t)dn * K + k0 + 8 * c) = o; }
    LDS_WAIT(); asm volatile("" ::: "memory");
}
template <bool PERMZ>
__device__ __forceinline__ void p0_transpose_pair(const float* W, int K, int N, bf16* WT, LAS float* scr, int item, int lane, const float* gain = nullptr) {
    const int nblk = N / 32, kb = item / nblk, nb = item % nblk, k0 = 64 * kb, n0 = 32 * nb;
    const GAS float* Wg = (const GAS float*)W;
    const int c = lane & 7;
    f32x4 g0 = (f32x4){1.f, 1.f, 1.f, 1.f}, g1 = g0;
    if (gain) { g0 = *(const GAS f32x4*)(gain + k0 + 8 * c); g1 = *(const GAS f32x4*)(gain + k0 + 8 * c + 4); }
    float tv[2][32];
#pragma unroll
    for (int h = 0; h < 2; ++h)
#pragma unroll
        for (int i = 0; i < 32; ++i) { const int kk = 2 * i + (lane >> 5); tv[h][i] = __builtin_nontemporal_load(Wg + (size_t)(k0 + kk) * N + n0 + 32 * h + (lane & 31)); }
#pragma unroll
    for (int h = 0; h < 2; ++h) {
#pragma unroll
        for (int i = 0; i < 32; ++i) { const int kk = 2 * i + (lane >> 5); scr[kk * 33 + (lane & 31)] = tv[h][i]; }
        LDS_WAIT(); asm volatile("" ::: "memory");
#pragma unroll
        for (int j = 0; j < 4; ++j) { const int n = (lane >> 3) + 8 * j; const LAS float* s = scr + (8 * c) * 33 + n;
            v4u o; o.x = pk2(s[0 * 33] * g0.x, s[1 * 33] * g0.y); o.y = pk2(s[2 * 33] * g0.z, s[3 * 33] * g0.w); o.z = pk2(s[4 * 33] * g1.x, s[5 * 33] * g1.y); o.w = pk2(s[6 * 33] * g1.z, s[7 * 33] * g1.w);
            const int dn = PERMZ ? zin_dest(n0 + 32 * h + n) : n0 + 32 * h + n;
            __builtin_nontemporal_store(o, (GAS v4u*)(WT + (size_t)dn * K + k0 + 8 * c)); }
        LDS_WAIT(); asm volatile("" ::: "memory");
    }
}
constexpr int CV_IN = (DM / 64) * (DIN / 32), CV_OUT = (DM / 64) * (DM / 32), CV_UP = (DM / 64) * (DFF / 32), CV_DN = (DFF / 64) * (DM / 32), CV_L = CV_IN + CV_OUT + CV_UP + CV_DN;
constexpr int CV_TOTAL = NLAYER * CV_L - CV_IN, CV_CHUNK = 16, CV_NCHUNK = CV_TOTAL / CV_CHUNK;
constexpr unsigned CV_EXH = 0xFFFFFFFFu;
constexpr int CW_Q = 8192;
constexpr int QST_OFF = LDSCTL_OFF + 4096;
static_assert(CV_TOTAL % (CV_CHUNK * 256) == 0 && CV_IN % (CV_CHUNK * 256) == 0 && CV_OUT % (CV_CHUNK * 256) == 0 && CV_UP % (CV_CHUNK * 256) == 0, "chunking");
__device__ __forceinline__ constexpr int cv_deadline(int l, int which) { return l * CV_L + (which == 0 ? CV_IN : which == 1 ? CV_IN + CV_OUT : which == 2 ? CV_IN + CV_OUT + CV_UP : CV_L) - CV_IN; }
__device__ __forceinline__ void cv_item(const Args& a, LAS float* scr, int I, int lane) {
    unsigned char* ws = a.ws;
    const int J = I + CV_IN, l = (J >= CV_L) ? 1 : 0; int r = J - l * CV_L;
    if (r < CV_IN) { p0_transpose_pair<true>(a.in[2] + (size_t)l * DM * DIN, DM, DIN, (bf16*)(ws + WS_WIN) + (size_t)l * DIN * DM, scr, r, lane, a.in[1] + (size_t)l * DM); return; } r -= CV_IN;
    if (r < CV_OUT) { p0_transpose_pair<false>(a.in[20] + (size_t)l * DM * DM, DM, DM, (bf16*)(ws + WS_WOUT) + (size_t)l * DM * DM, scr, r, lane); return; } r -= CV_OUT;
    if (r < CV_UP) { p0_transpose_pair<false>(a.in[22] + (size_t)l * DM * DFF, DM, DFF, (bf16*)(ws + WS_WUP) + (size_t)l * DFF * DM, scr, r, lane, a.in[21] + (size_t)l * DM); return; } r -= CV_UP;
    p0_transpose_pair<false>(a.in[23] + (size_t)l * DFF * DM, DFF, DM, (bf16*)(ws + WS_WDN) + (size_t)l * DM * DFF, scr, r, lane);
}
#ifndef NO_WAIT_STEAL
#define NO_WAIT_STEAL 0
#endif
__device__ __forceinline__ constexpr unsigned cv_seg_end(int s) {
    constexpr unsigned O = CV_OUT / 256, U = CV_UP / 256, D = CV_DN / 256, I = CV_IN / 256;
    const unsigned r = (s == 0 || s == 4) ? O : (s == 1 || s == 5) ? O + U : (s == 2 || s == 6) ? O + U + D : 0u;
    return s < 3 ? r : O + U + D + I + r;
}
constexpr int CW_HP = CW_Q + 2048, CW_FP = CW_Q + 2048 + 256 * 8;
__device__ __forceinline__ void seam_steal(const Frame& F, const Args& a, const XcdBarrier& b, int DS, int NS) {
    volatile LAS unsigned* QS = (volatile LAS unsigned*)(F.lds + QST_OFF);
    LAS float* scr = (LAS float*)(F.lds + RING_OFF + F.wave * 16384);
    const unsigned cu = blockIdx.x, pc = (cu + 1u) & 255u, TJ = (unsigned)CV_TOTAL / 256u;
    const unsigned DJ = DS >= 0 ? cv_seg_end(DS) : 0u, D0 = DS > 0 ? cv_seg_end(DS - 1) : 0u;
    const unsigned N1 = NS >= 0 ? cv_seg_end(NS) : 0u, N0 = NS > 0 ? cv_seg_end(NS - 1) : 0u;
    volatile LAS unsigned* WP = QS + 32 + 8 * F.wave;
    { unsigned lim = DJ;
      if (DS >= 0) { unsigned hp = 0u; if (F.lane == 0) hp = xb_ld((unsigned*)(F.ctl + CW_HP + cu * 8 + DS)); hp = (unsigned)__builtin_amdgcn_readfirstlane((int)hp);
                     lim = (2u * hp >= DJ - D0) ? D0 : DJ - 2u * hp; }
      if (F.lane == 0) { WP[0] = lim; WP[1] = DJ; WP[2] = N1; WP[3] = N0; WP[4] = (NS < 0) ? 1u : 0u;   WP[5] = 0u;   } }
    __syncthreads();
    const unsigned e0 = (unsigned)__builtin_amdgcn_readfirstlane((int)QS[0]);
#ifdef DIAG_STEAL
    unsigned stolen = 0u;
#endif
#define RDW(i) ((unsigned)__builtin_amdgcn_readfirstlane((int)WP[i]))
    for (;;) {
        const unsigned mode = RDW(5);
        if (mode == 1u && (unsigned)__builtin_amdgcn_readfirstlane((int)QS[0]) != e0) break;
        unsigned owner = cu, j0 = 0u;
        const unsigned mine = (unsigned)__builtin_amdgcn_readfirstlane((int)QS[1]);
        if (mode == 0u && mine >= RDW(0)) {
            const unsigned dj = RDW(1);
            if (F.lane == 0 && dj > 0u) __hip_atomic_fetch_max((LAS unsigned*)(F.lds + QST_OFF + 4), dj, __ATOMIC_RELAXED, __HIP_MEMORY_SCOPE_WORKGROUP);
            asm volatile("s_waitcnt vmcnt(0)" ::: "memory");
            __syncthreads();
            if (F.wave == 0 || NO_WAIT_STEAL) { if (threadIdx.x == 0) { __hip_atomic_store((unsigned*)(F.ctl + CW_FP + cu), QS[1], RLX_AGENT); xcd_barrier_leader(b); QS[0] = e0 + 1u; } break; }
            if (F.lane == 0) WP[5] = 1u;
            continue;
        }
        const unsigned fl = RDW(4);
        if (mode == 1u && !(fl & 1u) && mine >= RDW(2)) {
            if (!(fl & 2u)) { unsigned fp = 0u; if (F.lane == 0) fp = xb_ld((unsigned*)(F.ctl + CW_FP + pc)); fp = (unsigned)__builtin_amdgcn_readfirstlane((int)fp);
                              const unsigned n0 = RDW(3); if (F.lane == 0) { WP[3] = fp > n0 ? fp : n0; WP[4] = fl | 2u; } }
            unsigned m = 0u; if (F.lane == 0) m = __hip_atomic_fetch_add((LAS unsigned*)(F.lds + QST_OFF + 64 + 4 * NS), 1u, __ATOMIC_RELAXED, __HIP_MEMORY_SCOPE_WORKGROUP);
            m = (unsigned)__builtin_amdgcn_readfirstlane((int)m);
            const unsigned n1 = RDW(2);
            if (RDW(3) + 2u * (m + 1u) > n1) { if (F.lane == 0) WP[4] = RDW(4) | 1u; continue; }
            if (F.lane == 0) __hip_atomic_fetch_add((unsigned*)(F.ctl + CW_HP + pc * 8 + NS), 1u, RLX_AGENT);
            owner = pc; j0 = n1 - 2u * (m + 1u);
        } else {
            if (mine >= TJ) { if (mode == 0u) continue; __builtin_amdgcn_s_sleep(8); continue; }
            if (F.lane == 0) j0 = __hip_atomic_fetch_add((LAS unsigned*)(F.lds + QST_OFF + 4), 2u, __ATOMIC_RELAXED, __HIP_MEMORY_SCOPE_WORKGROUP);
            j0 = (unsigned)__builtin_amdgcn_readfirstlane((int)j0);
            if (j0 >= TJ) continue;
            if (j0 >= RDW(0) && j0 < RDW(1)) continue;
        }
        cv_item(a, scr, (int)(16u * (256u * (j0 >> 4) + owner) + (j0 & 15u)), F.lane);
#ifdef DIAG_STEAL
        stolen += 2u * mode;
#endif
    }
#undef RDW
#ifdef DIAG_STEAL
    if (F.lane == 0 && stolen) __hip_atomic_fetch_add((unsigned*)(F.ctl + CW_Q + 1024), stolen, RLX_AGENT);
#endif
    __syncthreads();
}
__device__ __forceinline__ void p0_prologue(const Frame& F, const Args& a) {
    LAS float* scr = (LAS float*)(F.lds + RING_OFF + F.wave * 16384);
    unsigned char* ws = a.ws;
    const int gw = F.vcu * NWAVES + F.wave, NGW = F.G * NWAVES;
    constexpr int I_PW1 = (256 / 64) * (256 / 32), I_PW = 4 * I_PW1;
    for (int it = gw; it < CV_IN + NLAYER * I_PW; it += NGW) {
        if (it < CV_IN) { p0_transpose_item<true>(a.in[2], DM, DIN, (bf16*)(ws + WS_WIN), scr, it, F.lane, a.in[1]); continue; }
        const int r = it - CV_IN, lg = r / I_PW1, ri = r % I_PW1;
        p0_transpose_item<false>(a.in[11] + (size_t)lg * 65536, 256, 256, (bf16*)(ws + WS_PWT) + (size_t)lg * 65536, scr, ri, F.lane);
    }
    const int gt = F.vcu * (NWAVES * 64) + F.tid, NGT = F.G * NWAVES * 64;
    { const GAS float* src = (const GAS float*)a.in[5]; GAS unsigned* dst = (GAS unsigned*)(ws + WS_GWS);
      for (int i = gt; i < NLAYER * 8 * 128 * 128 / 2; i += NGT) dst[i] = pk2(src[2 * i], src[2 * i + 1]); }
    { GAS float* rope = (GAS float*)(ws + WS_ROPE);
      for (int e = gt; e < SEQ * 8; e += NGT) {
          const int pos = e >> 3, i = e & 7;
          const float invf = (i == 0) ? 1.0f : (i == 1) ? 0x1.8d275ep-3f : (i == 2) ? 0x1.341190p-5f : (i == 3) ? 0x1.ddee9cp-8f : (i == 4) ? 0x1.72ba44p-10f : (i == 5) ? 0x1.1f91f0p-12f : (i == 6) ? 0x1.be218ap-15f : 0x1.5a0f50p-17f;
          const float angf = (float)pos * invf;
          const double ad = (double)angf;
          const double kq = __builtin_rint(ad * 0.63661977236758134308);
          const double y = __builtin_fma(-kq, 1.57079632679489661923, ad);
          const double y2 = y * y;
          const double sn = y * (1.0 + y2 * (-1.0 / 6 + y2 * (1.0 / 120 + y2 * (-1.0 / 5040 + y2 * (1.0 / 362880 + y2 * (-1.0 / 39916800))))));
          const double cs = 1.0 + y2 * (-0.5 + y2 * (1.0 / 24 + y2 * (-1.0 / 720 + y2 * (1.0 / 40320 + y2 * (-1.0 / 3628800 + y2 * (1.0 / 479001600))))));
          const int q = ((int)kq) & 3;
          const double c = (q == 0) ? cs : (q == 1) ? -sn : (q == 2) ? -cs : sn;
          const double s = (q == 0) ? sn : (q == 1) ? cs : (q == 2) ? -sn : -cs;
          rope[2 * e] = (float)c; rope[2 * e + 1] = (float)s;
      } }
}

__device__ __forceinline__ void xprep_phase(const Frame& F, const float* x, bf16* XB, float* SS) {
    const int gw = F.vcu * NWAVES + F.wave, NGW = F.G * NWAVES;
    for (int m = gw; m < M; m += NGW) {
        const GAS f32x4* xr = (const GAS f32x4*)(x + (size_t)m * DM) + F.lane;
        f32x4 v[16]; float s = 0.f;
#pragma unroll
        for (int j = 0; j < 16; ++j) { v[j] = xr[64 * j]; s += (v[j].x * v[j].x + v[j].y * v[j].y) + (v[j].z * v[j].z + v[j].w * v[j].w); }
        GAS u32x2* o8 = (GAS u32x2*)(XB + (size_t)m * DM) + F.lane;
#pragma unroll
        for (int j = 0; j < 16; ++j) { u32x2 w; w.x = pk2(v[j].x, v[j].y); w.y = pk2(v[j].z, v[j].w); o8[64 * j] = w; }
        ((GAS float*)SS)[(size_t)m * 64 + F.lane] = s;
    }
}
__device__ __forceinline__ void rs_table(const Frame& F, const float* SS, int pm) {
    LAS float* tab = (LAS float*)(F.lds + RSTAB_OFF);
    if (F.tid < 256) { const GAS f32x4* p = (const GAS f32x4*)(SS + (size_t)(pm * 256 + F.tid) * 64); float s = 0.f;
#pragma unroll
        for (int j = 0; j < 16; ++j) { const f32x4 v = p[j]; s += (v.x + v.y) + (v.z + v.w); }
        tab[F.tid] = 1.0f / sqrtf(s * (1.f / DM) + 1e-6f); }
    __syncthreads();
}

__device__ __forceinline__ int vimg_st(int k, int c) { const int kk = (k & ~0xC) | ((k & 4) << 1) | ((k & 8) >> 1); return ((kk >> 3) * 4 + (c >> 5)) * 512 + ((kk & 7) * 32 + (c & 31)) * 2; }
__device__ __forceinline__ int vimg_rd_base(int lane) { return ((lane & 3) << 3) | (((lane >> 2) & 3) << 6) | (((lane >> 4) & 1) << 5) | (((lane >> 5) & 1) << 8); }
typedef __attribute__((ext_vector_type(4))) short s16x4;
typedef __attribute__((ext_vector_type(16))) float f32x16;
template <int OFF> __device__ __forceinline__ s16x4 vimg_tr(int vb) { s16x4 r; asm volatile("ds_read_b64_tr_b16 %0, %1 offset:%2" : "=&v"(r) : "v"(vb), "i"(OFF) : "memory"); return r; }
__device__ __forceinline__ void unpack8(const v4u a, float (&v)[8]) { v[0] = bf_lo(a.x); v[1] = bf_hi(a.x); v[2] = bf_lo(a.y); v[3] = bf_hi(a.y); v[4] = bf_lo(a.z); v[5] = bf_hi(a.z); v[6] = bf_lo(a.w); v[7] = bf_hi(a.w); }

__device__ __forceinline__ void gmlp_unit(const Frame& F, const bf16* Z, bf16* YC, const float* SV, const bf16* Wsb, const float* bs, const float* lng, const float* lnb, int unit, char* ldsg) {
    const int chunk = unit >> 2, hp = unit & 3, r0 = chunk * 128, tid = F.tid, lane = F.lane, w = F.wave, r32 = lane & 31, hi = lane >> 5;
    LAS float* st = (LAS float*)(F.lds + RING_OFF);
    LAS unsigned char* VI = F.lds + RING_OFF + 1024;
    LAS float* OT = (LAS float*)(F.lds + RING_OFF + 1024 + 32768);
    if (tid < 128) { const GAS f32x4* p = (const GAS f32x4*)(SV + (size_t)(r0 + tid) * 32); float s1 = 0.f, s2 = 0.f;
#pragma unroll
        for (int j = 0; j < 8; ++j) { const f32x4 v = p[j]; s1 += v.x + v.z; s2 += v.y + v.w; }
        const float mean = s1 * (1.f / 1024.f), var = s2 * (1.f / 1024.f) - mean * mean;
        st[tid * 2] = mean; st[tid * 2 + 1] = 1.0f / sqrtf(fmaxf(var, 0.f) + 1e-5f); }
    __syncthreads();
    const int d0 = w & 3, ib0 = (w >> 2) * 2;
    const int vb = (int)(uintptr_t)(ldsg + RING_OFF + 1024) + vimg_rd_base(lane) + d0 * 512;
#pragma unroll 1
    for (int hq = 0; hq < 2; ++hq) {
        const int h = hp * 2 + hq;
        bf16x8 wa[8], wb[8];
        { const GAS bf16* wrow = (const GAS bf16*)Wsb + (size_t)(h * 128 + 32 * ib0 + r32) * 128 + 8 * hi;
#pragma unroll
          for (int ks = 0; ks < 8; ++ks) { wa[ks] = *(const GAS bf16x8*)(wrow + 16 * ks); wb[ks] = *(const GAS bf16x8*)(wrow + 32 * 128 + 16 * ks); } }
        { const int j = tid >> 2, cq = tid & 3; const float mean = st[j * 2], rstd = st[j * 2 + 1];
          const GAS v4u* p = (const GAS v4u*)(Z + (size_t)(r0 + j) * DIN + ZC_A + 1024 + h * 128 + cq * 32);
          const GAS f32x4* gp = (const GAS f32x4*)(lng + h * 128 + cq * 32); const GAS f32x4* bp = (const GAS f32x4*)(lnb + h * 128 + cq * 32);
          v4u a[4];
#pragma unroll
          for (int k4 = 0; k4 < 4; ++k4) a[k4] = p[k4];
#pragma unroll
          for (int k4 = 0; k4 < 4; ++k4) { float v[8]; unpack8(a[k4], v); const f32x4 g0 = gp[2 * k4], g1 = gp[2 * k4 + 1], b0 = bp[2 * k4], b1 = bp[2 * k4 + 1];
              v4u o; o.x = pk2((v[0] - mean) * rstd * g0.x + b0.x, (v[1] - mean) * rstd * g0.y + b0.y); o.y = pk2((v[2] - mean) * rstd * g0.z + b0.z, (v[3] - mean) * rstd * g0.w + b0.w);
              o.z = pk2((v[4] - mean) * rstd * g1.x + b1.x, (v[5] - mean) * rstd * g1.y + b1.y); o.w = pk2((v[6] - mean) * rstd * g1.z + b1.z, (v[7] - mean) * rstd * g1.w + b1.w);
              *(LAS v4u*)(VI + (j >> 6) * 16384 + vimg_st(j & 63, cq * 32 + k4 * 8)) = o; } }
        __syncthreads();
        f32x16 acc[2]; acc[0] = f32x16{}; acc[1] = f32x16{};
#define GM_RD(KS) lo_[KS] = vimg_tr<((KS) >> 2) * 16384 + ((KS) & 3) * 4096>(vb), hi_[KS] = vimg_tr<((KS) >> 2) * 16384 + ((KS) & 3) * 4096 + 2048>(vb)
#define GM_MM(KS) do { const bf16x8 b_ = (bf16x8){lo_[KS][0], lo_[KS][1], lo_[KS][2], lo_[KS][3], hi_[KS][0], hi_[KS][1], hi_[KS][2], hi_[KS][3]}; \
        acc[0] = __builtin_amdgcn_mfma_f32_32x32x16_bf16(wa[KS], b_, acc[0], 0, 0, 0); acc[1] = __builtin_amdgcn_mfma_f32_32x32x16_bf16(wb[KS], b_, acc[1], 0, 0, 0); } while (0)
        { s16x4 lo_[8], hi_[8];
          GM_RD(0); GM_RD(1); GM_RD(2); GM_RD(3); GM_RD(4); GM_RD(5); GM_RD(6); GM_RD(7);
          asm volatile("s_waitcnt lgkmcnt(0)" ::: "memory"); __builtin_amdgcn_sched_barrier(0);
          GM_MM(0); GM_MM(1); GM_MM(2); GM_MM(3); GM_MM(4); GM_MM(5); GM_MM(6); GM_MM(7); }
#undef GM_RD
#undef GM_MM
#define GM_STEP(KS) do { } while (0)
#undef GM_STEP
#pragma unroll
        for (int t = 0; t < 2; ++t)
#pragma unroll
            for (int r = 0; r < 16; ++r) OT[(32 * (ib0 + t) + (r & 3) + 8 * (r >> 2) + 4 * hi) * 132 + 32 * d0 + r32] = acc[t][r];
        __syncthreads();
        { const int i = tid >> 2, cq = tid & 3; const float b = bs[h * 128 + i];
          const GAS v4u* up = (const GAS v4u*)(Z + (size_t)(r0 + i) * DIN + ZC_A + h * 128 + cq * 32); GAS v4u* yp = (GAS v4u*)(YC + (size_t)(r0 + i) * DM + YC_A + h * 128 + cq * 32);
          v4u a[4];
#pragma unroll
          for (int k4 = 0; k4 < 4; ++k4) a[k4] = up[k4];
#pragma unroll
          for (int k4 = 0; k4 < 4; ++k4) { float u[8]; unpack8(a[k4], u); const f32x4 o0 = *(const LAS f32x4*)(OT + i * 132 + cq * 32 + k4 * 8), o1 = *(const LAS f32x4*)(OT + i * 132 + cq * 32 + k4 * 8 + 4);
              v4u o; o.x = pk2((o0.x + b) * u[0], (o0.y + b) * u[1]); o.y = pk2((o0.z + b) * u[2], (o0.w + b) * u[3]); o.z = pk2((o1.x + b) * u[4], (o1.y + b) * u[5]); o.w = pk2((o1.z + b) * u[6], (o1.w + b) * u[7]);
              yp[k4] = o; } }
    }
    __syncthreads();
}

template <int R> __device__ __forceinline__ void conv_rows(const unsigned (&hraw)[62], const f32x2v (&w)[31], f32x2v (&acc)[31], const f32x2v bias, LAS float* cvp, int rlo, int rhi) {
    const unsigned hv = (R >= rlo && R < rhi) ? hraw[R] : 0u;
    const f32x2v h = (f32x2v){bf_lo(hv), bf_hi(hv)};
#pragma unroll
    for (int k = 0; k < 31; ++k) { const int o = R - k; if (o >= 0 && o <= 31) acc[(o + 31) % 31] = acc[(o + 31) % 31] + h * w[k]; }
    if constexpr (R >= 30) { constexpr int o = R - 30; *(LAS f32x2v*)(cvp + o * GW) = acc[o % 31] + bias; acc[o % 31] = (f32x2v){0.f, 0.f}; }
    if constexpr (R + 1 < 62) conv_rows<R + 1>(hraw, w, acc, bias, cvp, rlo, rhi);
}
__device__ __forceinline__ void conv_unit(const Frame& F, const bf16* Z, bf16* YC, const float* cw, const float* cb, const float* lng, const float* lnb, int unit) {
    const int t0 = unit * 32, bstart = (t0 / SEQ) * SEQ, bend = bstart + SEQ, tid = F.tid, lane = F.lane, c0 = 2 * tid;
    LAS float* CV = (LAS float*)(F.lds + RING_OFF);
    unsigned hraw[62];
    { const GAS bf16* zp = (const GAS bf16*)Z + (ptrdiff_t)(t0 - 15) * DIN + ZC_B + c0;
#pragma unroll
      for (int r = 0; r < 62; ++r) { hraw[r] = *(const GAS unsigned*)zp; zp += DIN; asm volatile("" : "+v"(zp)); } }
    f32x2v w[31], acc[31];
    { const GAS float* wp = (const GAS float*)cw + c0;
#pragma unroll
      for (int k = 0; k < 31; ++k) { w[k] = *(const GAS f32x2v*)wp; acc[k] = (f32x2v){0.f, 0.f}; wp += GW; asm volatile("" : "+v"(wp)); } }
    const f32x2v bias = *(const GAS f32x2v*)(cb + c0);
    conv_rows<0>(hraw, w, acc, bias, CV + c0, bstart - (t0 - 15), bend - (t0 - 15));
    __syncthreads();
    { f32x4 x[4][4]; float sm[4], qv[4];
#pragma unroll
      for (int oo = 0; oo < 4; ++oo) { const int o = F.wave * 4 + oo; float s_ = 0.f;
#pragma unroll
          for (int j = 0; j < 4; ++j) { x[oo][j] = *(const LAS f32x4*)(CV + o * GW + lane * 4 + 256 * j); s_ += (x[oo][j].x + x[oo][j].y) + (x[oo][j].z + x[oo][j].w); }
          sm[oo] = s_; }
#pragma unroll
      for (int st = 1; st < 64; st <<= 1) {
#pragma unroll
          for (int oo = 0; oo < 4; ++oo) sm[oo] += __shfl_xor(sm[oo], st); }
#pragma unroll
      for (int oo = 0; oo < 4; ++oo) { const float mean = sm[oo] * (1.f / GW); float q = 0.f;
#pragma unroll
          for (int j = 0; j < 4; ++j) { x[oo][j] = x[oo][j] - mean; q += (x[oo][j].x * x[oo][j].x + x[oo][j].y * x[oo][j].y) + (x[oo][j].z * x[oo][j].z + x[oo][j].w * x[oo][j].w); }
          qv[oo] = q; }
#pragma unroll
      for (int st = 1; st < 64; st <<= 1) {
#pragma unroll
          for (int oo = 0; oo < 4; ++oo) qv[oo] += __shfl_xor(qv[oo], st); }
#pragma unroll
      for (int j = 0; j < 4; ++j) { const int c = lane * 4 + 256 * j; const f32x4 gv = *(const GAS f32x4*)(lng + c), bv = *(const GAS f32x4*)(lnb + c);
#pragma unroll
          for (int oo = 0; oo < 4; ++oo) { const int o = F.wave * 4 + oo; const float rstd = 1.0f / sqrtf(qv[oo] * (1.f / GW) + 1e-5f);
              f32x4 y = x[oo][j] * rstd * gv + bv; y.x *= sigmoidf_fast(y.x); y.y *= sigmoidf_fast(y.y); y.z *= sigmoidf_fast(y.z); y.w *= sigmoidf_fast(y.w);
              u32x2 wv; wv.x = pk2(y.x, y.y); wv.y = pk2(y.z, y.w);
              *(GAS u32x2*)(YC + (size_t)(t0 + o) * DM + YC_B + c) = wv; } } }
    __syncthreads();
}

__device__ __forceinline__ void pool_unit(const Frame& F, const bf16* Z, bf16* YC, const bf16* PWT, const float* scale, int unit) {
    const int g = unit & 3, tile = unit >> 2, t0 = tile * 64, bstart = (t0 / SEQ) * SEQ, tid = F.tid, lane = F.lane, fr = lane & 15, fq = lane >> 4, w = F.wave;
    const int wh = 1 << g;
    LAS bf16* ZT = (LAS bf16*)(F.lds + RING_OFF);
    LAS bf16* P = (LAS bf16*)(F.lds + RING_OFF + 80 * 264 * 2);
    const GAS bf16* pw = (const GAS bf16*)PWT + (size_t)g * 65536;
    bf16x8 Bf[8][2];
#pragma unroll
    for (int kk = 0; kk < 8; ++kk)
#pragma unroll
        for (int n = 0; n < 2; ++n) Bf[kk][n] = *(const GAS bf16x8*)(pw + (size_t)(32 * w + 16 * n + fr) * 256 + 32 * kk + 8 * fq);
    { const GAS bf16* zc = (const GAS bf16*)Z + ZC_C + g * 256; v4u a[5];
#pragma unroll
      for (int i = 0; i < 5; ++i) { const int q = tid + 512 * i, rr = q >> 5, cc = q & 31; int row = t0 - 8 + rr; row = row < bstart ? bstart : (row >= bstart + SEQ ? bstart + SEQ - 1 : row);
          a[i] = *(const GAS v4u*)(zc + (size_t)row * DIN + cc * 8); }
#pragma unroll
      for (int i = 0; i < 5; ++i) { const int q = tid + 512 * i, rr = q >> 5, cc = q & 31; *(LAS v4u*)(ZT + rr * 264 + cc * 8) = a[i]; } }
    __syncthreads();
    { const int cc = tid & 31, rg = tid >> 5;
      auto body = [&](auto GC) { constexpr int WH = 1 << decltype(GC)::value, NU = 2 * WH + 3;
          const int pos0 = t0 - bstart + 4 * rg - WH;
          v4u raw[NU];
#pragma unroll
          for (int i = 0; i < NU; ++i) raw[i] = *(const LAS v4u*)(ZT + (4 * rg - WH + i + 8) * 264 + cc * 8);
          float sw[8];
#pragma unroll
          for (int e = 0; e < 8; ++e) sw[e] = 0.f;
#pragma unroll
          for (int i = 0; i < 2 * WH; ++i) { const unsigned ps = (unsigned)(pos0 + i); float v[8]; unpack8(raw[i], v); const float mk = ps < (unsigned)SEQ ? 1.f : 0.f;
#pragma unroll
              for (int e = 0; e < 8; ++e) sw[e] += v[e] * mk; }
#pragma unroll
          for (int o = 0; o < 4; ++o) {
              if (o > 0) { float va[8], vr[8]; unpack8(raw[2 * WH - 1 + o], va); unpack8(raw[o - 1], vr);
                  const float ma = (unsigned)(pos0 + 2 * WH - 1 + o) < (unsigned)SEQ ? 1.f : 0.f, mr = (unsigned)(pos0 + o - 1) < (unsigned)SEQ ? 1.f : 0.f;
#pragma unroll
                  for (int e = 0; e < 8; ++e) sw[e] += va[e] * ma - vr[e] * mr; }
              const int pos = pos0 + WH + o; const int lo = pos - WH > 0 ? pos - WH : 0, hi = pos + WH < SEQ ? pos + WH : SEQ; const float inv = 1.0f / (float)(hi - lo);
              float v[8]; unpack8(raw[WH + o], v);
              v4u ov; ov.x = pk2(sw[0] * inv - v[0], sw[1] * inv - v[1]); ov.y = pk2(sw[2] * inv - v[2], sw[3] * inv - v[3]); ov.z = pk2(sw[4] * inv - v[4], sw[5] * inv - v[5]); ov.w = pk2(sw[6] * inv - v[6], sw[7] * inv - v[7]);
              *(LAS v4u*)(P + (4 * rg + o) * 264 + cc * 8) = ov; } };
      if (g == 0) body(std::integral_constant<int, 0>{}); else if (g == 1) body(std::integral_constant<int, 1>{}); else if (g == 2) body(std::integral_constant<int, 2>{}); else body(std::integral_constant<int, 3>{}); }
    __syncthreads();
    f32x4 acc[4][2];
#pragma unroll
    for (int m = 0; m < 4; ++m)
#pragma unroll
        for (int n = 0; n < 2; ++n) acc[m][n] = (f32x4){0.f, 0.f, 0.f, 0.f};
#pragma unroll
    for (int kk = 0; kk < 8; ++kk) {
        bf16x8 Af[4];
#pragma unroll
        for (int m = 0; m < 4; ++m) Af[m] = *(const LAS bf16x8*)(P + (16 * m + fr) * 264 + 32 * kk + 8 * fq);
#pragma unroll
        for (int m = 0; m < 4; ++m)
#pragma unroll
            for (int n = 0; n < 2; ++n) acc[m][n] = __builtin_amdgcn_mfma_f32_16x16x32_bf16(Bf[kk][n], Af[m], acc[m][n], 0, 0, 0);
    }
#pragma unroll
    for (int n = 0; n < 2; ++n) { const int d = 32 * w + 16 * n + 4 * fq; const f32x4 sc = *(const GAS f32x4*)(scale + g * 256 + d);
#pragma unroll
        for (int m = 0; m < 4; ++m) { const f32x4 v = acc[m][n] * sc; u32x2 wv; wv.x = pk2(v[0], v[1]); wv.y = pk2(v[2], v[3]);
            *(GAS u32x2*)(YC + (size_t)(t0 + 16 * m + fr) * DM + YC_C + g * 256 + d) = wv; } }
    __syncthreads();
}

namespace att {
typedef __attribute__((ext_vector_type(8))) short bf16x8;
typedef __attribute__((ext_vector_type(4))) short s16x4;
typedef __attribute__((ext_vector_type(16))) float f32x16;
typedef __attribute__((ext_vector_type(4))) unsigned u32x4;
constexpr int QBLK = 32, KVBLK = 64, NW = 8, LDQK = 64, LDV = 128;
constexpr int SHM_V = KVBLK * 128 * 2, SHM_K = KVBLK * 64 * 2;
constexpr int OFF_V = 0, OFF_K = 2 * SHM_V, OFF_WS = OFF_K + 2 * SHM_K, ATT_LDS = OFF_WS + NW * 64 * 4;
constexpr float THR = 8.0f;
#define KSWZ(row, colB) ((row) * 128 + ((colB) ^ ((((row) >> 1) & 7) << 4)))
#define SBAR() __builtin_amdgcn_sched_barrier(0)
__device__ __forceinline__ int crow(int r, int hi) { return (r & 3) + 8 * (r >> 2) + 4 * hi; }
__device__ __forceinline__ unsigned cvtpk(float lo, float hi) { unsigned r; asm volatile("v_cvt_pk_bf16_f32 %0, %1, %2" : "=v"(r) : "v"(lo), "v"(hi)); return r; }

__device__ __forceinline__ void partialSM(f32x16& p0, f32x16& p1, float& m_reg, float& alpha) {
    float pmax = p0[0];
#pragma unroll
    for (int r = 1; r < 16; ++r) pmax = fmaxf(pmax, p0[r]);
#pragma unroll
    for (int r = 0; r < 16; ++r) pmax = fmaxf(pmax, p1[r]);
    { auto rr = __builtin_amdgcn_permlane32_swap(__float_as_uint(pmax), __float_as_uint(pmax), false, false);
      pmax = fmaxf(__uint_as_float(rr[0]), __uint_as_float(rr[1])); }
    if (__builtin_expect(__all(pmax - m_reg <= THR), 1)) { alpha = 1.f; }
    else { const float mn = fmaxf(m_reg, pmax); alpha = __builtin_amdgcn_exp2f(m_reg - mn); m_reg = mn; }
    const float mm = m_reg;
#pragma unroll
    for (int r = 0; r < 16; ++r) { p0[r] -= mm; p1[r] -= mm; }
#pragma unroll
    for (int r = 0; r < 16; ++r) p0[r] = __builtin_amdgcn_exp2f(p0[r]);
}
__device__ __forceinline__ void finishSM(f32x16& p0, f32x16& p1, float alpha, float& l_reg, bf16x8& pa0, bf16x8& pa1, bf16x8& pa2, bf16x8& pa3) {
#pragma unroll
    for (int r = 0; r < 16; ++r) p1[r] = __builtin_amdgcn_exp2f(p1[r]);
    float ps = 0.f;
#pragma unroll
    for (int r = 0; r < 16; ++r) ps += p0[r];
#pragma unroll
    for (int r = 0; r < 16; ++r) ps += p1[r];
    { auto rr = __builtin_amdgcn_permlane32_swap(__float_as_uint(ps), __float_as_uint(ps), false, false);
      ps = __uint_as_float(rr[0]) + __uint_as_float(rr[1]); }
    l_reg = l_reg * alpha + ps;
#define PK4(P, BASE, OUT) do { unsigned a0 = cvtpk(P[BASE + 0], P[BASE + 1]), a1 = cvtpk(P[BASE + 2], P[BASE + 3]);   \
    unsigned b0 = cvtpk(P[BASE + 4], P[BASE + 5]), b1 = cvtpk(P[BASE + 6], P[BASE + 7]);                              \
    auto r0 = __builtin_amdgcn_permlane32_swap(a0, b0, false, false); auto r1 = __builtin_amdgcn_permlane32_swap(a1, b1, false, false); \
    u32x4 w = {r0[0], r1[0], r0[1], r1[1]}; OUT = *reinterpret_cast<bf16x8*>(&w); } while (0)
    PK4(p0, 0, pa0); PK4(p0, 8, pa1); PK4(p1, 0, pa2); PK4(p1, 8, pa3);
#undef PK4
}
__device__ __forceinline__ void qkt(f32x16& p0, f32x16& p1, const char* Ks, const bf16x8* qr, int r32, int hi) {
    p0 = f32x16{}; p1 = f32x16{};
#pragma unroll
    for (int d0 = 0; d0 < 4; ++d0) { const int cb = (d0 * 16 + hi * 8) * 2;
        const bf16x8 b0 = *reinterpret_cast<const bf16x8*>(Ks + KSWZ(r32, cb));
        const bf16x8 b1 = *reinterpret_cast<const bf16x8*>(Ks + KSWZ(32 + r32, cb));
        p0 = __builtin_amdgcn_mfma_f32_32x32x16_bf16(b0, qr[d0], p0, 0, 0, 0);
        p1 = __builtin_amdgcn_mfma_f32_32x32x16_bf16(b1, qr[d0], p1, 0, 0, 0); }
}
__device__ __forceinline__ int v_st(int k, int c) { const int kk = (k & ~0xC) | ((k & 4) << 1) | ((k & 8) >> 1); return ((kk >> 3) * 4 + (c >> 5)) * 512 + ((kk & 7) * 32 + (c & 31)) * 2; }
__device__ __forceinline__ int v_rd_base(int lane) { return ((lane & 3) << 3) | (((lane >> 2) & 3) << 6) | (((lane >> 4) & 1) << 5) | (((lane >> 5) & 1) << 8); }
constexpr int v_rd_off(int d0, int ks, int half) { return d0 * 512 + ks * 4096 + half * 2048; }
template <int OFF> __device__ __forceinline__ s16x4 tr_read(int vb) {
    s16x4 r; asm volatile("ds_read_b64_tr_b16 %0, %1 offset:%2" : "=&v"(r) : "v"(vb), "i"(OFF) : "memory"); return r;
}
template <int D0> __device__ __forceinline__ void pv_one(f32x16& od, int vb, bf16x8 pa0, bf16x8 pa1, bf16x8 pa2, bf16x8 pa3) {
    const s16x4 l0 = tr_read<v_rd_off(D0, 0, 0)>(vb), h0 = tr_read<v_rd_off(D0, 0, 1)>(vb), l1 = tr_read<v_rd_off(D0, 1, 0)>(vb), h1 = tr_read<v_rd_off(D0, 1, 1)>(vb);
    const s16x4 l2 = tr_read<v_rd_off(D0, 2, 0)>(vb), h2 = tr_read<v_rd_off(D0, 2, 1)>(vb), l3 = tr_read<v_rd_off(D0, 3, 0)>(vb), h3 = tr_read<v_rd_off(D0, 3, 1)>(vb);
    asm volatile("s_waitcnt lgkmcnt(0)" ::: "memory"); SBAR();
#define PK(L, H) (bf16x8){L[0], L[1], L[2], L[3], H[0], H[1], H[2], H[3]}
    od = __builtin_amdgcn_mfma_f32_32x32x16_bf16(pa0, PK(l0, h0), od, 0, 0, 0);
    od = __builtin_amdgcn_mfma_f32_32x32x16_bf16(pa1, PK(l1, h1), od, 0, 0, 0);
    od = __builtin_amdgcn_mfma_f32_32x32x16_bf16(pa2, PK(l2, h2), od, 0, 0, 0);
    od = __builtin_amdgcn_mfma_f32_32x32x16_bf16(pa3, PK(l3, h3), od, 0, 0, 0);
#undef PK
}
__device__ __forceinline__ void pv_d0(f32x16* o, int vb, bf16x8 pa0, bf16x8 pa1, bf16x8 pa2, bf16x8 pa3) {
    pv_one<0>(o[0], vb, pa0, pa1, pa2, pa3); pv_one<1>(o[1], vb, pa0, pa1, pa2, pa3); pv_one<2>(o[2], vb, pa0, pa1, pa2, pa3); pv_one<3>(o[3], vb, pa0, pa1, pa2, pa3);
}

__device__ __forceinline__ void attn_pass(const bf16* __restrict__ Qb, const bf16* __restrict__ Kh, const bf16* __restrict__ Vh, char* lds, f32x16 (&o)[4], float& l_out) {
    int tid_ = threadIdx.x; asm volatile("" : "+v"(tid_));
    const int tid = tid_, wid = tid >> 6, lane = tid & 63, r32 = lane & 31, hi = lane >> 5;
    char* V_lds = lds + OFF_V; char* K_lds = lds + OFF_K;
    float* ws = (float*)(lds + OFF_WS) + wid * 64; float* al_l = ws + 32;
    float m_reg = -1e30f, l_reg = 0.f; bf16x8 qr[4];
#pragma unroll
    for (int d = 0; d < 4; ++d) o[d] = f32x16{};
    const GAS bf16* Qw = (const GAS bf16*)Qb + (size_t)(wid * QBLK + r32) * LDQK + hi * 8;
#pragma unroll
    for (int d0 = 0; d0 < 4; ++d0) qr[d0] = *(const GAS bf16x8*)(Qw + d0 * 16);
    const int sr = tid >> 4, sc = (tid & 15) * 8, vst0 = v_st(sr, sc), vst1 = v_st(32 + sr, sc);
    const int kr = tid >> 3, kc = (tid & 7) * 16, kst = KSWZ(kr, kc);
    const int vb0 = (int)(uintptr_t)V_lds + v_rd_base(lane);
    const GAS bf16* Kg = (const GAS bf16*)Kh + (size_t)kr * LDQK + (tid & 7) * 8;
    const GAS bf16* Vg = (const GAS bf16*)Vh + (size_t)sr * LDV + sc;
    struct { bf16x8 vs0, vs1, ks0; } sr_[2];
#define SLOAD(i, k0) do { sr_[i].vs0 = *(const GAS bf16x8*)(Vg + (size_t)(k0) * LDV); sr_[i].vs1 = *(const GAS bf16x8*)(Vg + (size_t)((k0) + 32) * LDV); \
    sr_[i].ks0 = *(const GAS bf16x8*)(Kg + (size_t)(k0) * LDQK); } while (0)
#define SWRITE(b, i) do { *(bf16x8*)(V_lds + (b) * SHM_V + vst0) = sr_[i].vs0; *(bf16x8*)(V_lds + (b) * SHM_V + vst1) = sr_[i].vs1; \
    *(bf16x8*)(K_lds + (b) * SHM_K + kst) = sr_[i].ks0; } while (0)
#define SWAIT() asm volatile("s_waitcnt vmcnt(3)" ::: "memory")
#define RESC(a) do { if (__any((a) < 1.f)) { if (hi == 0) al_l[r32] = (a); asm volatile("s_waitcnt lgkmcnt(0)" ::: "memory"); \
    _Pragma("unroll") for (int d = 0; d < 4; ++d) _Pragma("unroll") for (int r = 0; r < 16; ++r) o[d][r] *= al_l[crow(r, hi)]; } } while (0)
    f32x16 pA0, pA1, pB0, pB1; float alA, alB; bf16x8 pa0, pa1, pa2, pa3; constexpr int NT = SEQ / KVBLK;
    constexpr int SE = 0, SO = 1;
    SLOAD(SE, 0); asm volatile("s_waitcnt vmcnt(0)" ::: "memory"); SWRITE(0, SE); __syncthreads();
    qkt(pA0, pA1, K_lds, qr, r32, hi); partialSM(pA0, pA1, m_reg, alA);
    SLOAD(SO, KVBLK); SLOAD(SE, 2 * KVBLK);
    SWAIT(); SWRITE(1, SO); __syncthreads();
    for (int j = 1; j + 1 < NT; j += 2) {
        SBAR(); qkt(pB0, pB1, K_lds + SHM_K, qr, r32, hi);
        finishSM(pA0, pA1, alA, l_reg, pa0, pa1, pa2, pa3); SBAR();
        SLOAD(SO, (j + 2) * KVBLK); SBAR();
        pv_d0(o, vb0, pa0, pa1, pa2, pa3); partialSM(pB0, pB1, m_reg, alB);
        __syncthreads(); SWAIT(); SWRITE(0, SE);
        RESC(alB); __syncthreads();
        SBAR(); qkt(pA0, pA1, K_lds, qr, r32, hi);
        finishSM(pB0, pB1, alB, l_reg, pa0, pa1, pa2, pa3); SBAR();
        if (j + 3 < NT) SLOAD(SE, (j + 3) * KVBLK); SBAR();
        pv_d0(o, vb0 + SHM_V, pa0, pa1, pa2, pa3); partialSM(pA0, pA1, m_reg, alA);
        __syncthreads(); SWAIT(); SWRITE(1, SO);
        RESC(alA); __syncthreads();
    }
    SBAR(); qkt(pB0, pB1, K_lds + SHM_K, qr, r32, hi);
    finishSM(pA0, pA1, alA, l_reg, pa0, pa1, pa2, pa3); SBAR();
    pv_d0(o, vb0, pa0, pa1, pa2, pa3); partialSM(pB0, pB1, m_reg, alB);
    __syncthreads(); RESC(alB);
    finishSM(pB0, pB1, alB, l_reg, pa0, pa1, pa2, pa3); SBAR();
    pv_d0(o, vb0 + SHM_V, pa0, pa1, pa2, pa3);
    l_out = l_reg;
    __syncthreads();
#undef SLOAD
#undef SWRITE
#undef SWAIT
#undef RESC
}

constexpr int F_OFF_WS = 4 * SHM_V + 4 * SHM_K;
template <int G> __device__ __forceinline__ void pv_rd(s16x4 (&lo)[4], s16x4 (&hh)[4], int vb) {
    lo[0] = tr_read<v_rd_off(G, 0, 0)>(vb); hh[0] = tr_read<v_rd_off(G, 0, 1)>(vb); lo[1] = tr_read<v_rd_off(G, 1, 0)>(vb); hh[1] = tr_read<v_rd_off(G, 1, 1)>(vb);
    lo[2] = tr_read<v_rd_off(G, 2, 0)>(vb); hh[2] = tr_read<v_rd_off(G, 2, 1)>(vb); lo[3] = tr_read<v_rd_off(G, 3, 0)>(vb); hh[3] = tr_read<v_rd_off(G, 3, 1)>(vb);
}
__device__ __forceinline__ void pv_mm(f32x16& od, const s16x4 (&lo)[4], const s16x4 (&hh)[4], bf16x8 pa0, bf16x8 pa1, bf16x8 pa2, bf16x8 pa3) {
#define PK(L, H) (bf16x8){L[0], L[1], L[2], L[3], H[0], H[1], H[2], H[3]}
    od = __builtin_amdgcn_mfma_f32_32x32x16_bf16(pa0, PK(lo[0], hh[0]), od, 0, 0, 0);
    od = __builtin_amdgcn_mfma_f32_32x32x16_bf16(pa1, PK(lo[1], hh[1]), od, 0, 0, 0);
    od = __builtin_amdgcn_mfma_f32_32x32x16_bf16(pa2, PK(lo[2], hh[2]), od, 0, 0, 0);
    od = __builtin_amdgcn_mfma_f32_32x32x16_bf16(pa3, PK(lo[3], hh[3]), od, 0, 0, 0);
#undef PK
}
template <int OFF> __device__ __forceinline__ bf16x8 lds_rd128(int addr) { bf16x8 r; asm volatile("ds_read_b128 %0, %1 offset:%2" : "=&v"(r) : "v"(addr), "i"(OFF) : "memory"); return r; }
__device__ __forceinline__ float fadd_s(float a, float b) { float r; asm("v_add_f32_e32 %0, %1, %2" : "=v"(r) : "v"(a), "v"(b)); return r; }
constexpr int F_NSLOT = 4;
constexpr int F2_OFF_V = 0, F2_OFF_K = F_NSLOT * SHM_V, F2_END = F2_OFF_K + F_NSLOT * SHM_K;
static_assert(F2_END <= F_OFF_WS, "attention rings below the per-wave scratch");
template <int ABL> __device__ __forceinline__ void attn_pass_fast(const bf16* __restrict__ Qb, const bf16* __restrict__ Kh, const bf16* __restrict__ Vh, char* lds, f32x16 (&o)[4], float& l_out) {
    int tid_ = threadIdx.x; asm volatile("" : "+v"(tid_));
    const int tid = tid_, wid = __builtin_amdgcn_readfirstlane(tid >> 6), lane = tid & 63, r32 = lane & 31, hi = lane >> 5; const bool trail = wid >= 4;
    LAS unsigned char* ldsl = (LAS unsigned char*)(unsigned)(uintptr_t)lds;
    bf16x8 qr[4];
#pragma unroll
    for (int d = 0; d < 4; ++d) o[d] = f32x16{};
    const GAS bf16* Qw = (const GAS bf16*)Qb + (size_t)(wid * QBLK + r32) * LDQK + hi * 8;
#pragma unroll
    for (int d0 = 0; d0 < 4; ++d0) qr[d0] = *(const GAS bf16x8*)(Qw + d0 * 16);
    const int krow = wid * 8 + (lane >> 3), kpos = lane & 7;
    const GAS bf16* Kg = (const GAS bf16*)Kh + (size_t)krow * LDQK + ((kpos ^ ((krow >> 1) & 7)) * 8);
    const int vsub0 = 4 * wid + (lane >> 5), vsub1 = vsub0 + 2;
    const int vkk0 = (vsub0 >> 2) * 8 + ((lane & 31) >> 2), vkk1 = (vsub1 >> 2) * 8 + ((lane & 31) >> 2);
    const GAS bf16* Vg0 = (const GAS bf16*)Vh + (size_t)vkk0 * LDV + (vsub0 & 3) * 32 + (lane & 3) * 8;
    const GAS bf16* Vg1 = (const GAS bf16*)Vh + (size_t)vkk1 * LDV + (vsub1 & 3) * 32 + (lane & 3) * 8;
    const int vb0 = (int)(unsigned)(uintptr_t)(lds + F2_OFF_V) + v_rd_base(lane);
    const int kbase = (int)(unsigned)(uintptr_t)(lds + F2_OFF_K);
    const int ka0 = kbase + KSWZ(r32, (0 * 16 + hi * 8) * 2), ka1 = kbase + KSWZ(r32, (1 * 16 + hi * 8) * 2), ka2 = kbase + KSWZ(r32, (2 * 16 + hi * 8) * 2), ka3 = kbase + KSWZ(r32, (3 * 16 + hi * 8) * 2);
    constexpr int NT = SEQ / KVBLK;
#define FBAR() do { asm volatile("s_waitcnt lgkmcnt(0)\n\ts_barrier" ::: "memory"); SBAR(); } while (0)
#define DMA_K(t, slot) __builtin_amdgcn_global_load_lds((const GAS unsigned*)(Kg + (size_t)(t) * KVBLK * LDQK), (LAS unsigned*)(ldsl + F2_OFF_K + (slot) * SHM_K + wid * 1024), 16, 0, 0)
#define DMA_V(t, slot) do { __builtin_amdgcn_global_load_lds((const GAS unsigned*)(Vg0 + (size_t)(t) * KVBLK * LDV), (LAS unsigned*)(ldsl + F2_OFF_V + (slot) * SHM_V + wid * 2048), 16, 0, 0); \
    __builtin_amdgcn_global_load_lds((const GAS unsigned*)(Vg1 + (size_t)(t) * KVBLK * LDV), (LAS unsigned*)(ldsl + F2_OFF_V + (slot) * SHM_V + wid * 2048 + 1024), 16, 0, 0); } while (0)
#define KREAD(kb) do { kf[0] = lds_rd128<0>(ka0 + (kb)); kf[1] = lds_rd128<4096>(ka0 + (kb)); kf[2] = lds_rd128<0>(ka1 + (kb)); kf[3] = lds_rd128<4096>(ka1 + (kb)); \
    kf[4] = lds_rd128<0>(ka2 + (kb)); kf[5] = lds_rd128<4096>(ka2 + (kb)); kf[6] = lds_rd128<0>(ka3 + (kb)); kf[7] = lds_rd128<4096>(ka3 + (kb)); } while (0)
#define QKT() do { p0 = __builtin_amdgcn_mfma_f32_32x32x16_bf16(kf[0], qr[0], f32x16{}, 0, 0, 0); p1 = __builtin_amdgcn_mfma_f32_32x32x16_bf16(kf[1], qr[0], f32x16{}, 0, 0, 0); \
    p0 = __builtin_amdgcn_mfma_f32_32x32x16_bf16(kf[2], qr[1], p0, 0, 0, 0); p1 = __builtin_amdgcn_mfma_f32_32x32x16_bf16(kf[3], qr[1], p1, 0, 0, 0); \
    p0 = __builtin_amdgcn_mfma_f32_32x32x16_bf16(kf[4], qr[2], p0, 0, 0, 0); p1 = __builtin_amdgcn_mfma_f32_32x32x16_bf16(kf[5], qr[2], p1, 0, 0, 0); \
    p0 = __builtin_amdgcn_mfma_f32_32x32x16_bf16(kf[6], qr[3], p0, 0, 0, 0); p1 = __builtin_amdgcn_mfma_f32_32x32x16_bf16(kf[7], qr[3], p1, 0, 0, 0); } while (0)
    bf16x8 kf[8];
    DMA_K(0, 0); DMA_K(1, 1); DMA_K(2, 2); DMA_V(0, 0); DMA_V(1, 1);
    asm volatile("s_waitcnt vmcnt(0)" ::: "memory");
    __syncthreads();
    if (trail) FBAR();
    f32x16 p0, p1; bf16x8 pa0, pa1, pa2, pa3; float l_reg = 0.f;
    KREAD(0); asm volatile("s_waitcnt lgkmcnt(0)" ::: "memory"); SBAR();
#define EXP8(P, B) do { _Pragma("unroll") for (int r_ = 0; r_ < 8; ++r_) P[(B) + r_] = __builtin_amdgcn_exp2f(P[(B) + r_]); } while (0)
    QKT();
    EXP8(p0, 0); EXP8(p0, 8); EXP8(p1, 0); EXP8(p1, 8);
    FBAR();
    int ks_w = 3, vs_w = 2;
    int kb_r = SHM_K, vb_r = 0;
    s16x4 la[4], ha[4], lb[4], hb[4];
#pragma unroll 1
    for (int x = 0; x < NT; ++x) {
        const int vb = vb0 + vb_r;
        if (x + 1 < NT) KREAD(kb_r);
        pv_rd<0>(la, ha, vb); pv_rd<1>(lb, hb, vb);
        if (x + 3 < NT) DMA_K(x + 3, ks_w);
        if (x + 2 < NT) DMA_V(x + 2, vs_w);
        { float a = fadd_s(p0[0], p0[1]), b = fadd_s(p0[2], p0[3]), c = fadd_s(p1[0], p1[1]), d = fadd_s(p1[2], p1[3]);
#pragma unroll
          for (int r = 4; r < 16; r += 4) { a = fadd_s(a, fadd_s(p0[r], p0[r + 1])); b = fadd_s(b, fadd_s(p0[r + 2], p0[r + 3])); c = fadd_s(c, fadd_s(p1[r], p1[r + 1])); d = fadd_s(d, fadd_s(p1[r + 2], p1[r + 3])); }
          l_reg = fadd_s(l_reg, fadd_s(fadd_s(a, b), fadd_s(c, d))); }
        { u32x4 w;
          w = (u32x4){cvtpk(p0[0], p0[1]), cvtpk(p0[2], p0[3]), cvtpk(p0[4], p0[5]), cvtpk(p0[6], p0[7])}; pa0 = __builtin_bit_cast(bf16x8, w);
          w = (u32x4){cvtpk(p0[8], p0[9]), cvtpk(p0[10], p0[11]), cvtpk(p0[12], p0[13]), cvtpk(p0[14], p0[15])}; pa1 = __builtin_bit_cast(bf16x8, w);
          w = (u32x4){cvtpk(p1[0], p1[1]), cvtpk(p1[2], p1[3]), cvtpk(p1[4], p1[5]), cvtpk(p1[6], p1[7])}; pa2 = __builtin_bit_cast(bf16x8, w);
          w = (u32x4){cvtpk(p1[8], p1[9]), cvtpk(p1[10], p1[11]), cvtpk(p1[12], p1[13]), cvtpk(p1[14], p1[15])}; pa3 = __builtin_bit_cast(bf16x8, w); }
        if (x + 3 < NT) asm volatile("s_waitcnt vmcnt(3)" ::: "memory"); else asm volatile("s_waitcnt vmcnt(0)" ::: "memory");
        FBAR();
        __builtin_amdgcn_s_setprio(2);
#define MIX4() do { _Pragma("unroll") for (int i_ = 0; i_ < 4; ++i_) { __builtin_amdgcn_sched_group_barrier(0x008, 1, 0); __builtin_amdgcn_sched_group_barrier(0x400, 2, 0); } } while (0)
        if (x + 1 < NT) QKT();
        SBAR();
        pv_mm(o[0], la, ha, pa0, pa1, pa2, pa3);
        EXP8(p0, 0);
        MIX4(); SBAR();
        pv_rd<2>(la, ha, vb);
        pv_mm(o[1], lb, hb, pa0, pa1, pa2, pa3);
        EXP8(p0, 8);
        MIX4(); SBAR();
        pv_rd<3>(lb, hb, vb);
        __builtin_amdgcn_s_setprio(0);
        asm volatile("s_waitcnt lgkmcnt(8)" ::: "memory"); SBAR();
        pv_mm(o[2], la, ha, pa0, pa1, pa2, pa3);
        EXP8(p1, 0);
        MIX4(); SBAR();
        asm volatile("s_waitcnt lgkmcnt(0)" ::: "memory"); SBAR();
        pv_mm(o[3], lb, hb, pa0, pa1, pa2, pa3);
        EXP8(p1, 8);
        MIX4(); SBAR();
#undef MIX4
        __builtin_amdgcn_s_setprio(0);
        ks_w = (ks_w + 1) & 3; vs_w = (vs_w + 1) & 3;
        kb_r = (kb_r + SHM_K) & (F_NSLOT * SHM_K - 1); vb_r = (vb_r + SHM_V) & (F_NSLOT * SHM_V - 1);
        FBAR();
    }
    if (!trail) FBAR();
    { auto rr = __builtin_amdgcn_permlane32_swap(__float_as_uint(l_reg), __float_as_uint(l_reg), false, false); l_reg = __uint_as_float(rr[0]) + __uint_as_float(rr[1]); }
    l_out = l_reg;
    __syncthreads();
#undef FBAR
#undef DMA_K
#undef DMA_V
#undef KREAD
#undef QKT
#undef EXP8
}

template <int ABL> __device__ __forceinline__ void attn_unit(int b, int h, int qb, const bf16* QH, const bf16* KH, const bf16* VH, bf16* YC, float* OS, const float* subg, float lam, float oscale, char* lds, bool fast) {
    int tid_ = threadIdx.x; asm volatile("" : "+v"(tid_));
    const int tid = tid_, wid = tid >> 6, lane = tid & 63, r32 = lane & 31, hi = lane >> 5;
    const size_t rowbase = (size_t)b * SEQ, q0 = rowbase + (size_t)qb * 256;
    float* wsf = (float*)(lds + F_OFF_WS) + wid * 64;
#pragma unroll 1
    for (int c = 0; c < 2; ++c) {
        f32x16 o[4]; float l;
        const size_t hcb = (size_t)((b * 16 + h * 2 + c)) * SEQ; const bf16* Qp = QH + (hcb + (size_t)qb * 256) * LDQK; const bf16* Kp = KH + hcb * LDQK; const bf16* Vp = VH + (size_t)(b * 8 + h) * SEQ * LDV;
        if (fast) attn_pass_fast<ABL>(Qp, Kp, Vp, lds, o, l);
        else attn_pass(Qp, Kp, Vp, lds, o, l);
        if (hi == 0) wsf[r32] = l; asm volatile("s_waitcnt lgkmcnt(0)" ::: "memory");
        float rli[16];
#pragma unroll
        for (int r = 0; r < 16; ++r) rli[r] = 1.0f / wsf[crow(r, hi)];
        GAS float* os = (GAS float*)OS + (q0 + wid * QBLK + 4 * hi) * GW + h * 128 + r32;
        asm volatile("" : "+v"(os));
        if (c == 0) {
#pragma unroll
            for (int r = 0; r < 16; ++r) { GAS float* p = os + ((r & 3) + 8 * (r >> 2)) * GW; asm volatile("" : "+v"(p));
#pragma unroll
                for (int d0 = 0; d0 < 4; ++d0) p[d0 * 32] = o[d0][r] * rli[r]; }
        } else {
            float ssq[16], ov[16][4];
#pragma unroll
            for (int r = 0; r < 16; ++r) { const GAS float* p = os + ((r & 3) + 8 * (r >> 2)) * GW; asm volatile("" : "+v"(p));
#pragma unroll
                for (int d0 = 0; d0 < 4; ++d0) ov[r][d0] = p[d0 * 32]; }
#pragma unroll
            for (int r = 0; r < 16; ++r) { float s = 0.f;
#pragma unroll
                for (int d0 = 0; d0 < 4; ++d0) { const float v = ov[r][d0] - lam * (o[d0][r] * rli[r]); o[d0][r] = v; s += v * v; }
                ssq[r] = s; }
#pragma unroll
            for (int r = 0; r < 16; ++r) { float s = ssq[r]; s += __shfl_xor(s, 1); s += __shfl_xor(s, 2); s += __shfl_xor(s, 4); s += __shfl_xor(s, 8); s += __shfl_xor(s, 16);
                ssq[r] = oscale / sqrtf(s * (1.f / 128.f) + 1e-6f); }
            GAS bf16* yo = (GAS bf16*)YC + (q0 + wid * QBLK + 4 * hi) * DM + YC_D + h * 128 + r32;
            asm volatile("" : "+v"(yo));
#pragma unroll
            for (int r = 0; r < 16; ++r) { GAS bf16* p = yo + ((r & 3) + 8 * (r >> 2)) * DM; asm volatile("" : "+v"(p));
#pragma unroll
                for (int d0 = 0; d0 < 4; ++d0) p[d0 * 32] = (bf16)f2bf(o[d0][r] * ssq[r] * subg[d0 * 32 + r32]); }
        }
        asm volatile("s_waitcnt vmcnt(0) lgkmcnt(0)" ::: "memory");
    }
}
#undef KSWZ
#undef SBAR
}

__global__ void __launch_bounds__(NWAVES * 64, 2) hybrid_fwd(Args args) {
    extern __shared__ __attribute__((aligned(16))) unsigned char lds[];
    Frame F;
    F.lds = (LAS unsigned char*)lds;
    F.MISC = (volatile LAS unsigned*)(F.lds + MISC_OFF);
    F.tid = threadIdx.x; F.lane = F.tid & 63; F.wave = __builtin_amdgcn_readfirstlane(F.tid >> 6);
    F.G = gridDim.x; { const int bx = blockIdx.x; F.vcu = (F.G % 8 == 0) ? (bx % 8) * (F.G / 8) + bx / 8 : bx; }
    unsigned char* ws = args.ws;
    F.ctl = (gu32*)(ws + WS_CTL);
    for (int u = F.tid; u < (LDS_BYTES - LDSCTL_OFF) / 4; u += NWAVES * 64) ((LAS unsigned*)(F.lds + LDSCTL_OFF))[u] = 0u;
    __syncthreads();
#if MK_SPLIT
#define GRID_BAR() do { } while (0)
#else
    XcdBarrier bar = xcd_barrier_post((unsigned*)(F.ctl + CW_BAR), F.MISC + 8);
#define GRID_BAR() xcd_barrier(bar)
#endif
    const int lo = args.ph_lo, hi = args.ph_hi;
#ifndef PH_MASK
#define PH_MASK 0x1FF
#endif
#define IN(k) (lo <= (k) && (k) < hi)
#define PM(b) ((PH_MASK >> (b)) & 1)
#ifndef LM
#define LM 15
#endif
#ifndef PROBE_DUP
#define PROBE_DUP 0
#endif
#define DUP(b) ((PROBE_DUP >> (b)) & 1)
#ifndef PROBE_XBAR
#define PROBE_XBAR 0
#endif
#define SEAM(k, DS, NS) do { if ((k) + 1 < hi) { seam_steal(F, args, bar, (DS), (NS)); for (int xb_ = 0; xb_ < PROBE_XBAR; ++xb_) GRID_BAR(); } } while (0)

    bf16* const XN = (bf16*)(ws + WS_XN); bf16* const Z = (bf16*)(ws + WS_Z); bf16* const YC = (bf16*)(ws + WS_YC); bf16* const HB = (bf16*)(ws + WS_HB);
    float* const OS = (float*)(ws + WS_OS); const float* const rope = (const float*)(ws + WS_ROPE);
    const float* const x_in = args.in[0]; float* const out = args.out;

    bf16* const XB = XN; float* const SS = (float*)(ws + WS_SS);
    if (PM(8) && IN(0)) { p0_prologue(F, args); xprep_phase(F, x_in, XB, SS); if (DUP(8)) { p0_prologue(F, args); xprep_phase(F, x_in, XB, SS); } SEAM(0, -1, 0); }

#define FRESH() do { int t_ = threadIdx.x; asm volatile("" : "+v"(t_)); F.tid = t_; F.lane = t_ & 63; F.wave = __builtin_amdgcn_readfirstlane(t_ >> 6); } while (0)
    for (int l = 0; l < NLAYER; ++l) {
        const int pb = 1 + 5 * l;
        const float* xcur = (l == 0) ? x_in : out;
        const LAS float* rstab = (const LAS float*)(F.lds + RSTAB_OFF);
        if (PM(0) && IN(pb + 0)) { FRESH();
            pg8::Gemm g{XB, (const bf16*)(ws + WS_WIN) + (size_t)l * DIN * DM, M, DIN, DM}; pg8::StaticOrder S; S.init(M, DIN, F.G, (int)blockIdx.x);
            { pg8::Unit u0; S.next(0, u0); rs_table(F, SS, u0.pm); }
            pg8::EpiZ E{Z, DIN, rstab, (float*)(ws + WS_SV), args.in[13] + l * 64, args.in[14] + l * 64, rope, QSCALE, SEQ - 1, 13, (bf16*)(ws + WS_QH), (bf16*)(ws + WS_KH), (bf16*)(ws + WS_VH)};
            pg8::gemm_phase<pg8::EpiZ, pg8::StaticOrder, true, true>(F.lds + RING_OFF, g, S, E);
            if (DUP(0)) pg8::gemm_phase<pg8::EpiZ, pg8::StaticOrder, true, true>(F.lds + RING_OFF, g, S, E);
            SEAM(pb + 0, -1, 4 * l);
        }
        if (PM(2) && IN(pb + 1)) { FRESH();
            float s1 = 0.f, s2 = 0.f;
            for (int i = 0; i < 64; ++i) { s1 += args.in[15][l * 64 + i] * args.in[16][l * 64 + i]; s2 += args.in[17][l * 64 + i] * args.in[18][l * 64 + i]; }
            const float lam_init = (l == 0) ? 0.2f : 0.35550907f;
            const float lam = expf(s1) - expf(s2) + lam_init;
            float gqm = 0.f, gkm = 0.f;
            for (int i = 0; i < 64; ++i) { gqm = fmaxf(gqm, fabsf(args.in[13][l * 64 + i])); gkm = fmaxf(gkm, fabsf(args.in[14][l * 64 + i])); }
            const bool fastsm = (64.0f * gqm * gkm * QSCALE * 1.02f) < 40.0f;
#ifndef ATT_ABL
#define ATT_ABL 0
#endif
            if (DUP(2)) for (int U = F.vcu; U < BATCH * 8 * (SEQ / 256); U += F.G) {
                const int xg = (U % 256) / 32, i = U / 256, qb = U % 32, bh = xg * 2 + i;
                att::attn_unit<ATT_ABL>(bh >> 3, bh & 7, qb, (const bf16*)(ws + WS_QH), (const bf16*)(ws + WS_KH), (const bf16*)(ws + WS_VH), HB, (float*)(ws + WS_HB + 256 * MiB), args.in[19] + l * 128, lam, 1.0f - lam_init, (char*)lds + RING_OFF, fastsm);
            }
            for (int U = F.vcu; U < BATCH * 8 * (SEQ / 256); U += F.G) {
                const int xg = (U % 256) / 32, i = U / 256, qb = U % 32, bh = xg * 2 + i;
                att::attn_unit<0>(bh >> 3, bh & 7, qb, (const bf16*)(ws + WS_QH), (const bf16*)(ws + WS_KH), (const bf16*)(ws + WS_VH), YC, OS, args.in[19] + l * 128, lam, 1.0f - lam_init, (char*)lds + RING_OFF, fastsm);
            }
        }
        if (PM(1) && IN(pb + 1)) { FRESH();
            for (int rep = 0; rep < 1 + DUP(1); ++rep) { FRESH();
            if (LM & 2) for (int u = F.vcu; u < (M / 128) * 4; u += F.G) gmlp_unit(F, Z, YC, (const float*)(ws + WS_SV), (const bf16*)(ws + WS_GWS) + (size_t)l * 8 * 128 * 128, args.in[6] + l * 8 * 128, args.in[3] + l * GW, args.in[4] + l * GW, u, (char*)lds);
            FRESH();
            if (LM & 4) for (int u = F.vcu; u < M / 32; u += F.G) conv_unit(F, Z, YC, args.in[7] + (size_t)l * 31 * GW, args.in[8] + l * GW, args.in[9] + l * GW, args.in[10] + l * GW, u);
            FRESH();
            if (LM & 8) for (int u = F.vcu; u < (M / 64) * 4; u += F.G) pool_unit(F, Z, YC, (const bf16*)(ws + WS_PWT) + (size_t)l * 4 * 65536, args.in[12] + l * GW, u);
            }
            SEAM(pb + 1, 4 * l, 4 * l + 1);
        }
        if (PM(3) && IN(pb + 2)) { FRESH();
            pg8::Gemm g{YC, (const bf16*)(ws + WS_WOUT) + (size_t)l * DM * DM, M, DM, DM}; pg8::StaticOrder S; S.init(M, DM, F.G, (int)blockIdx.x);
            if (l == 0) { typedef pg8::EpiRes<false, false> E_t; E_t E{x_in, nullptr, DM, XB, SS};
                if (DUP(3)) { E_t E2{x_in, nullptr, DM, HB, OS}; pg8::gemm_phase<E_t, pg8::StaticOrder, true, true>(F.lds + RING_OFF, g, S, E2); }
                pg8::gemm_phase<E_t, pg8::StaticOrder, true, true>(F.lds + RING_OFF, g, S, E); }
            else { typedef pg8::EpiRes<true, false> E_t; E_t E{XB, nullptr, DM, XB, SS};
                if (DUP(3)) { E_t E2{XB, nullptr, DM, HB, OS}; pg8::gemm_phase<E_t, pg8::StaticOrder, true, true>(F.lds + RING_OFF, g, S, E2); }
                pg8::gemm_phase<E_t, pg8::StaticOrder, true, true>(F.lds + RING_OFF, g, S, E); }
            SEAM(pb + 2, 4 * l + 1, 4 * l + 2);
        }
        if (PM(4) && IN(pb + 3)) { FRESH();
            pg8::Gemm g{XB, (const bf16*)(ws + WS_WUP) + (size_t)l * DFF * DM, M, DFF, DM}; pg8::StaticOrder S; S.init(M, DFF, F.G, (int)blockIdx.x);
            { pg8::Unit u0; S.next(0, u0); rs_table(F, SS, u0.pm); }
            pg8::EpiRelu2 E{HB, DFF, rstab};
#ifdef PROBE_SPLIT_UP
            { pg8::StaticOrder S1 = S; S1.i1 = 8; pg8::gemm_phase<pg8::EpiRelu2, pg8::StaticOrder, true, true>(F.lds + RING_OFF, g, S1, E); GRID_BAR();
              pg8::StaticOrder S2 = S; S2.i0 = 8; pg8::gemm_phase<pg8::EpiRelu2, pg8::StaticOrder, true, true>(F.lds + RING_OFF, g, S2, E); }
#else
            pg8::gemm_phase<pg8::EpiRelu2, pg8::StaticOrder, true, true>(F.lds + RING_OFF, g, S, E);
#endif
            if (DUP(4)) { if (DUP(10)) { pg8::EpiRelu2T<true> E2{(bf16*)Z, DFF, rstab}; pg8::gemm_phase<pg8::EpiRelu2T<true>, pg8::StaticOrder, true, true>(F.lds + RING_OFF, g, S, E2); }
                          else pg8::gemm_phase<pg8::EpiRelu2, pg8::StaticOrder, true, true>(F.lds + RING_OFF, g, S, E); }
            SEAM(pb + 3, 4 * l + 2, (4 * l + 3 <= 6) ? 4 * l + 3 : -1);
        }
        if (PM(5) && IN(pb + 4)) { FRESH();
            pg8::Gemm g{HB, (const bf16*)(ws + WS_WDN) + (size_t)l * DM * DFF, M, DM, DFF}; pg8::StaticOrder S; S.init(M, DM, F.G, (int)blockIdx.x);
            if (l + 1 < NLAYER) { typedef pg8::EpiRes<true, false> E_t; E_t E{XB, nullptr, DM, XB, SS};
                if (DUP(5)) { E_t E2{XB, nullptr, DM, YC, OS}; pg8::gemm_phase<E_t, pg8::StaticOrder, true, true>(F.lds + RING_OFF, g, S, E2); }
                pg8::gemm_phase<E_t, pg8::StaticOrder, true, true>(F.lds + RING_OFF, g, S, E); }
            else { typedef pg8::EpiRes<true, true> E_t; E_t E{XB, out, DM, nullptr, nullptr};
                if (DUP(5)) { E_t E2{XB, (float*)Z, DM, nullptr, nullptr}; pg8::gemm_phase<E_t, pg8::StaticOrder, true, true>(F.lds + RING_OFF, g, S, E2); }
                pg8::gemm_phase<E_t, pg8::StaticOrder, true, true>(F.lds + RING_OFF, g, S, E); }
            SEAM(pb + 4, 4 * l + 3, 4 * l + 4);
        }
    }
#ifdef DIAG_STEAL
    if (blockIdx.x == 0 && threadIdx.x == 0) { asm volatile("s_waitcnt vmcnt(0)" ::: "memory"); const unsigned cnt = xb_ld((unsigned*)(F.ctl + CW_Q + 1024)); out[0] = 1000.0f * (float)cnt / (float)CV_TOTAL; }
#endif
#undef IN
#undef SEAM
}

constexpr int N_PHASES = 1 + 5 * NLAYER;
extern "C" void kernel_launch(void* const* d_in, const int* in_sizes, int n_in, void* d_out, int out_size, void* d_ws, size_t ws_size, hipStream_t stream) {
    static int grid = 0;
    if (grid == 0) {
        if (n_in != 24 || in_sizes[0] != M * DM || out_size != M * DM || ws_size < WS_END) { fprintf(stderr, "kernel_launch: unexpected shapes (n_in %d, in0 %d, out %d, ws %zu; need ws >= %zu); nothing launched\n", n_in, n_in > 0 ? in_sizes[0] : -1, out_size, ws_size, (size_t)WS_END); grid = -1; return; }
        int dev = 0, cus = 0, per_cu = 0;
        if (hipGetDevice(&dev) != hipSuccess || hipDeviceGetAttribute(&cus, hipDeviceAttributeMultiprocessorCount, dev) != hipSuccess) { fprintf(stderr, "kernel_launch: device query failed\n"); grid = -1; return; }
        if (hipFuncSetAttribute((const void*)hybrid_fwd, hipFuncAttributeMaxDynamicSharedMemorySize, LDS_BYTES) != hipSuccess) { fprintf(stderr, "kernel_launch: hipFuncSetAttribute failed\n"); grid = -1; return; }
        if (hipOccupancyMaxActiveBlocksPerMultiprocessor(&per_cu, (const void*)hybrid_fwd, NWAVES * 64, LDS_BYTES) != hipSuccess || per_cu < 1)
            fprintf(stderr, "kernel_launch: note: occupancy query reports %d workgroups per CU\n", per_cu);
        (void)hipGetLastError();
        grid = cus;
        if (grid != 256) { fprintf(stderr, "kernel_launch: built for a 256-CU device (one row panel per workgroup in every GEMM phase); found %d CUs; nothing launched\n", cus); grid = -1; return; }
    }
    if (grid < 0) return;
    if (hipMemsetAsync((char*)d_ws + WS_CTL, 0, CTL_ZERO_BYTES, stream) != hipSuccess) { fprintf(stderr, "kernel_launch: memset failed\n"); return; }
    Args a{};
    for (int i = 0; i < 24; ++i) a.in[i] = (const float*)d_in[i];
    a.out = (float*)d_out; a.ws = (unsigned char*)d_ws;
#if MK_SPLIT
    for (int p = 0; p < N_PHASES; ++p) { a.ph_lo = p; a.ph_hi = p + 1; hipLaunchKernelGGL(hybrid_fwd, dim3(grid), dim3(NWAVES * 64), LDS_BYTES, stream, a); }
#else
    a.ph_lo = 0; a.ph_hi = N_PHASES; hipLaunchKernelGGL(hybrid_fwd, dim3(grid), dim3(NWAVES * 64), LDS_BYTES, stream, a);
#endif
    const hipError_t le = hipPeekAtLastError();
    if (le != hipSuccess) fprintf(stderr, "kernel_launch: launch failed: %s\n", hipGetErrorName(le));
}
```

```cpp
#include <hip/hip_runtime.h>
#include <cstdio>
#include <cstdint>
#include <type_traits>
namespace pg8 {
#define PG8_LAS __attribute__((address_space(3)))
typedef unsigned short bf16_t;
typedef short bf16x8 __attribute__((ext_vector_type(8)));
typedef float f32x4 __attribute__((ext_vector_type(4)));
typedef unsigned u32x4 __attribute__((ext_vector_type(4)));
constexpr int BM = 256, BK = 64, HALF = 128, HTB = HALF * BK * 2  , STAGE_BYTES = 8 * HTB, NXCD = 8, WGM = 8;

__host__ __device__ __forceinline__ int lds_byte(int r, int c) { const int st = (r >> 4) * 2 + (c >> 5), rr = r & 15, cc = c & 31, ob = rr * 64 + cc * 2; return st * 1024 + (ob ^ (((ob >> 9) & 1) << 5)); }
__host__ __device__ __forceinline__ void stage_rc(int b, int& R, int& C) { const int st = b / 1024, sb = b % 1024, swz = sb ^ (((sb >> 9) & 1) << 5); R = (st >> 1) * 16 + swz / 64; C = (st & 1) * 32 + (swz % 64) / 2; }
__host__ __device__ __forceinline__ int perm32(int rho) { const int n = rho >> 4, i = rho & 15; return 8 * (i >> 2) + 4 * n + (i & 3); }

struct Unit { int pm, pn; };
struct Gemm { const bf16_t* A; const bf16_t* Bt; int M, N, K; };

struct StaticOrder {
    int nM, nN, nwg, G, c, i0 = 0, i1 = 1 << 30;
    __host__ __device__ __forceinline__ void init(int M, int N, int G_, int c_) { nM = M / BM; nN = N / BM; nwg = nM * nN; G = G_; c = c_; }
    __host__ __device__ __forceinline__ bool next(int i_, Unit& u) const {
        const int i = i_ + i0; if (i >= i1) return false;
        const long L = (long)i * G + c; if (L >= nwg) return false;
        int wgid = (int)L; { const int q = nwg / NXCD, r = nwg % NXCD, xcd = wgid % NXCD, off = wgid / NXCD; wgid = (xcd < r ? xcd * (q + 1) : r * (q + 1) + (xcd - r) * q) + off; }
        const int nig = WGM * nN, gid = wgid / nig, fm = gid * WGM, gsz = (nM - fm) < WGM ? (nM - fm) : WGM;
        u.pm = fm + ((wgid % nig) % gsz); u.pn = (wgid % nig) / gsz; return true;
    }
    __device__ __forceinline__ void a_ready(const Unit&) const {}
    __device__ __forceinline__ void done(const Unit&) const {}
};

__device__ __forceinline__ unsigned cvt_pk_bf16(float lo, float hi) { unsigned r; asm volatile("v_cvt_pk_bf16_f32 %0, %1, %2" : "=v"(r) : "v"(lo), "v"(hi)); return r; }
typedef float f32x2 __attribute__((ext_vector_type(2)));
__device__ __forceinline__ f32x2 gelu_pk(f32x2 v) {
    const f32x2 av = __builtin_elementwise_abs(v), d = av * 0.2316418882f + 1.0f;
    f32x2 t; t.x = __builtin_amdgcn_rcpf(d.x); t.y = __builtin_amdgcn_rcpf(d.y);
    f32x2 q = t * 0.5307027145f + (-0.7265760135f); q = q * t + 0.7107068705f; q = q * t + (-0.142248368f); q = q * t + 0.127414796f; q = q * t;
    const f32x2 s = (v * v) * (-0.72134752044f);
    f32x2 e; e.x = __builtin_amdgcn_exp2f(s.x); e.y = __builtin_amdgcn_exp2f(s.y);
    const f32x2 m = v * (q * e), r = v - m;
    f32x2 o; o.x = v.x < 0.f ? m.x : r.x; o.y = v.y < 0.f ? m.y : r.y; return o;
}

template <int ACT  > struct EpiBf16 {
    static constexpr bool PERM = true, AFTER_DRAIN = false; static_assert(ACT == 0 || ACT == 1, "EpiBf16: ACT is 0 (none) or 1 (gelu_pk)");
    bf16_t* O; int ldc; const float* bias; int split_cols; size_t split_stride; float scale0;
    __device__ __forceinline__ void operator()(const f32x4 (&acc)[2][2][4][2], const Unit& u, int wr, int wc, int fr, int fq) const {
        const int row0 = u.pm * BM + wr * 64 + fr; int colt = u.pn * BM; bf16_t* base = O;
        float sc = 1.f; if (split_cols) { const int t = colt / split_cols; base += (size_t)t * split_stride; colt -= t * split_cols; if (t == 0) sc = scale0; }
        const int col0 = colt + wc * 32 + 8 * fq, bcol0 = u.pn * BM + wc * 32 + 8 * fq;
        f32x4 bv[2][2];
#pragma unroll
        for (int bj = 0; bj < 2; ++bj)
#pragma unroll
            for (int n = 0; n < 2; ++n) bv[bj][n] = bias ? *(const f32x4*)(bias + bcol0 + bj * HALF + 4 * n) : (f32x4){0.f, 0.f, 0.f, 0.f};
#pragma unroll
        for (int ai = 0; ai < 2; ++ai)
#pragma unroll
            for (int m = 0; m < 4; ++m) { bf16_t* rowp = base + (size_t)(row0 + ai * HALF + m * 16) * ldc + col0;
#pragma unroll
                for (int bj = 0; bj < 2; ++bj) { f32x4 v0 = acc[ai][bj][m][0] + bv[bj][0], v1 = acc[ai][bj][m][1] + bv[bj][1];
                    if (ACT == 1) { f32x2 a = gelu_pk((f32x2){v0[0], v0[1]}), b = gelu_pk((f32x2){v0[2], v0[3]}), c = gelu_pk((f32x2){v1[0], v1[1]}), d = gelu_pk((f32x2){v1[2], v1[3]});
                        v0 = (f32x4){a.x, a.y, b.x, b.y}; v1 = (f32x4){c.x, c.y, d.x, d.y}; }
                    v0 = v0 * sc; v1 = v1 * sc; u32x4 w; w.x = cvt_pk_bf16(v0[0], v0[1]); w.y = cvt_pk_bf16(v0[2], v0[3]); w.z = cvt_pk_bf16(v1[0], v1[1]); w.w = cvt_pk_bf16(v1[2], v1[3]);
                    *(u32x4*)(rowp + bj * HALF) = w; } }
    }
};

struct EpiZ {
    static constexpr bool PERM = true, AFTER_DRAIN = false;
    bf16_t* O; int ldc; const PG8_LAS float* rs; float* sv; const float* qg; const float* kg; const float* rope; float qscale; int seqmask, seqshift; bf16_t* qh; bf16_t* kh; bf16_t* vh;
    __device__ __forceinline__ void operator()(const f32x4 (&acc)[2][2][4][2], const Unit& u, int wr, int wc, int fr, int fq) const {
        const int pn = u.pn, row0 = u.pm * BM + wr * 64 + fr;
        if (pn < 8) {
            const int col0 = pn * BM + wc * 32 + 8 * fq; const bool st = pn >= 4;
#pragma unroll
            for (int ai = 0; ai < 2; ++ai)
#pragma unroll
                for (int m = 0; m < 4; ++m) { const int row = row0 + ai * HALF + m * 16; bf16_t* rowp = O + (size_t)row * ldc + col0; const float rsv = rs[ai * HALF + wr * 64 + m * 16 + fr]; float s1 = 0.f, s2 = 0.f;
#pragma unroll
                    for (int bj = 0; bj < 2; ++bj) { f32x4 v0 = acc[ai][bj][m][0] * rsv, v1 = acc[ai][bj][m][1] * rsv;
                        { f32x2 a = gelu_pk((f32x2){v0[0], v0[1]}), b = gelu_pk((f32x2){v0[2], v0[3]}), c = gelu_pk((f32x2){v1[0], v1[1]}), d = gelu_pk((f32x2){v1[2], v1[3]});
                          v0 = (f32x4){a.x, a.y, b.x, b.y}; v1 = (f32x4){c.x, c.y, d.x, d.y}; }
                        s1 += ((v0[0] + v0[1]) + (v0[2] + v0[3])) + ((v1[0] + v1[1]) + (v1[2] + v1[3]));
                        s2 += ((v0[0] * v0[0] + v0[1] * v0[1]) + (v0[2] * v0[2] + v0[3] * v0[3])) + ((v1[0] * v1[0] + v1[1] * v1[1]) + (v1[2] * v1[2] + v1[3] * v1[3]));
                        u32x4 w; w.x = cvt_pk_bf16(v0[0], v0[1]); w.y = cvt_pk_bf16(v0[2], v0[3]); w.z = cvt_pk_bf16(v1[0], v1[1]); w.w = cvt_pk_bf16(v1[2], v1[3]);
                        *(u32x4*)(rowp + bj * HALF) = w; }
                    if (st) { s1 += __shfl_xor(s1, 16); s2 += __shfl_xor(s2, 16); s1 += __shfl_xor(s1, 32); s2 += __shfl_xor(s2, 32);
                        if (fq == 0) *(f32x2*)(sv + ((size_t)row * 16 + (pn - 4) * 4 + wc) * 2) = (f32x2){s1, s2}; } }
        } else if (pn < 16) {
            const int col0 = 2048 + (pn - 8) * HALF + wc * 32 + 8 * fq;
#pragma unroll
            for (int ai = 0; ai < 2; ++ai)
#pragma unroll
                for (int m = 0; m < 4; ++m) { bf16_t* rowp = O + (size_t)(row0 + ai * HALF + m * 16) * ldc + col0; const float rsv = rs[ai * HALF + wr * 64 + m * 16 + fr], nrs = -1.4426950408889634f * rsv;
                    float h[8];
#pragma unroll
                    for (int n = 0; n < 2; ++n)
#pragma unroll
                        for (int e = 0; e < 4; ++e) h[n * 4 + e] = acc[ai][0][m][n][e] * rsv * __builtin_amdgcn_rcpf(1.0f + __builtin_amdgcn_exp2f(acc[ai][1][m][n][e] * nrs));
                    u32x4 w; w.x = cvt_pk_bf16(h[0], h[1]); w.y = cvt_pk_bf16(h[2], h[3]); w.z = cvt_pk_bf16(h[4], h[5]); w.w = cvt_pk_bf16(h[6], h[7]);
                    *(u32x4*)rowp = w; }
        } else if (pn < 20) {
            const int col0 = pn * BM + wc * 32 + 8 * fq;
#pragma unroll
            for (int ai = 0; ai < 2; ++ai)
#pragma unroll
                for (int m = 0; m < 4; ++m) { bf16_t* rowp = O + (size_t)(row0 + ai * HALF + m * 16) * ldc + col0; const float rsv = rs[ai * HALF + wr * 64 + m * 16 + fr];
#pragma unroll
                    for (int bj = 0; bj < 2; ++bj) { const f32x4 v0 = acc[ai][bj][m][0] * rsv, v1 = acc[ai][bj][m][1] * rsv;
                        u32x4 w; w.x = cvt_pk_bf16(v0[0], v0[1]); w.y = cvt_pk_bf16(v0[2], v0[3]); w.z = cvt_pk_bf16(v1[0], v1[1]); w.w = cvt_pk_bf16(v1[2], v1[3]);
                        *(u32x4*)(rowp + bj * HALF) = w; } }
        } else if (pn >= 28) {
#pragma unroll
            for (int ai = 0; ai < 2; ++ai)
#pragma unroll
                for (int m = 0; m < 4; ++m) { const int row = row0 + ai * HALF + m * 16, b = row >> seqshift, t = row & seqmask; const float rsv = rs[ai * HALF + wr * 64 + m * 16 + fr];
#pragma unroll
                    for (int bj = 0; bj < 2; ++bj) { const f32x4 v0 = acc[ai][bj][m][0] * rsv, v1 = acc[ai][bj][m][1] * rsv;
                        u32x4 w; w.x = cvt_pk_bf16(v0[0], v0[1]); w.y = cvt_pk_bf16(v0[2], v0[3]); w.z = cvt_pk_bf16(v1[0], v1[1]); w.w = cvt_pk_bf16(v1[2], v1[3]);
                        *(u32x4*)(vh + ((size_t)((b * 8 + (pn - 28) * 2 + bj)) << seqshift | (size_t)t) * 128 + wc * 32 + 8 * fq) = w; } }
        } else {
            const bool isq = pn < 24; const int hc = (pn - (isq ? 20 : 24)) * 4 + wc; bf16_t* const dst = isq ? qh : kh;
            const float* gp = isq ? qg : kg; const float sc = isq ? qscale : 1.0f;
            f32x4 g[2][2];
#pragma unroll
            for (int n = 0; n < 2; ++n) { g[0][n] = *(const f32x4*)(gp + (fq < 2 ? 4 * fq + 8 * n : 8 * fq + 4 * n)) * sc; g[1][n] = *(const f32x4*)(gp + 32 + 8 * fq + 4 * n) * sc; }
#pragma unroll
            for (int ai = 0; ai < 2; ++ai)
#pragma unroll
                for (int m = 0; m < 4; ++m) { const int row = row0 + ai * HALF + m * 16; bf16_t* rowp = dst + (((size_t)((row >> seqshift) * 16 + hc)) << seqshift | (size_t)(row & seqmask)) * 64 + 8 * fq; const float rsv = rs[ai * HALF + wr * 64 + m * 16 + fr];
                    f32x4 v[2][2]; float s = 0.f;
#pragma unroll
                    for (int bj = 0; bj < 2; ++bj)
#pragma unroll
                        for (int n = 0; n < 2; ++n) { v[bj][n] = acc[ai][bj][m][n] * rsv; s += (v[bj][n][0] * v[bj][n][0] + v[bj][n][1] * v[bj][n][1]) + (v[bj][n][2] * v[bj][n][2] + v[bj][n][3] * v[bj][n][3]); }
                    s += __shfl_xor(s, 16); s += __shfl_xor(s, 32);
                    const float rn = 1.0f / sqrtf(s * (1.f / 64.f) + 1e-6f);
#pragma unroll
                    for (int bj = 0; bj < 2; ++bj)
#pragma unroll
                        for (int n = 0; n < 2; ++n) v[bj][n] = v[bj][n] * rn * g[bj][n];
                    if (fq < 2) {
                        const float* rp = rope + (size_t)(row & seqmask) * 16 + fq * 8; const f32x4 cs0 = *(const f32x4*)rp, cs1 = *(const f32x4*)(rp + 4);
                        const f32x4 x1 = v[0][0], x2 = v[0][1]; const f32x4 cc = (f32x4){cs0[0], cs0[2], cs1[0], cs1[2]}, sn = (f32x4){cs0[1], cs0[3], cs1[1], cs1[3]};
                        v[0][0] = x1 * cc - x2 * sn; v[0][1] = x2 * cc + x1 * sn; }
#pragma unroll
                    for (int bj = 0; bj < 2; ++bj) { u32x4 w; w.x = cvt_pk_bf16(v[bj][0][0], v[bj][0][1]); w.y = cvt_pk_bf16(v[bj][0][2], v[bj][0][3]); w.z = cvt_pk_bf16(v[bj][1][0], v[bj][1][1]); w.w = cvt_pk_bf16(v[bj][1][2], v[bj][1][3]);
                        *(u32x4*)(rowp + bj * 32) = w; } }
        }
    }
};
template <bool NOSTORE = false> struct EpiRelu2T {
    static constexpr bool PERM = true, AFTER_DRAIN = false;
    bf16_t* O; int ldc; const PG8_LAS float* rs;
    __device__ __forceinline__ void operator()(const f32x4 (&acc)[2][2][4][2], const Unit& u, int wr, int wc, int fr, int fq) const {
        const int row0 = u.pm * BM + wr * 64 + fr; const int col0 = u.pn * BM + wc * 32 + 8 * fq;
#pragma unroll
        for (int ai = 0; ai < 2; ++ai)
#pragma unroll
            for (int m = 0; m < 4; ++m) { bf16_t* rowp = O + (size_t)(row0 + ai * HALF + m * 16) * ldc + col0; const float rsv = rs[ai * HALF + wr * 64 + m * 16 + fr];
#pragma unroll
                for (int bj = 0; bj < 2; ++bj) { f32x4 v0 = acc[ai][bj][m][0] * rsv, v1 = acc[ai][bj][m][1] * rsv;
                    v0 = __builtin_elementwise_max(v0, (f32x4){0.f, 0.f, 0.f, 0.f}); v1 = __builtin_elementwise_max(v1, (f32x4){0.f, 0.f, 0.f, 0.f}); v0 = v0 * v0; v1 = v1 * v1;
                    u32x4 w; w.x = cvt_pk_bf16(v0[0], v0[1]); w.y = cvt_pk_bf16(v0[2], v0[3]); w.z = cvt_pk_bf16(v1[0], v1[1]); w.w = cvt_pk_bf16(v1[2], v1[3]);
                    if (!NOSTORE || w.x == 0x12345678u) *(u32x4*)(rowp + bj * HALF) = w; } }
    }
};
typedef EpiRelu2T<false> EpiRelu2;
template <bool BASE_BF16, bool OUT_F32> struct EpiRes {
    static constexpr bool PERM = true, AFTER_DRAIN = false;
    const void* base; float* out; int ldc; bf16_t* xb; float* ss;
    __device__ __forceinline__ void operator()(const f32x4 (&acc)[2][2][4][2], const Unit& u, int wr, int wc, int fr, int fq) const {
        const int row0 = u.pm * BM + wr * 64 + fr, col0 = u.pn * BM + wc * 32 + 8 * fq;
        if constexpr (BASE_BF16) {
            u32x4 bw[2][4][2];
#pragma unroll
            for (int ai = 0; ai < 2; ++ai)
#pragma unroll
                for (int m = 0; m < 4; ++m) { const size_t off = (size_t)(row0 + ai * HALF + m * 16) * ldc + col0;
#pragma unroll
                    for (int bj = 0; bj < 2; ++bj) bw[ai][m][bj] = *(const u32x4*)((const bf16_t*)base + off + bj * HALF); }
#pragma unroll
            for (int ai = 0; ai < 2; ++ai) {
                float sq[4];
#pragma unroll
                for (int m = 0; m < 4; ++m) { const size_t off = (size_t)(row0 + ai * HALF + m * 16) * ldc + col0; float s = 0.f;
#pragma unroll
                    for (int bj = 0; bj < 2; ++bj) { const u32x4 w0 = bw[ai][m][bj];
                        const f32x4 b0 = (f32x4){__builtin_bit_cast(float, w0.x << 16), __builtin_bit_cast(float, w0.x & 0xffff0000u), __builtin_bit_cast(float, w0.y << 16), __builtin_bit_cast(float, w0.y & 0xffff0000u)};
                        const f32x4 b1 = (f32x4){__builtin_bit_cast(float, w0.z << 16), __builtin_bit_cast(float, w0.z & 0xffff0000u), __builtin_bit_cast(float, w0.w << 16), __builtin_bit_cast(float, w0.w & 0xffff0000u)};
                        const f32x4 o0 = b0 + acc[ai][bj][m][0], o1 = b1 + acc[ai][bj][m][1];
                        if constexpr (OUT_F32) { *(f32x4*)(out + off + bj * HALF) = o0; *(f32x4*)(out + off + bj * HALF + 4) = o1; }
                        else { u32x4 w; w.x = cvt_pk_bf16(o0[0], o0[1]); w.y = cvt_pk_bf16(o0[2], o0[3]); w.z = cvt_pk_bf16(o1[0], o1[1]); w.w = cvt_pk_bf16(o1[2], o1[3]); *(u32x4*)(xb + off + bj * HALF) = w;
                            s += ((o0[0] * o0[0] + o0[1] * o0[1]) + (o0[2] * o0[2] + o0[3] * o0[3])) + ((o1[0] * o1[0] + o1[1] * o1[1]) + (o1[2] * o1[2] + o1[3] * o1[3])); } }
                    sq[m] = s; }
                if constexpr (!OUT_F32) {
#pragma unroll
                    for (int m = 0; m < 4; ++m) { float s = sq[m]; s += __shfl_xor(s, 16); s += __shfl_xor(s, 32); if (fq == 0) ss[(size_t)(row0 + ai * HALF + m * 16) * 64 + u.pn * 4 + wc] = s; } }
            }
        } else {
#pragma unroll
        for (int ai = 0; ai < 2; ++ai) {
            f32x4 bs[4][2][2];
#pragma unroll
            for (int m = 0; m < 4; ++m) { const size_t off = (size_t)(row0 + ai * HALF + m * 16) * ldc + col0;
#pragma unroll
                for (int bj = 0; bj < 2; ++bj) { bs[m][bj][0] = *(const f32x4*)((const float*)base + off + bj * HALF); bs[m][bj][1] = *(const f32x4*)((const float*)base + off + bj * HALF + 4); } }
            float sq[4];
#pragma unroll
            for (int m = 0; m < 4; ++m) { const size_t off = (size_t)(row0 + ai * HALF + m * 16) * ldc + col0; float s = 0.f;
#pragma unroll
                for (int bj = 0; bj < 2; ++bj) { const f32x4 o0 = bs[m][bj][0] + acc[ai][bj][m][0], o1 = bs[m][bj][1] + acc[ai][bj][m][1];
                    if constexpr (OUT_F32) { *(f32x4*)(out + off + bj * HALF) = o0; *(f32x4*)(out + off + bj * HALF + 4) = o1; }
                    else { u32x4 w; w.x = cvt_pk_bf16(o0[0], o0[1]); w.y = cvt_pk_bf16(o0[2], o0[3]); w.z = cvt_pk_bf16(o1[0], o1[1]); w.w = cvt_pk_bf16(o1[2], o1[3]); *(u32x4*)(xb + off + bj * HALF) = w;
                        s += ((o0[0] * o0[0] + o0[1] * o0[1]) + (o0[2] * o0[2] + o0[3] * o0[3])) + ((o1[0] * o1[0] + o1[1] * o1[1]) + (o1[2] * o1[2] + o1[3] * o1[3])); } }
                sq[m] = s; }
            if constexpr (!OUT_F32) {
#pragma unroll
                for (int m = 0; m < 4; ++m) { float s = sq[m]; s += __shfl_xor(s, 16); s += __shfl_xor(s, 32); if (fq == 0) ss[(size_t)(row0 + ai * HALF + m * 16) * 64 + u.pn * 4 + wc] = s; } }
            asm volatile("" ::: "memory");
        }
        }
    }
};
template <class Epi, class Sched, bool ALIGN_EPI = false, bool SP2 = false>
__device__ __forceinline__ void gemm_phase(PG8_LAS unsigned char* lds, const Gemm g, const Sched& S, const Epi& E) {
    int tid_ = threadIdx.x; asm volatile("" : "+v"(tid_));
    const int tid = tid_, wid = __builtin_amdgcn_readfirstlane(tid >> 6), lane = tid & 63, wr = wid >> 2, wc = wid & 3, fr = lane & 15, fq = lane >> 4;
    const int K = g.K, nt = K / BK;
    unsigned voffA[2], voffB[2];
#pragma unroll
    for (int i = 0; i < 2; ++i) { int R, C; stage_rc(tid * 16 + i * 8192, R, C); const int Rb = Epi::PERM ? ((R & ~31) + perm32(R & 31)) : R;
        voffA[i] = (unsigned)(R * K + C) * 2u; voffB[i] = (unsigned)(Rb * K + C) * 2u; }
    const size_t kstep = (size_t)(BK * 2);
    const size_t hstep = (size_t)HALF * K * 2;
    const size_t tstep = 2 * hstep;
    const unsigned ldsw = (unsigned)wid * 1024u;
    const int aoff = lds_byte(wr * 64 + fr, fq * 8), boff = lds_byte(wc * 32 + fr, fq * 8);
#define PG8_SA(b, h) (((b) * 2 + (h)) * HTB)
#define PG8_SB(b, h) ((4 + (b) * 2 + (h)) * HTB)
#define PG8_STAGE(bufoff, gbase, voff) do { _Pragma("unroll") for (int _i = 0; _i < 2; ++_i) \
        __builtin_amdgcn_global_load_lds((const unsigned*)((const char*)(gbase) + (voff)[_i]), (PG8_LAS unsigned*)(lds + (bufoff) + ldsw + _i * 8192), 16, 0, 0); } while (0)
#define PG8_LDA(dst, b, h) do { _Pragma("unroll") for (int m = 0; m < 4; ++m) _Pragma("unroll") for (int k = 0; k < 2; ++k) dst[m][k] = *(const PG8_LAS bf16x8*)(lds + PG8_SA(b, h) + aoff + m * 2048 + k * 1024); } while (0)
#define PG8_LDB(dst, b, h) do { _Pragma("unroll") for (int n = 0; n < 2; ++n) _Pragma("unroll") for (int k = 0; k < 2; ++k) dst[n][k] = *(const PG8_LAS bf16x8*)(lds + PG8_SB(b, h) + boff + n * 2048 + k * 1024); } while (0)
#define PG8_MMA(ai, bj, At, Bt) do { __builtin_amdgcn_s_setprio(PG8_PRIO_MMA); _Pragma("unroll") for (int m = 0; m < 4; ++m) _Pragma("unroll") for (int n = 0; n < 2; ++n) _Pragma("unroll") for (int k = 0; k < 2; ++k) \
        acc[ai][bj][m][n] = __builtin_amdgcn_mfma_f32_16x16x32_bf16(Bt[n][k], At[m][k], acc[ai][bj][m][n], 0, 0, 0); __builtin_amdgcn_s_setprio(PG8_PRIO_LOAD); } while (0)
#ifndef PG8_PRIO_MMA
#define PG8_PRIO_MMA 1
#define PG8_PRIO_LOAD 0
#endif
#define PG8_WAIT_V(n) asm volatile("s_waitcnt vmcnt(" #n ")" ::: "memory")
#define PG8_WAIT_L(n) asm volatile("s_waitcnt lgkmcnt(" #n ")" ::: "memory")
#define PG8_BAR __builtin_amdgcn_s_barrier()
#define PG8_SCHED __builtin_amdgcn_sched_barrier(0)
    Unit cur, nxt; int ui = 0;
    if (!S.next(0, cur)) return;
    f32x4 acc[2][2][4][2];
#pragma unroll
    for (int a = 0; a < 2; ++a)
#pragma unroll
        for (int b = 0; b < 2; ++b)
#pragma unroll
            for (int m = 0; m < 4; ++m)
#pragma unroll
                for (int n = 0; n < 2; ++n) acc[a][b][m][n] = (f32x4){0.f, 0.f, 0.f, 0.f};
    bf16x8 At[4][2], B0[2][2], B1[2][2];
    const char* cA = (const char*)g.A + (size_t)cur.pm * tstep; const char* cB = (const char*)g.Bt + (size_t)cur.pn * tstep;
    S.a_ready(cur);
    if constexpr (SP2) {
        PG8_STAGE(PG8_SB(0, 0), cB, voffB); PG8_STAGE(PG8_SB(0, 1), cB + hstep, voffB); PG8_STAGE(PG8_SA(0, 0), cA, voffA); PG8_STAGE(PG8_SA(0, 1), cA + hstep, voffA);
        if (wr == 1) PG8_BAR;
        PG8_WAIT_V(2); PG8_BAR;
        PG8_STAGE(PG8_SB(1, 0), cB + kstep, voffB); PG8_STAGE(PG8_SA(1, 0), cA + kstep, voffA); PG8_STAGE(PG8_SB(1, 1), cB + hstep + kstep, voffB);
        PG8_WAIT_V(6); PG8_BAR;
    } else {
        PG8_STAGE(PG8_SB(0, 0), cB, voffB); PG8_STAGE(PG8_SA(0, 0), cA, voffA); PG8_STAGE(PG8_SB(0, 1), cB + hstep, voffB); PG8_STAGE(PG8_SA(0, 1), cA + hstep, voffA);
        if (wr == 1) PG8_BAR;
        PG8_WAIT_V(4); PG8_BAR;
        PG8_STAGE(PG8_SB(1, 0), cB + kstep, voffB); PG8_STAGE(PG8_SA(1, 0), cA + kstep, voffA); PG8_STAGE(PG8_SB(1, 1), cB + hstep + kstep, voffB);
        PG8_WAIT_V(6); PG8_BAR;
    }
    for (;;) {
        const bool has_next = S.next(ui + 1, nxt);
        const char* nA = has_next ? (const char*)g.A + (size_t)nxt.pm * tstep : cA; const char* nB = has_next ? (const char*)g.Bt + (size_t)nxt.pn * tstep : cB;
        for (int t = 0; t < nt; t += 2) {
            const bool last = (t == nt - 2);
            const char* a1 = cA + (size_t)(t + 1) * kstep;
            const char* a2 = last ? nA : cA + (size_t)(t + 2) * kstep; const char* b2 = last ? nB : cB + (size_t)(t + 2) * kstep;
            const char* a3 = a2 + kstep; const char* b3 = b2 + kstep;
            if (last && has_next) S.a_ready(nxt);
            if constexpr (SP2) {
            PG8_LDB(B0, 0, 0); PG8_LDB(B1, 0, 1); PG8_SCHED; PG8_LDA(At, 0, 0); PG8_STAGE(PG8_SA(1, 1), a1 + hstep, voffA);
            PG8_WAIT_V(8); PG8_WAIT_L(0); PG8_BAR; PG8_MMA(0, 0, At, B0); PG8_MMA(0, 1, At, B1); PG8_BAR; PG8_SCHED;
            PG8_LDA(At, 0, 1); PG8_STAGE(PG8_SB(0, 0), b2, voffB); PG8_STAGE(PG8_SB(0, 1), b2 + hstep, voffB); PG8_STAGE(PG8_SA(0, 0), a2, voffA);
            PG8_WAIT_V(8); PG8_WAIT_L(0); PG8_BAR; PG8_MMA(1, 0, At, B0); PG8_MMA(1, 1, At, B1); PG8_BAR; PG8_SCHED;
            PG8_LDB(B0, 1, 0); PG8_LDB(B1, 1, 1); PG8_SCHED; PG8_LDA(At, 1, 0); PG8_STAGE(PG8_SA(0, 1), a2 + hstep, voffA);
            PG8_WAIT_V(8); PG8_WAIT_L(0); PG8_BAR; PG8_MMA(0, 0, At, B0); PG8_MMA(0, 1, At, B1); PG8_BAR; PG8_SCHED;
            PG8_LDA(At, 1, 1); PG8_STAGE(PG8_SB(1, 0), b3, voffB); PG8_STAGE(PG8_SB(1, 1), b3 + hstep, voffB); PG8_STAGE(PG8_SA(1, 0), a3, voffA);
            PG8_WAIT_V(8); PG8_WAIT_L(0); PG8_BAR; PG8_MMA(1, 0, At, B0); PG8_MMA(1, 1, At, B1); PG8_BAR; PG8_SCHED;
            } else {
            PG8_LDB(B0, 0, 0); PG8_SCHED; PG8_LDA(At, 0, 0); PG8_STAGE(PG8_SA(1, 1), a1 + hstep, voffA);
            PG8_WAIT_L(8); PG8_BAR; PG8_WAIT_L(0); PG8_MMA(0, 0, At, B0); PG8_BAR; PG8_SCHED;
            PG8_LDB(B1, 0, 1); PG8_STAGE(PG8_SB(0, 0), b2, voffB);
            PG8_BAR; PG8_WAIT_L(0); PG8_MMA(0, 1, At, B1); PG8_BAR;
            PG8_LDA(At, 0, 1); PG8_STAGE(PG8_SA(0, 0), a2, voffA);
            PG8_BAR; PG8_WAIT_L(0); PG8_MMA(1, 0, At, B0); PG8_BAR; PG8_SCHED;
            PG8_STAGE(PG8_SB(0, 1), b2 + hstep, voffB);
            PG8_WAIT_V(6); PG8_BAR; PG8_MMA(1, 1, At, B1); PG8_BAR;
            PG8_LDB(B0, 1, 0); PG8_SCHED; PG8_LDA(At, 1, 0); PG8_STAGE(PG8_SA(0, 1), a2 + hstep, voffA);
            PG8_WAIT_L(8); PG8_BAR; PG8_WAIT_L(0); PG8_MMA(0, 0, At, B0); PG8_BAR; PG8_SCHED;
            PG8_LDB(B1, 1, 1); PG8_STAGE(PG8_SB(1, 0), b3, voffB);
            PG8_BAR; PG8_WAIT_L(0); PG8_MMA(0, 1, At, B1); PG8_BAR;
            PG8_LDA(At, 1, 1); PG8_STAGE(PG8_SA(1, 0), a3, voffA);
            PG8_BAR; PG8_WAIT_L(0); PG8_MMA(1, 0, At, B0); PG8_BAR; PG8_SCHED;
            PG8_STAGE(PG8_SB(1, 1), b3 + hstep, voffB);
            PG8_WAIT_V(6); PG8_BAR; PG8_MMA(1, 1, At, B1); PG8_BAR;
            }
        }
        if constexpr (ALIGN_EPI) { if (wr == 0) PG8_BAR; }
        if constexpr (!Epi::AFTER_DRAIN) { E(acc, cur, wr, wc, fr, fq); S.done(cur); }
        if (!has_next) break;
#pragma unroll
        for (int a = 0; a < 2; ++a)
#pragma unroll
            for (int b = 0; b < 2; ++b)
#pragma unroll
                for (int m = 0; m < 4; ++m)
#pragma unroll
                    for (int n = 0; n < 2; ++n) acc[a][b][m][n] = (f32x4){0.f, 0.f, 0.f, 0.f};
        cur = nxt; cA = nA; cB = nB; ++ui;
        if constexpr (ALIGN_EPI) { if (wr == 1) PG8_BAR; }
    }
    PG8_WAIT_V(0);
    if constexpr (!ALIGN_EPI) { if (wr == 0) PG8_BAR; }
    PG8_BAR;
    if constexpr (Epi::AFTER_DRAIN) { E.fused(acc, cur, wr, wc, fr, fq, lds, wid, lane); S.done(cur); }
#undef PG8_SA
#undef PG8_SB
#undef PG8_STAGE
#undef PG8_LDA
#undef PG8_LDB
#undef PG8_MMA
#undef PG8_WAIT_V
#undef PG8_WAIT_L
#undef PG8_BAR
#undef PG8_SCHED
}
}

constexpr int NWAVES = 8;
constexpr int BATCH = 2, SEQ = 8192, DM = 4096, NLAYER = 2, GW = 1024, DIN = 8192, DFF = 16384;
constexpr int M = BATCH * SEQ;
constexpr int ZC_A = 0, ZC_B = 2048, ZC_C = 4096, ZC_Q = 5120, ZC_K = 6144, ZC_V = 7168;
constexpr int YC_A = 0, YC_B = 1024, YC_C = 2048, YC_D = 3072;
constexpr float QSCALE = 0.125f * 1.4426950408889634f;
#ifndef MK_SPLIT
#define MK_SPLIT 0
#endif

constexpr size_t MiB = 1u << 20;
constexpr size_t WS_CTL = 0, CTL_ZERO_BYTES = 64 * 1024;
constexpr size_t WS_ROPE = 1 * MiB;
constexpr size_t WS_PWT = 2 * MiB;
constexpr size_t WS_GWS = 3 * MiB;
constexpr size_t WS_SS = 4 * MiB;
constexpr size_t WS_SV = 8 * MiB;
constexpr size_t WS_WIN = 16 * MiB;
constexpr size_t WS_WOUT = 144 * MiB;
constexpr size_t WS_WUP = 208 * MiB;
constexpr size_t WS_WDN = 464 * MiB;
constexpr size_t WS_XN = 720 * MiB;
constexpr size_t WS_Z = 848 * MiB;
constexpr size_t WS_YC = 1104 * MiB;
constexpr size_t WS_HB = 1232 * MiB;
constexpr size_t WS_OS = 1744 * MiB;
constexpr size_t WS_QH = 1808 * MiB;
constexpr size_t WS_KH = 1840 * MiB;
constexpr size_t WS_VH = 1872 * MiB;
constexpr size_t WS_END = 1904 * MiB;
constexpr int CW_BAR = 1024;

constexpr int RING_OFF = 0, RING_BYTES = 131072;
constexpr int LDSCTL_OFF = RING_BYTES, MISC_OFF = LDSCTL_OFF + 320;
constexpr int RSTAB_OFF = RING_BYTES + 1024;
constexpr int LDS_BYTES = 147456;

#define GAS __attribute__((address_space(1)))
#define LAS __attribute__((address_space(3)))
typedef unsigned short bf16;
typedef unsigned v4u __attribute__((ext_vector_type(4)));
typedef float f32x4 __attribute__((ext_vector_type(4)));
typedef short bf16x8 __attribute__((ext_vector_type(8)));
typedef GAS unsigned gu32;
typedef GAS unsigned long long gu64;
#define RLX_AGENT __ATOMIC_RELAXED, __HIP_MEMORY_SCOPE_AGENT
#define LDS_WAIT() asm volatile("s_waitcnt lgkmcnt(0)" ::: "memory")
#define VM_WAIT() asm volatile("s_waitcnt vmcnt(0)" ::: "memory")
__device__ __forceinline__ unsigned long long rt() { return __builtin_amdgcn_s_memrealtime(); }
__device__ __forceinline__ unsigned f2bf(float f) { unsigned u = __builtin_bit_cast(unsigned, f); return (u + 0x7fffu + ((u >> 16) & 1u)) >> 16; }
__device__ __forceinline__ unsigned pk2(float lo, float hi) { return f2bf(lo) | (f2bf(hi) << 16); }

#define XB_TMO      128
#define XB_XCNT(j)  (256  + 64 * (j))
#define XB_XSUB(j)  (1280 + 64 * (j))
#define XB_XGEN(j)  (2304 + 64 * (j))
#define XB_TOP      3328
#define XB_TOPGEN   3392
#define XCD_BAR_WORDS 3456
#define XB_SPIN_CAP (1u << 18)

__device__ __forceinline__ unsigned xb_ld(unsigned* p)              { return __hip_atomic_load(p, __ATOMIC_RELAXED, __HIP_MEMORY_SCOPE_AGENT); }
__device__ __forceinline__ unsigned xb_add(unsigned* p, unsigned v) { return __hip_atomic_fetch_add(p, v, __ATOMIC_RELAXED, __HIP_MEMORY_SCOPE_AGENT); }
__device__ __forceinline__ unsigned xb_xcc_id() { return (unsigned)__builtin_amdgcn_s_getreg((3 << 11) | 20) & 0xFu; }
#define XB_SPIN(cond, bar) do { unsigned _sp = 0; while (cond) { __builtin_amdgcn_s_sleep(1); \
    if ((++_sp & 255u) == 0u) { if (xb_ld(&(bar)[XB_TMO])) break; if (_sp > XB_SPIN_CAP) { atomicAdd(&(bar)[XB_TMO], 1u); break; } } } } while (0)

struct XcdBarrier {
    unsigned* bar; unsigned x;
    volatile LAS unsigned* st;
};

__device__ __forceinline__ XcdBarrier xcd_barrier_post(unsigned* bar, volatile LAS unsigned* st) {
    XcdBarrier b; b.bar = bar; b.x = xb_xcc_id(); b.st = st;
    if (threadIdx.x == 0) (void)xb_add(&bar[XB_XCNT(b.x)], 1u);
    return b;
}
__device__ __forceinline__ void xcd_barrier_complete(unsigned* bar, unsigned x, unsigned& nloc, unsigned& nx) {
    const unsigned G = gridDim.x * gridDim.y * gridDim.z;
    unsigned sum, cnt, mine, sp = 0u;
    for (;;) {
        sum = 0u; cnt = 0u; mine = 0u;
#pragma unroll
        for (unsigned j = 0; j < 16; ++j) { const unsigned c = xb_ld(&bar[XB_XCNT(j)]); sum += c; cnt += (c > 0u) ? 1u : 0u; mine = (j == x) ? c : mine; }
        if (sum == G) break;
        __builtin_amdgcn_s_sleep(1);
        if ((++sp & 255u) == 0u) { if (xb_ld(&bar[XB_TMO])) break; if (sp > XB_SPIN_CAP) { atomicAdd(&bar[XB_TMO], 1u); break; } }
    }
    nloc = mine > 0u ? mine : 1u; nx = cnt > 0u ? cnt : 1u;
}

__device__ __forceinline__ void xcd_barrier_leader(const XcdBarrier& b) {
        unsigned* bar = b.bar;
        __builtin_amdgcn_s_waitcnt(0);
        unsigned nloc = b.st[0], nx = b.st[1];
        if (nloc == 0u) { xcd_barrier_complete(bar, b.x, nloc, nx); b.st[0] = nloc; b.st[1] = nx; }
        const unsigned old = xb_add(&bar[XB_XSUB(b.x)], 1u);
        const unsigned gen = old / nloc;
        if (old + 1u == (gen + 1u) * nloc) {
            __builtin_amdgcn_fence(__ATOMIC_RELEASE, "agent");
            asm volatile("s_waitcnt vmcnt(0)" ::: "memory");
            const unsigned og = xb_add(&bar[XB_TOP], 1u);
            const unsigned tg = og / nx;
            if (og + 1u == (tg + 1u) * nx) xb_add(&bar[XB_TOPGEN], 1u);
            else XB_SPIN(xb_ld(&bar[XB_TOPGEN]) == tg, bar);
            __builtin_amdgcn_fence(__ATOMIC_ACQUIRE, "agent");
            xb_add(&bar[XB_XGEN(b.x)], 1u);
            asm volatile("s_waitcnt vmcnt(0)" ::: "memory");
        } else {
            XB_SPIN(xb_ld(&bar[XB_XGEN(b.x)]) == gen, bar);
            __builtin_amdgcn_fence(__ATOMIC_ACQUIRE, "agent");
            asm volatile("s_waitcnt vmcnt(0)" ::: "memory");
        }
}
__device__ __forceinline__ void xcd_barrier(const XcdBarrier& b) {
    asm volatile("s_waitcnt vmcnt(0)" ::: "memory");
    __syncthreads();
    if (threadIdx.x == 0) xcd_barrier_leader(b);
    __syncthreads();
}

typedef unsigned u32x2 __attribute__((ext_vector_type(2)));
typedef float f32x2v __attribute__((ext_vector_type(2)));
struct Frame {
    LAS unsigned char* lds;
    volatile LAS unsigned* MISC;
    gu32* ctl;
    int tid, lane, wave;
    int vcu, G;
};
struct Args { const float* in[24]; float* out; unsigned char* ws; int ph_lo, ph_hi; };

__device__ __forceinline__ float wave_sum(float v) {
#pragma unroll
    for (int o = 1; o < 64; o <<= 1) v += __shfl_xor(v, o);
    return v;
}
__device__ __forceinline__ float bf_lo(unsigned w) { return __builtin_bit_cast(float, w << 16); }
__device__ __forceinline__ float bf_hi(unsigned w) { return __builtin_bit_cast(float, w & 0xffff0000u); }
__device__ __forceinline__ float sigmoidf_fast(float x) { return __builtin_amdgcn_rcpf(1.0f + __builtin_amdgcn_exp2f(-1.4426950408889634f * x)); }

__device__ __forceinline__ int zin_dest(int n) {
    if (n < 2048 || (n >= 4096 && n < 5120) || n >= 7168) return n;
    if (n < 4096) { const int j = n - 2048, half = j >> 10, c = j & 1023; return 2048 + 256 * (c >> 7) + 128 * half + (c & 127); }
    const int base = (n < 6144) ? 5120 : 6144, j = n - base, hc = j >> 6, d = j & 63;
    const int pos = (d < 16) ? ((d & 3) | ((d & 4) << 1) | ((d & 8) >> 1)) : d;
    return base + 256 * (hc >> 2) + 32 * (hc & 3) + (d < 32 ? pos : 128 + (d - 32));
}
template <bool PERMZ>
__device__ __forceinline__ void p0_transpose_item(const float* W, int K, int N, bf16* WT, LAS float* scr, int item, int lane, const float* gain = nullptr) {
    const int nblk = N / 32, kb = item / nblk, nb = item % nblk, k0 = 64 * kb, n0 = 32 * nb;
    const GAS float* Wg = (const GAS float*)W;
    const int c = lane & 7;
    f32x4 g0 = (f32x4){1.f, 1.f, 1.f, 1.f}, g1 = g0;
    if (gain) { g0 = *(const GAS f32x4*)(gain + k0 + 8 * c); g1 = *(const GAS f32x4*)(gain + k0 + 8 * c + 4); }
    float tv[32];
#pragma unroll
    for (int i = 0; i < 32; ++i) { const int kk = 2 * i + (lane >> 5); tv[i] = Wg[(size_t)(k0 + kk) * N + n0 + (lane & 31)]; }
#pragma unroll
    for (int i = 0; i < 32; ++i) { const int kk = 2 * i + (lane >> 5); scr[kk * 33 + (lane & 31)] = tv[i]; }
    LDS_WAIT(); asm volatile("" ::: "memory");
#pragma unroll
    for (int j = 0; j < 4; ++j) { const int n = (lane >> 3) + 8 * j; const LAS float* s = scr + (8 * c) * 33 + n;
        v4u o; o.x = pk2(s[0 * 33] * g0.x, s[1 * 33] * g0.y); o.y = pk2(s[2 * 33] * g0.z, s[3 * 33] * g0.w); o.z = pk2(s[4 * 33] * g1.x, s[5 * 33] * g1.y); o.w = pk2(s[6 * 33] * g1.z, s[7 * 33] * g1.w);
        const int dn = PERMZ ? zin_dest(n0 + n) : n0 + n;
        *(GAS v4u*)(WT + (size_t)dn * K + k0 + 8 * c) = o; }
    LDS_WAIT(); asm volatile("" ::: "memory");
}
template <bool PERMZ>
__device__ __forceinline__ void p0_transpose_pair(const float* W, int K, int N, bf16* WT, LAS float* scr, int item, int lane, const float* gain = nullptr) {
    const int nblk = N / 32, kb = item / nblk, nb = item % nblk, k0 = 64 * kb, n0 = 32 * nb;
    const GAS float* Wg = (const GAS float*)W;
    const int c = lane & 7;
    f32x4 g0 = (f32x4){1.f, 1.f, 1.f, 1.f}, g1 = g0;
    if (gain) { g0 = *(const GAS f32x4*)(gain + k0 + 8 * c); g1 = *(const GAS f32x4*)(gain + k0 + 8 * c + 4); }
    float tv[2][32];
#pragma unroll
    for (int h = 0; h < 2; ++h)
#pragma unroll
        for (int i = 0; i < 32; ++i) { const int kk = 2 * i + (lane >> 5); tv[h][i] = __builtin_nontemporal_load(Wg + (size_t)(k0 + kk) * N + n0 + 32 * h + (lane & 31)); }
#pragma unroll
    for (int h = 0; h < 2; ++h) {
#pragma unroll
        for (int i = 0; i < 32; ++i) { const int kk = 2 * i + (lane >> 5); scr[kk * 33 + (lane & 31)] = tv[h][i]; }
        LDS_WAIT(); asm volatile("" ::: "memory");
#pragma unroll
        for (int j = 0; j < 4; ++j) { const int n = (lane >> 3) + 8 * j; const LAS float* s = scr + (8 * c) * 33 + n;
            v4u o; o.x = pk2(s[0 * 33] * g0.x, s[1 * 33] * g0.y); o.y = pk2(s[2 * 33] * g0.z, s[3 * 33] * g0.w); o.z = pk2(s[4 * 33] * g1.x, s[5 * 33] * g1.y); o.w = pk2(s[6 * 33] * g1.z, s[7 * 33] * g1.w);
            const int dn = PERMZ ? zin_dest(n0 + 32 * h + n) : n0 + 32 * h + n;
            __builtin_nontemporal_store(o, (GAS v4u*)(WT + (size_t)dn * K + k0 + 8 * c)); }
        LDS_WAIT(); asm volatile("" ::: "memory");
    }
}
constexpr int CV_IN = (DM / 64) * (DIN / 32), CV_OUT = (DM / 64) * (DM / 32), CV_UP = (DM / 64) * (DFF / 32), CV_DN = (DFF / 64) * (DM / 32), CV_L = CV_IN + CV_OUT + CV_UP + CV_DN;
constexpr int CV_TOTAL = NLAYER * CV_L - CV_IN, CV_CHUNK = 16, CV_NCHUNK = CV_TOTAL / CV_CHUNK;
constexpr unsigned CV_EXH = 0xFFFFFFFFu;
constexpr int CW_Q = 8192;
constexpr int QST_OFF = LDSCTL_OFF + 4096;
static_assert(CV_TOTAL % (CV_CHUNK * 256) == 0 && CV_IN % (CV_CHUNK * 256) == 0 && CV_OUT % (CV_CHUNK * 256) == 0 && CV_UP % (CV_CHUNK * 256) == 0, "chunking");
__device__ __forceinline__ constexpr int cv_deadline(int l, int which) { return l * CV_L + (which == 0 ? CV_IN : which == 1 ? CV_IN + CV_OUT : which == 2 ? CV_IN + CV_OUT + CV_UP : CV_L) - CV_IN; }
__device__ __forceinline__ void cv_item(const Args& a, LAS float* scr, int I, int lane) {
    unsigned char* ws = a.ws;
    const int J = I + CV_IN, l = (J >= CV_L) ? 1 : 0; int r = J - l * CV_L;
    if (r < CV_IN) { p0_transpose_pair<true>(a.in[2] + (size_t)l * DM * DIN, DM, DIN, (bf16*)(ws + WS_WIN) + (size_t)l * DIN * DM, scr, r, lane, a.in[1] + (size_t)l * DM); return; } r -= CV_IN;
    if (r < CV_OUT) { p0_transpose_pair<false>(a.in[20] + (size_t)l * DM * DM, DM, DM, (bf16*)(ws + WS_WOUT) + (size_t)l * DM * DM, scr, r, lane); return; } r -= CV_OUT;
    if (r < CV_UP) { p0_transpose_pair<false>(a.in[22] + (size_t)l * DM * DFF, DM, DFF, (bf16*)(ws + WS_WUP) + (size_t)l * DFF * DM, scr, r, lane, a.in[21] + (size_t)l * DM); return; } r -= CV_UP;
    p0_transpose_pair<false>(a.in[23] + (size_t)l * DFF * DM, DFF, DM, (bf16*)(ws + WS_WDN) + (size_t)l * DM * DFF, scr, r, lane);
}
#ifndef NO_WAIT_STEAL
#define NO_WAIT_STEAL 0
#endif
__device__ __forceinline__ void seam_steal(const Frame& F, const Args& a, const XcdBarrier& b, int DI) {
    volatile LAS unsigned* QS = (volatile LAS unsigned*)(F.lds + QST_OFF);
    LAS float* scr = (LAS float*)(F.lds + RING_OFF + F.wave * 16384);
    const unsigned cu = blockIdx.x, DJ = (unsigned)DI / 256u, TJ = (unsigned)CV_TOTAL / 256u;
    __syncthreads();
    const unsigned e0 = (unsigned)__builtin_amdgcn_readfirstlane((int)QS[0]);
    unsigned cur = (unsigned)__builtin_amdgcn_readfirstlane((int)QS[8 + 2 * F.wave]), end = (unsigned)__builtin_amdgcn_readfirstlane((int)QS[9 + 2 * F.wave]);
    int mode = 0;
#ifdef DIAG_STEAL
    unsigned stolen = 0u;
#endif
    for (;;) {
        if (mode == 1 && (unsigned)__builtin_amdgcn_readfirstlane((int)QS[0]) != e0) break;
        if (cur == end) {
            bool arrive = false;
            if (end == CV_EXH) { if (mode == 0) arrive = true; else { __builtin_amdgcn_s_sleep(8); continue; } }
            else {
                if (mode == 0 && (unsigned)__builtin_amdgcn_readfirstlane((int)QS[1]) >= DJ) arrive = true;
                else {
                    unsigned j0 = 0u; if (F.lane == 0) j0 = __hip_atomic_fetch_add((LAS unsigned*)(F.lds + QST_OFF + 4), 2u, __ATOMIC_RELAXED, __HIP_MEMORY_SCOPE_WORKGROUP);
                    j0 = (unsigned)__builtin_amdgcn_readfirstlane((int)j0);
                    if (j0 >= TJ) { cur = end = CV_EXH; continue; }
                    cur = j0; end = j0 + 2u;
                }
            }
            if (arrive) {
                asm volatile("s_waitcnt vmcnt(0)" ::: "memory");
                __syncthreads();
                if (F.wave == 0 || NO_WAIT_STEAL) { if (threadIdx.x == 0) { xcd_barrier_leader(b); QS[0] = e0 + 1u; } break; }
                mode = 1; continue;
            }
        }
        cv_item(a, scr, (int)(16u * (256u * (cur >> 4) + cu) + (cur & 15u)), F.lane); cur += 2u;
#ifdef DIAG_STEAL
        stolen += 2u * (unsigned)mode;
#endif
    }
    if (F.lane == 0) { QS[8 + 2 * F.wave] = cur; QS[9 + 2 * F.wave] = end; }
#ifdef DIAG_STEAL
    if (F.lane == 0 && stolen) __hip_atomic_fetch_add((unsigned*)(F.ctl + CW_Q + 1024), stolen, RLX_AGENT);
#endif
    __syncthreads();
}
__device__ __forceinline__ void p0_prologue(const Frame& F, const Args& a) {
    LAS float* scr = (LAS float*)(F.lds + RING_OFF + F.wave * 16384);
    unsigned char* ws = a.ws;
    const int gw = F.vcu * NWAVES + F.wave, NGW = F.G * NWAVES;
    constexpr int I_PW1 = (256 / 64) * (256 / 32), I_PW = 4 * I_PW1;
    for (int it = gw; it < CV_IN + NLAYER * I_PW; it += NGW) {
        if (it < CV_IN) { p0_transpose_item<true>(a.in[2], DM, DIN, (bf16*)(ws + WS_WIN), scr, it, F.lane, a.in[1]); continue; }
        const int r = it - CV_IN, lg = r / I_PW1, ri = r % I_PW1;
        p0_transpose_item<false>(a.in[11] + (size_t)lg * 65536, 256, 256, (bf16*)(ws + WS_PWT) + (size_t)lg * 65536, scr, ri, F.lane);
    }
    const int gt = F.vcu * (NWAVES * 64) + F.tid, NGT = F.G * NWAVES * 64;
    { const GAS float* src = (const GAS float*)a.in[5]; GAS unsigned* dst = (GAS unsigned*)(ws + WS_GWS);
      for (int i = gt; i < NLAYER * 8 * 128 * 128 / 2; i += NGT) dst[i] = pk2(src[2 * i], src[2 * i + 1]); }
    { GAS float* rope = (GAS float*)(ws + WS_ROPE);
      for (int e = gt; e < SEQ * 8; e += NGT) {
          const int pos = e >> 3, i = e & 7;
          const float invf = (i == 0) ? 1.0f : (i == 1) ? 0x1.8d275ep-3f : (i == 2) ? 0x1.341190p-5f : (i == 3) ? 0x1.ddee9cp-8f : (i == 4) ? 0x1.72ba44p-10f : (i == 5) ? 0x1.1f91f0p-12f : (i == 6) ? 0x1.be218ap-15f : 0x1.5a0f50p-17f;
          const float angf = (float)pos * invf;
          const double ad = (double)angf;
          const double kq = __builtin_rint(ad * 0.63661977236758134308);
          const double y = __builtin_fma(-kq, 1.57079632679489661923, ad);
          const double y2 = y * y;
          const double sn = y * (1.0 + y2 * (-1.0 / 6 + y2 * (1.0 / 120 + y2 * (-1.0 / 5040 + y2 * (1.0 / 362880 + y2 * (-1.0 / 39916800))))));
          const double cs = 1.0 + y2 * (-0.5 + y2 * (1.0 / 24 + y2 * (-1.0 / 720 + y2 * (1.0 / 40320 + y2 * (-1.0 / 3628800 + y2 * (1.0 / 479001600))))));
          const int q = ((int)kq) & 3;
          const double c = (q == 0) ? cs : (q == 1) ? -sn : (q == 2) ? -cs : sn;
          const double s = (q == 0) ? sn : (q == 1) ? cs : (q == 2) ? -sn : -cs;
          rope[2 * e] = (float)c; rope[2 * e + 1] = (float)s;
      } }
}

__device__ __forceinline__ void xprep_phase(const Frame& F, const float* x, bf16* XB, float* SS) {
    const int gw = F.vcu * NWAVES + F.wave, NGW = F.G * NWAVES;
    for (int m = gw; m < M; m += NGW) {
        const GAS f32x4* xr = (const GAS f32x4*)(x + (size_t)m * DM) + F.lane;
        f32x4 v[16]; float s = 0.f;
#pragma unroll
        for (int j = 0; j < 16; ++j) { v[j] = xr[64 * j]; s += (v[j].x * v[j].x + v[j].y * v[j].y) + (v[j].z * v[j].z + v[j].w * v[j].w); }
        GAS u32x2* o8 = (GAS u32x2*)(XB + (size_t)m * DM) + F.lane;
#pragma unroll
        for (int j = 0; j < 16; ++j) { u32x2 w; w.x = pk2(v[j].x, v[j].y); w.y = pk2(v[j].z, v[j].w); o8[64 * j] = w; }
        ((GAS float*)SS)[(size_t)m * 64 + F.lane] = s;
    }
}
__device__ __forceinline__ void rs_table(const Frame& F, const float* SS, int pm) {
    LAS float* tab = (LAS float*)(F.lds + RSTAB_OFF);
    if (F.tid < 256) { const GAS f32x4* p = (const GAS f32x4*)(SS + (size_t)(pm * 256 + F.tid) * 64); float s = 0.f;
#pragma unroll
        for (int j = 0; j < 16; ++j) { const f32x4 v = p[j]; s += (v.x + v.y) + (v.z + v.w); }
        tab[F.tid] = 1.0f / sqrtf(s * (1.f / DM) + 1e-6f); }
    __syncthreads();
}

__device__ __forceinline__ int vimg_st(int k, int c) { const int kk = (k & ~0xC) | ((k & 4) << 1) | ((k & 8) >> 1); return ((kk >> 3) * 4 + (c >> 5)) * 512 + ((kk & 7) * 32 + (c & 31)) * 2; }
__device__ __forceinline__ int vimg_rd_base(int lane) { return ((lane & 3) << 3) | (((lane >> 2) & 3) << 6) | (((lane >> 4) & 1) << 5) | (((lane >> 5) & 1) << 8); }
typedef __attribute__((ext_vector_type(4))) short s16x4;
typedef __attribute__((ext_vector_type(16))) float f32x16;
template <int OFF> __device__ __forceinline__ s16x4 vimg_tr(int vb) { s16x4 r; asm volatile("ds_read_b64_tr_b16 %0, %1 offset:%2" : "=&v"(r) : "v"(vb), "i"(OFF) : "memory"); return r; }
__device__ __forceinline__ void unpack8(const v4u a, float (&v)[8]) { v[0] = bf_lo(a.x); v[1] = bf_hi(a.x); v[2] = bf_lo(a.y); v[3] = bf_hi(a.y); v[4] = bf_lo(a.z); v[5] = bf_hi(a.z); v[6] = bf_lo(a.w); v[7] = bf_hi(a.w); }

__device__ __forceinline__ void gmlp_unit(const Frame& F, const bf16* Z, bf16* YC, const float* SV, const bf16* Wsb, const float* bs, const float* lng, const float* lnb, int unit, char* ldsg) {
    const int chunk = unit >> 2, hp = unit & 3, r0 = chunk * 128, tid = F.tid, lane = F.lane, w = F.wave, r32 = lane & 31, hi = lane >> 5;
    LAS float* st = (LAS float*)(F.lds + RING_OFF);
    LAS unsigned char* VI = F.lds + RING_OFF + 1024;
    LAS float* OT = (LAS float*)(F.lds + RING_OFF + 1024 + 32768);
    if (tid < 128) { const GAS f32x4* p = (const GAS f32x4*)(SV + (size_t)(r0 + tid) * 32); float s1 = 0.f, s2 = 0.f;
#pragma unroll
        for (int j = 0; j < 8; ++j) { const f32x4 v = p[j]; s1 += v.x + v.z; s2 += v.y + v.w; }
        const float mean = s1 * (1.f / 1024.f), var = s2 * (1.f / 1024.f) - mean * mean;
        st[tid * 2] = mean; st[tid * 2 + 1] = 1.0f / sqrtf(fmaxf(var, 0.f) + 1e-5f); }
    __syncthreads();
    const int d0 = w & 3, ib0 = (w >> 2) * 2;
    const int vb = (int)(uintptr_t)(ldsg + RING_OFF + 1024) + vimg_rd_base(lane) + d0 * 512;
#pragma unroll 1
    for (int hq = 0; hq < 2; ++hq) {
        const int h = hp * 2 + hq;
        bf16x8 wa[8], wb[8];
        { const GAS bf16* wrow = (const GAS bf16*)Wsb + (size_t)(h * 128 + 32 * ib0 + r32) * 128 + 8 * hi;
#pragma unroll
          for (int ks = 0; ks < 8; ++ks) { wa[ks] = *(const GAS bf16x8*)(wrow + 16 * ks); wb[ks] = *(const GAS bf16x8*)(wrow + 32 * 128 + 16 * ks); } }
        { const int j = tid >> 2, cq = tid & 3; const float mean = st[j * 2], rstd = st[j * 2 + 1];
          const GAS v4u* p = (const GAS v4u*)(Z + (size_t)(r0 + j) * DIN + ZC_A + 1024 + h * 128 + cq * 32);
          const GAS f32x4* gp = (const GAS f32x4*)(lng + h * 128 + cq * 32); const GAS f32x4* bp = (const GAS f32x4*)(lnb + h * 128 + cq * 32);
          v4u a[4];
#pragma unroll
          for (int k4 = 0; k4 < 4; ++k4) a[k4] = p[k4];
#pragma unroll
          for (int k4 = 0; k4 < 4; ++k4) { float v[8]; unpack8(a[k4], v); const f32x4 g0 = gp[2 * k4], g1 = gp[2 * k4 + 1], b0 = bp[2 * k4], b1 = bp[2 * k4 + 1];
              v4u o; o.x = pk2((v[0] - mean) * rstd * g0.x + b0.x, (v[1] - mean) * rstd * g0.y + b0.y); o.y = pk2((v[2] - mean) * rstd * g0.z + b0.z, (v[3] - mean) * rstd * g0.w + b0.w);
              o.z = pk2((v[4] - mean) * rstd * g1.x + b1.x, (v[5] - mean) * rstd * g1.y + b1.y); o.w = pk2((v[6] - mean) * rstd * g1.z + b1.z, (v[7] - mean) * rstd * g1.w + b1.w);
              *(LAS v4u*)(VI + (j >> 6) * 16384 + vimg_st(j & 63, cq * 32 + k4 * 8)) = o; } }
        __syncthreads();
        f32x16 acc[2]; acc[0] = f32x16{}; acc[1] = f32x16{};
#define GM_RD(KS) lo_[KS] = vimg_tr<((KS) >> 2) * 16384 + ((KS) & 3) * 4096>(vb), hi_[KS] = vimg_tr<((KS) >> 2) * 16384 + ((KS) & 3) * 4096 + 2048>(vb)
#define GM_MM(KS) do { const bf16x8 b_ = (bf16x8){lo_[KS][0], lo_[KS][1], lo_[KS][2], lo_[KS][3], hi_[KS][0], hi_[KS][1], hi_[KS][2], hi_[KS][3]}; \
        acc[0] = __builtin_amdgcn_mfma_f32_32x32x16_bf16(wa[KS], b_, acc[0], 0, 0, 0); acc[1] = __builtin_amdgcn_mfma_f32_32x32x16_bf16(wb[KS], b_, acc[1], 0, 0, 0); } while (0)
        { s16x4 lo_[8], hi_[8];
          GM_RD(0); GM_RD(1); GM_RD(2); GM_RD(3); GM_RD(4); GM_RD(5); GM_RD(6); GM_RD(7);
          asm volatile("s_waitcnt lgkmcnt(0)" ::: "memory"); __builtin_amdgcn_sched_barrier(0);
          GM_MM(0); GM_MM(1); GM_MM(2); GM_MM(3); GM_MM(4); GM_MM(5); GM_MM(6); GM_MM(7); }
#undef GM_RD
#undef GM_MM
#define GM_STEP(KS) do { } while (0)
#undef GM_STEP
#pragma unroll
        for (int t = 0; t < 2; ++t)
#pragma unroll
            for (int r = 0; r < 16; ++r) OT[(32 * (ib0 + t) + (r & 3) + 8 * (r >> 2) + 4 * hi) * 132 + 32 * d0 + r32] = acc[t][r];
        __syncthreads();
        { const int i = tid >> 2, cq = tid & 3; const float b = bs[h * 128 + i];
          const GAS v4u* up = (const GAS v4u*)(Z + (size_t)(r0 + i) * DIN + ZC_A + h * 128 + cq * 32); GAS v4u* yp = (GAS v4u*)(YC + (size_t)(r0 + i) * DM + YC_A + h * 128 + cq * 32);
          v4u a[4];
#pragma unroll
          for (int k4 = 0; k4 < 4; ++k4) a[k4] = up[k4];
#pragma unroll
          for (int k4 = 0; k4 < 4; ++k4) { float u[8]; unpack8(a[k4], u); const f32x4 o0 = *(const LAS f32x4*)(OT + i * 132 + cq * 32 + k4 * 8), o1 = *(const LAS f32x4*)(OT + i * 132 + cq * 32 + k4 * 8 + 4);
              v4u o; o.x = pk2((o0.x + b) * u[0], (o0.y + b) * u[1]); o.y = pk2((o0.z + b) * u[2], (o0.w + b) * u[3]); o.z = pk2((o1.x + b) * u[4], (o1.y + b) * u[5]); o.w = pk2((o1.z + b) * u[6], (o1.w + b) * u[7]);
              yp[k4] = o; } }
    }
    __syncthreads();
}

template <int R> __device__ __forceinline__ void conv_rows(const unsigned (&hraw)[62], const f32x2v (&w)[31], f32x2v (&acc)[31], const f32x2v bias, LAS float* cvp, int rlo, int rhi) {
    const unsigned hv = (R >= rlo && R < rhi) ? hraw[R] : 0u;
    const f32x2v h = (f32x2v){bf_lo(hv), bf_hi(hv)};
#pragma unroll
    for (int k = 0; k < 31; ++k) { const int o = R - k; if (o >= 0 && o <= 31) acc[(o + 31) % 31] = acc[(o + 31) % 31] + h * w[k]; }
    if constexpr (R >= 30) { constexpr int o = R - 30; *(LAS f32x2v*)(cvp + o * GW) = acc[o % 31] + bias; acc[o % 31] = (f32x2v){0.f, 0.f}; }
    if constexpr (R + 1 < 62) conv_rows<R + 1>(hraw, w, acc, bias, cvp, rlo, rhi);
}
__device__ __forceinline__ void conv_unit(const Frame& F, const bf16* Z, bf16* YC, const float* cw, const float* cb, const float* lng, const float* lnb, int unit) {
    const int t0 = unit * 32, bstart = (t0 / SEQ) * SEQ, bend = bstart + SEQ, tid = F.tid, lane = F.lane, c0 = 2 * tid;
    LAS float* CV = (LAS float*)(F.lds + RING_OFF);
    unsigned hraw[62];
    { const GAS bf16* zp = (const GAS bf16*)Z + (ptrdiff_t)(t0 - 15) * DIN + ZC_B + c0;
#pragma unroll
      for (int r = 0; r < 62; ++r) { hraw[r] = *(const GAS unsigned*)zp; zp += DIN; asm volatile("" : "+v"(zp)); } }
    f32x2v w[31], acc[31];
    { const GAS float* wp = (const GAS float*)cw + c0;
#pragma unroll
      for (int k = 0; k < 31; ++k) { w[k] = *(const GAS f32x2v*)wp; acc[k] = (f32x2v){0.f, 0.f}; wp += GW; asm volatile("" : "+v"(wp)); } }
    const f32x2v bias = *(const GAS f32x2v*)(cb + c0);
    conv_rows<0>(hraw, w, acc, bias, CV + c0, bstart - (t0 - 15), bend - (t0 - 15));
    __syncthreads();
    { f32x4 x[4][4]; float sm[4], qv[4];
#pragma unroll
      for (int oo = 0; oo < 4; ++oo) { const int o = F.wave * 4 + oo; float s_ = 0.f;
#pragma unroll
          for (int j = 0; j < 4; ++j) { x[oo][j] = *(const LAS f32x4*)(CV + o * GW + lane * 4 + 256 * j); s_ += (x[oo][j].x + x[oo][j].y) + (x[oo][j].z + x[oo][j].w); }
          sm[oo] = s_; }
#pragma unroll
      for (int st = 1; st < 64; st <<= 1) {
#pragma unroll
          for (int oo = 0; oo < 4; ++oo) sm[oo] += __shfl_xor(sm[oo], st); }
#pragma unroll
      for (int oo = 0; oo < 4; ++oo) { const float mean = sm[oo] * (1.f / GW); float q = 0.f;
#pragma unroll
          for (int j = 0; j < 4; ++j) { x[oo][j] = x[oo][j] - mean; q += (x[oo][j].x * x[oo][j].x + x[oo][j].y * x[oo][j].y) + (x[oo][j].z * x[oo][j].z + x[oo][j].w * x[oo][j].w); }
          qv[oo] = q; }
#pragma unroll
      for (int st = 1; st < 64; st <<= 1) {
#pragma unroll
          for (int oo = 0; oo < 4; ++oo) qv[oo] += __shfl_xor(qv[oo], st); }
#pragma unroll
      for (int j = 0; j < 4; ++j) { const int c = lane * 4 + 256 * j; const f32x4 gv = *(const GAS f32x4*)(lng + c), bv = *(const GAS f32x4*)(lnb + c);
#pragma unroll
          for (int oo = 0; oo < 4; ++oo) { const int o = F.wave * 4 + oo; const float rstd = 1.0f / sqrtf(qv[oo] * (1.f / GW) + 1e-5f);
              f32x4 y = x[oo][j] * rstd * gv + bv; y.x *= sigmoidf_fast(y.x); y.y *= sigmoidf_fast(y.y); y.z *= sigmoidf_fast(y.z); y.w *= sigmoidf_fast(y.w);
              u32x2 wv; wv.x = pk2(y.x, y.y); wv.y = pk2(y.z, y.w);
              *(GAS u32x2*)(YC + (size_t)(t0 + o) * DM + YC_B + c) = wv; } } }
    __syncthreads();
}

__device__ __forceinline__ void pool_unit(const Frame& F, const bf16* Z, bf16* YC, const bf16* PWT, const float* scale, int unit) {
    const int g = unit & 3, tile = unit >> 2, t0 = tile * 64, bstart = (t0 / SEQ) * SEQ, tid = F.tid, lane = F.lane, fr = lane & 15, fq = lane >> 4, w = F.wave;
    const int wh = 1 << g;
    LAS bf16* ZT = (LAS bf16*)(F.lds + RING_OFF);
    LAS bf16* P = (LAS bf16*)(F.lds + RING_OFF + 80 * 264 * 2);
    const GAS bf16* pw = (const GAS bf16*)PWT + (size_t)g * 65536;
    bf16x8 Bf[8][2];
#pragma unroll
    for (int kk = 0; kk < 8; ++kk)
#pragma unroll
        for (int n = 0; n < 2; ++n) Bf[kk][n] = *(const GAS bf16x8*)(pw + (size_t)(32 * w + 16 * n + fr) * 256 + 32 * kk + 8 * fq);
    { const GAS bf16* zc = (const GAS bf16*)Z + ZC_C + g * 256; v4u a[5];
#pragma unroll
      for (int i = 0; i < 5; ++i) { const int q = tid + 512 * i, rr = q >> 5, cc = q & 31; int row = t0 - 8 + rr; row = row < bstart ? bstart : (row >= bstart + SEQ ? bstart + SEQ - 1 : row);
          a[i] = *(const GAS v4u*)(zc + (size_t)row * DIN + cc * 8); }
#pragma unroll
      for (int i = 0; i < 5; ++i) { const int q = tid + 512 * i, rr = q >> 5, cc = q & 31; *(LAS v4u*)(ZT + rr * 264 + cc * 8) = a[i]; } }
    __syncthreads();
    { const int cc = tid & 31, rg = tid >> 5;
      auto body = [&](auto GC) __attribute__((always_inline)) { constexpr int WH = 1 << decltype(GC)::value, NU = 2 * WH + 3;
          const int pos0 = t0 - bstart + 4 * rg - WH;
          v4u raw[NU];
#pragma unroll
          for (int i = 0; i < NU; ++i) raw[i] = *(const LAS v4u*)(ZT + (4 * rg - WH + i + 8) * 264 + cc * 8);
          float sw[8];
#pragma unroll
          for (int e = 0; e < 8; ++e) sw[e] = 0.f;
#pragma unroll
          for (int i = 0; i < 2 * WH; ++i) { const unsigned ps = (unsigned)(pos0 + i); float v[8]; unpack8(raw[i], v); const float mk = ps < (unsigned)SEQ ? 1.f : 0.f;
#pragma unroll
              for (int e = 0; e < 8; ++e) sw[e] += v[e] * mk; }
#pragma unroll
          for (int o = 0; o < 4; ++o) {
              if (o > 0) { float va[8], vr[8]; unpack8(raw[2 * WH - 1 + o], va); unpack8(raw[o - 1], vr);
                  const float ma = (unsigned)(pos0 + 2 * WH - 1 + o) < (unsigned)SEQ ? 1.f : 0.f, mr = (unsigned)(pos0 + o - 1) < (unsigned)SEQ ? 1.f : 0.f;
#pragma unroll
                  for (int e = 0; e < 8; ++e) sw[e] += va[e] * ma - vr[e] * mr; }
              const int pos = pos0 + WH + o; const int lo = pos - WH > 0 ? pos - WH : 0, hi = pos + WH < SEQ ? pos + WH : SEQ; const float inv = 1.0f / (float)(hi - lo);
              float v[8]; unpack8(raw[WH + o], v);
              v4u ov; ov.x = pk2(sw[0] * inv - v[0], sw[1] * inv - v[1]); ov.y = pk2(sw[2] * inv - v[2], sw[3] * inv - v[3]); ov.z = pk2(sw[4] * inv - v[4], sw[5] * inv - v[5]); ov.w = pk2(sw[6] * inv - v[6], sw[7] * inv - v[7]);
              *(LAS v4u*)(P + (4 * rg + o) * 264 + cc * 8) = ov; } };
      if (g == 0) body(std::integral_constant<int, 0>{}); else if (g == 1) body(std::integral_constant<int, 1>{}); else if (g == 2) body(std::integral_constant<int, 2>{}); else body(std::integral_constant<int, 3>{}); }
    __syncthreads();
    f32x4 acc[4][2];
#pragma unroll
    for (int m = 0; m < 4; ++m)
#pragma unroll
        for (int n = 0; n < 2; ++n) acc[m][n] = (f32x4){0.f, 0.f, 0.f, 0.f};
#pragma unroll
    for (int kk = 0; kk < 8; ++kk) {
        bf16x8 Af[4];
#pragma unroll
        for (int m = 0; m < 4; ++m) Af[m] = *(const LAS bf16x8*)(P + (16 * m + fr) * 264 + 32 * kk + 8 * fq);
#pragma unroll
        for (int m = 0; m < 4; ++m)
#pragma unroll
            for (int n = 0; n < 2; ++n) acc[m][n] = __builtin_amdgcn_mfma_f32_16x16x32_bf16(Bf[kk][n], Af[m], acc[m][n], 0, 0, 0);
    }
#pragma unroll
    for (int n = 0; n < 2; ++n) { const int d = 32 * w + 16 * n + 4 * fq; const f32x4 sc = *(const GAS f32x4*)(scale + g * 256 + d);
#pragma unroll
        for (int m = 0; m < 4; ++m) { const f32x4 v = acc[m][n] * sc; u32x2 wv; wv.x = pk2(v[0], v[1]); wv.y = pk2(v[2], v[3]);
            *(GAS u32x2*)(YC + (size_t)(t0 + 16 * m + fr) * DM + YC_C + g * 256 + d) = wv; } }
    __syncthreads();
}

namespace att {
typedef __attribute__((ext_vector_type(8))) short bf16x8;
typedef __attribute__((ext_vector_type(4))) short s16x4;
typedef __attribute__((ext_vector_type(16))) float f32x16;
typedef __attribute__((ext_vector_type(4))) unsigned u32x4;
constexpr int QBLK = 32, KVBLK = 64, NW = 8, LDQK = 64, LDV = 128;
constexpr int SHM_V = KVBLK * 128 * 2, SHM_K = KVBLK * 64 * 2;
constexpr int OFF_V = 0, OFF_K = 2 * SHM_V, OFF_WS = OFF_K + 2 * SHM_K, ATT_LDS = OFF_WS + NW * 64 * 4;
constexpr float THR = 8.0f;
#define KSWZ(row, colB) ((row) * 128 + ((colB) ^ ((((row) >> 1) & 7) << 4)))
#define SBAR() __builtin_amdgcn_sched_barrier(0)
__device__ __forceinline__ int crow(int r, int hi) { return (r & 3) + 8 * (r >> 2) + 4 * hi; }
__device__ __forceinline__ unsigned cvtpk(float lo, float hi) { unsigned r; asm volatile("v_cvt_pk_bf16_f32 %0, %1, %2" : "=v"(r) : "v"(lo), "v"(hi)); return r; }

__device__ __forceinline__ void partialSM(f32x16& p0, f32x16& p1, float& m_reg, float& alpha) {
    float pmax = p0[0];
#pragma unroll
    for (int r = 1; r < 16; ++r) pmax = fmaxf(pmax, p0[r]);
#pragma unroll
    for (int r = 0; r < 16; ++r) pmax = fmaxf(pmax, p1[r]);
    { auto rr = __builtin_amdgcn_permlane32_swap(__float_as_uint(pmax), __float_as_uint(pmax), false, false);
      pmax = fmaxf(__uint_as_float(rr[0]), __uint_as_float(rr[1])); }
    if (__builtin_expect(__all(pmax - m_reg <= THR), 1)) { alpha = 1.f; }
    else { const float mn = fmaxf(m_reg, pmax); alpha = __builtin_amdgcn_exp2f(m_reg - mn); m_reg = mn; }
    const float mm = m_reg;
#pragma unroll
    for (int r = 0; r < 16; ++r) { p0[r] -= mm; p1[r] -= mm; }
#pragma unroll
    for (int r = 0; r < 16; ++r) p0[r] = __builtin_amdgcn_exp2f(p0[r]);
}
__device__ __forceinline__ void finishSM(f32x16& p0, f32x16& p1, float alpha, float& l_reg, bf16x8& pa0, bf16x8& pa1, bf16x8& pa2, bf16x8& pa3) {
#pragma unroll
    for (int r = 0; r < 16; ++r) p1[r] = __builtin_amdgcn_exp2f(p1[r]);
    float ps = 0.f;
#pragma unroll
    for (int r = 0; r < 16; ++r) ps += p0[r];
#pragma unroll
    for (int r = 0; r < 16; ++r) ps += p1[r];
    { auto rr = __builtin_amdgcn_permlane32_swap(__float_as_uint(ps), __float_as_uint(ps), false, false);
      ps = __uint_as_float(rr[0]) + __uint_as_float(rr[1]); }
    l_reg = l_reg * alpha + ps;
#define PK4(P, BASE, OUT) do { unsigned a0 = cvtpk(P[BASE + 0], P[BASE + 1]), a1 = cvtpk(P[BASE + 2], P[BASE + 3]);   \
    unsigned b0 = cvtpk(P[BASE + 4], P[BASE + 5]), b1 = cvtpk(P[BASE + 6], P[BASE + 7]);                              \
    auto r0 = __builtin_amdgcn_permlane32_swap(a0, b0, false, false); auto r1 = __builtin_amdgcn_permlane32_swap(a1, b1, false, false); \
    u32x4 w = {r0[0], r1[0], r0[1], r1[1]}; OUT = *reinterpret_cast<bf16x8*>(&w); } while (0)
    PK4(p0, 0, pa0); PK4(p0, 8, pa1); PK4(p1, 0, pa2); PK4(p1, 8, pa3);
#undef PK4
}
__device__ __forceinline__ void qkt(f32x16& p0, f32x16& p1, const char* Ks, const bf16x8* qr, int r32, int hi) {
    p0 = f32x16{}; p1 = f32x16{};
#pragma unroll
    for (int d0 = 0; d0 < 4; ++d0) { const int cb = (d0 * 16 + hi * 8) * 2;
        const bf16x8 b0 = *reinterpret_cast<const bf16x8*>(Ks + KSWZ(r32, cb));
        const bf16x8 b1 = *reinterpret_cast<const bf16x8*>(Ks + KSWZ(32 + r32, cb));
        p0 = __builtin_amdgcn_mfma_f32_32x32x16_bf16(b0, qr[d0], p0, 0, 0, 0);
        p1 = __builtin_amdgcn_mfma_f32_32x32x16_bf16(b1, qr[d0], p1, 0, 0, 0); }
}
__device__ __forceinline__ int v_st(int k, int c) { const int kk = (k & ~0xC) | ((k & 4) << 1) | ((k & 8) >> 1); return ((kk >> 3) * 4 + (c >> 5)) * 512 + ((kk & 7) * 32 + (c & 31)) * 2; }
__device__ __forceinline__ int v_rd_base(int lane) { return ((lane & 3) << 3) | (((lane >> 2) & 3) << 6) | (((lane >> 4) & 1) << 5) | (((lane >> 5) & 1) << 8); }
constexpr int v_rd_off(int d0, int ks, int half) { return d0 * 512 + ks * 4096 + half * 2048; }
template <int OFF> __device__ __forceinline__ s16x4 tr_read(int vb) {
    s16x4 r; asm volatile("ds_read_b64_tr_b16 %0, %1 offset:%2" : "=&v"(r) : "v"(vb), "i"(OFF) : "memory"); return r;
}
template <int D0> __device__ __forceinline__ void pv_one(f32x16& od, int vb, bf16x8 pa0, bf16x8 pa1, bf16x8 pa2, bf16x8 pa3) {
    const s16x4 l0 = tr_read<v_rd_off(D0, 0, 0)>(vb), h0 = tr_read<v_rd_off(D0, 0, 1)>(vb), l1 = tr_read<v_rd_off(D0, 1, 0)>(vb), h1 = tr_read<v_rd_off(D0, 1, 1)>(vb);
    const s16x4 l2 = tr_read<v_rd_off(D0, 2, 0)>(vb), h2 = tr_read<v_rd_off(D0, 2, 1)>(vb), l3 = tr_read<v_rd_off(D0, 3, 0)>(vb), h3 = tr_read<v_rd_off(D0, 3, 1)>(vb);
    asm volatile("s_waitcnt lgkmcnt(0)" ::: "memory"); SBAR();
#define PK(L, H) (bf16x8){L[0], L[1], L[2], L[3], H[0], H[1], H[2], H[3]}
    od = __builtin_amdgcn_mfma_f32_32x32x16_bf16(pa0, PK(l0, h0), od, 0, 0, 0);
    od = __builtin_amdgcn_mfma_f32_32x32x16_bf16(pa1, PK(l1, h1), od, 0, 0, 0);
    od = __builtin_amdgcn_mfma_f32_32x32x16_bf16(pa2, PK(l2, h2), od, 0, 0, 0);
    od = __builtin_amdgcn_mfma_f32_32x32x16_bf16(pa3, PK(l3, h3), od, 0, 0, 0);
#undef PK
}
__device__ __forceinline__ void pv_d0(f32x16* o, int vb, bf16x8 pa0, bf16x8 pa1, bf16x8 pa2, bf16x8 pa3) {
    pv_one<0>(o[0], vb, pa0, pa1, pa2, pa3); pv_one<1>(o[1], vb, pa0, pa1, pa2, pa3); pv_one<2>(o[2], vb, pa0, pa1, pa2, pa3); pv_one<3>(o[3], vb, pa0, pa1, pa2, pa3);
}

__device__ __forceinline__ void attn_pass(const bf16* __restrict__ Qb, const bf16* __restrict__ Kh, const bf16* __restrict__ Vh, char* lds, f32x16 (&o)[4], float& l_out) {
    int tid_ = threadIdx.x; asm volatile("" : "+v"(tid_));
    const int tid = tid_, wid = tid >> 6, lane = tid & 63, r32 = lane & 31, hi = lane >> 5;
    char* V_lds = lds + OFF_V; char* K_lds = lds + OFF_K;
    float* ws = (float*)(lds + OFF_WS) + wid * 64; float* al_l = ws + 32;
    float m_reg = -1e30f, l_reg = 0.f; bf16x8 qr[4];
#pragma unroll
    for (int d = 0; d < 4; ++d) o[d] = f32x16{};
    const GAS bf16* Qw = (const GAS bf16*)Qb + (size_t)(wid * QBLK + r32) * LDQK + hi * 8;
#pragma unroll
    for (int d0 = 0; d0 < 4; ++d0) qr[d0] = *(const GAS bf16x8*)(Qw + d0 * 16);
    const int sr = tid >> 4, sc = (tid & 15) * 8, vst0 = v_st(sr, sc), vst1 = v_st(32 + sr, sc);
    const int kr = tid >> 3, kc = (tid & 7) * 16, kst = KSWZ(kr, kc);
    const int vb0 = (int)(uintptr_t)V_lds + v_rd_base(lane);
    const GAS bf16* Kg = (const GAS bf16*)Kh + (size_t)kr * LDQK + (tid & 7) * 8;
    const GAS bf16* Vg = (const GAS bf16*)Vh + (size_t)sr * LDV + sc;
    struct { bf16x8 vs0, vs1, ks0; } sr_[2];
#define SLOAD(i, k0) do { sr_[i].vs0 = *(const GAS bf16x8*)(Vg + (size_t)(k0) * LDV); sr_[i].vs1 = *(const GAS bf16x8*)(Vg + (size_t)((k0) + 32) * LDV); \
    sr_[i].ks0 = *(const GAS bf16x8*)(Kg + (size_t)(k0) * LDQK); } while (0)
#define SWRITE(b, i) do { *(bf16x8*)(V_lds + (b) * SHM_V + vst0) = sr_[i].vs0; *(bf16x8*)(V_lds + (b) * SHM_V + vst1) = sr_[i].vs1; \
    *(bf16x8*)(K_lds + (b) * SHM_K + kst) = sr_[i].ks0; } while (0)
#define SWAIT() asm volatile("s_waitcnt vmcnt(3)" ::: "memory")
#define RESC(a) do { if (__any((a) < 1.f)) { if (hi == 0) al_l[r32] = (a); asm volatile("s_waitcnt lgkmcnt(0)" ::: "memory"); \
    _Pragma("unroll") for (int d = 0; d < 4; ++d) _Pragma("unroll") for (int r = 0; r < 16; ++r) o[d][r] *= al_l[crow(r, hi)]; } } while (0)
    f32x16 pA0, pA1, pB0, pB1; float alA, alB; bf16x8 pa0, pa1, pa2, pa3; constexpr int NT = SEQ / KVBLK;
    constexpr int SE = 0, SO = 1;
    SLOAD(SE, 0); asm volatile("s_waitcnt vmcnt(0)" ::: "memory"); SWRITE(0, SE); __syncthreads();
    qkt(pA0, pA1, K_lds, qr, r32, hi); partialSM(pA0, pA1, m_reg, alA);
    SLOAD(SO, KVBLK); SLOAD(SE, 2 * KVBLK);
    SWAIT(); SWRITE(1, SO); __syncthreads();
    for (int j = 1; j + 1 < NT; j += 2) {
        SBAR(); qkt(pB0, pB1, K_lds + SHM_K, qr, r32, hi);
        finishSM(pA0, pA1, alA, l_reg, pa0, pa1, pa2, pa3); SBAR();
        SLOAD(SO, (j + 2) * KVBLK); SBAR();
        pv_d0(o, vb0, pa0, pa1, pa2, pa3); partialSM(pB0, pB1, m_reg, alB);
        __syncthreads(); SWAIT(); SWRITE(0, SE);
        RESC(alB); __syncthreads();
        SBAR(); qkt(pA0, pA1, K_lds, qr, r32, hi);
        finishSM(pB0, pB1, alB, l_reg, pa0, pa1, pa2, pa3); SBAR();
        if (j + 3 < NT) SLOAD(SE, (j + 3) * KVBLK); SBAR();
        pv_d0(o, vb0 + SHM_V, pa0, pa1, pa2, pa3); partialSM(pA0, pA1, m_reg, alA);
        __syncthreads(); SWAIT(); SWRITE(1, SO);
        RESC(alA); __syncthreads();
    }
    SBAR(); qkt(pB0, pB1, K_lds + SHM_K, qr, r32, hi);
    finishSM(pA0, pA1, alA, l_reg, pa0, pa1, pa2, pa3); SBAR();
    pv_d0(o, vb0, pa0, pa1, pa2, pa3); partialSM(pB0, pB1, m_reg, alB);
    __syncthreads(); RESC(alB);
    finishSM(pB0, pB1, alB, l_reg, pa0, pa1, pa2, pa3); SBAR();
    pv_d0(o, vb0 + SHM_V, pa0, pa1, pa2, pa3);
    l_out = l_reg;
    __syncthreads();
#undef SLOAD
#undef SWRITE
#undef SWAIT
#undef RESC
}

constexpr int F_OFF_WS = 4 * SHM_V + 4 * SHM_K;
template <int G> __device__ __forceinline__ void pv_rd(s16x4 (&lo)[4], s16x4 (&hh)[4], int vb) {
    lo[0] = tr_read<v_rd_off(G, 0, 0)>(vb); hh[0] = tr_read<v_rd_off(G, 0, 1)>(vb); lo[1] = tr_read<v_rd_off(G, 1, 0)>(vb); hh[1] = tr_read<v_rd_off(G, 1, 1)>(vb);
    lo[2] = tr_read<v_rd_off(G, 2, 0)>(vb); hh[2] = tr_read<v_rd_off(G, 2, 1)>(vb); lo[3] = tr_read<v_rd_off(G, 3, 0)>(vb); hh[3] = tr_read<v_rd_off(G, 3, 1)>(vb);
}
__device__ __forceinline__ void pv_mm(f32x16& od, const s16x4 (&lo)[4], const s16x4 (&hh)[4], bf16x8 pa0, bf16x8 pa1, bf16x8 pa2, bf16x8 pa3) {
#define PK(L, H) (bf16x8){L[0], L[1], L[2], L[3], H[0], H[1], H[2], H[3]}
    od = __builtin_amdgcn_mfma_f32_32x32x16_bf16(pa0, PK(lo[0], hh[0]), od, 0, 0, 0);
    od = __builtin_amdgcn_mfma_f32_32x32x16_bf16(pa1, PK(lo[1], hh[1]), od, 0, 0, 0);
    od = __builtin_amdgcn_mfma_f32_32x32x16_bf16(pa2, PK(lo[2], hh[2]), od, 0, 0, 0);
    od = __builtin_amdgcn_mfma_f32_32x32x16_bf16(pa3, PK(lo[3], hh[3]), od, 0, 0, 0);
#undef PK
}
template <int OFF> __device__ __forceinline__ bf16x8 lds_rd128(int addr) { bf16x8 r; asm volatile("ds_read_b128 %0, %1 offset:%2" : "=&v"(r) : "v"(addr), "i"(OFF) : "memory"); return r; }
__device__ __forceinline__ float fadd_s(float a, float b) { float r; asm("v_add_f32_e32 %0, %1, %2" : "=v"(r) : "v"(a), "v"(b)); return r; }
constexpr int F_NSLOT = 4;
constexpr int F2_OFF_V = 0, F2_OFF_K = F_NSLOT * SHM_V, F2_END = F2_OFF_K + F_NSLOT * SHM_K;
static_assert(F2_END <= F_OFF_WS, "attention rings below the per-wave scratch");
template <int ABL> __device__ __forceinline__ void attn_pass_fast(const bf16* __restrict__ Qb, const bf16* __restrict__ Kh, const bf16* __restrict__ Vh, char* lds, f32x16 (&o)[4], float& l_out) {
    int tid_ = threadIdx.x; asm volatile("" : "+v"(tid_));
    const int tid = tid_, wid = __builtin_amdgcn_readfirstlane(tid >> 6), lane = tid & 63, r32 = lane & 31, hi = lane >> 5; const bool trail = wid >= 4;
    LAS unsigned char* ldsl = (LAS unsigned char*)(unsigned)(uintptr_t)lds;
    bf16x8 qr[4];
#pragma unroll
    for (int d = 0; d < 4; ++d) o[d] = f32x16{};
    const GAS bf16* Qw = (const GAS bf16*)Qb + (size_t)(wid * QBLK + r32) * LDQK + hi * 8;
#pragma unroll
    for (int d0 = 0; d0 < 4; ++d0) qr[d0] = *(const GAS bf16x8*)(Qw + d0 * 16);
    const int krow = wid * 8 + (lane >> 3), kpos = lane & 7;
    const GAS bf16* Kg = (const GAS bf16*)Kh + (size_t)krow * LDQK + ((kpos ^ ((krow >> 1) & 7)) * 8);
    const int vsub0 = 4 * wid + (lane >> 5), vsub1 = vsub0 + 2;
    const int vkk0 = (vsub0 >> 2) * 8 + ((lane & 31) >> 2), vkk1 = (vsub1 >> 2) * 8 + ((lane & 31) >> 2);
    const GAS bf16* Vg0 = (const GAS bf16*)Vh + (size_t)vkk0 * LDV + (vsub0 & 3) * 32 + (lane & 3) * 8;
    const GAS bf16* Vg1 = (const GAS bf16*)Vh + (size_t)vkk1 * LDV + (vsub1 & 3) * 32 + (lane & 3) * 8;
    const int vb0 = (int)(unsigned)(uintptr_t)(lds + F2_OFF_V) + v_rd_base(lane);
    const int kbase = (int)(unsigned)(uintptr_t)(lds + F2_OFF_K);
    const int ka0 = kbase + KSWZ(r32, (0 * 16 + hi * 8) * 2), ka1 = kbase + KSWZ(r32, (1 * 16 + hi * 8) * 2), ka2 = kbase + KSWZ(r32, (2 * 16 + hi * 8) * 2), ka3 = kbase + KSWZ(r32, (3 * 16 + hi * 8) * 2);
    constexpr int NT = SEQ / KVBLK;
#define FBAR() do { asm volatile("s_waitcnt lgkmcnt(0)\n\ts_barrier" ::: "memory"); SBAR(); } while (0)
#define DMA_K(t, slot) __builtin_amdgcn_global_load_lds((const GAS unsigned*)(Kg + (size_t)(t) * KVBLK * LDQK), (LAS unsigned*)(ldsl + F2_OFF_K + (slot) * SHM_K + wid * 1024), 16, 0, 0)
#define DMA_V(t, slot) do { __builtin_amdgcn_global_load_lds((const GAS unsigned*)(Vg0 + (size_t)(t) * KVBLK * LDV), (LAS unsigned*)(ldsl + F2_OFF_V + (slot) * SHM_V + wid * 2048), 16, 0, 0); \
    __builtin_amdgcn_global_load_lds((const GAS unsigned*)(Vg1 + (size_t)(t) * KVBLK * LDV), (LAS unsigned*)(ldsl + F2_OFF_V + (slot) * SHM_V + wid * 2048 + 1024), 16, 0, 0); } while (0)
#define KREAD(kb) do { kf[0] = lds_rd128<0>(ka0 + (kb)); kf[1] = lds_rd128<4096>(ka0 + (kb)); kf[2] = lds_rd128<0>(ka1 + (kb)); kf[3] = lds_rd128<4096>(ka1 + (kb)); \
    kf[4] = lds_rd128<0>(ka2 + (kb)); kf[5] = lds_rd128<4096>(ka2 + (kb)); kf[6] = lds_rd128<0>(ka3 + (kb)); kf[7] = lds_rd128<4096>(ka3 + (kb)); } while (0)
#define QKT() do { p0 = __builtin_amdgcn_mfma_f32_32x32x16_bf16(kf[0], qr[0], f32x16{}, 0, 0, 0); p1 = __builtin_amdgcn_mfma_f32_32x32x16_bf16(kf[1], qr[0], f32x16{}, 0, 0, 0); \
    p0 = __builtin_amdgcn_mfma_f32_32x32x16_bf16(kf[2], qr[1], p0, 0, 0, 0); p1 = __builtin_amdgcn_mfma_f32_32x32x16_bf16(kf[3], qr[1], p1, 0, 0, 0); \
    p0 = __builtin_amdgcn_mfma_f32_32x32x16_bf16(kf[4], qr[2], p0, 0, 0, 0); p1 = __builtin_amdgcn_mfma_f32_32x32x16_bf16(kf[5], qr[2], p1, 0, 0, 0); \
    p0 = __builtin_amdgcn_mfma_f32_32x32x16_bf16(kf[6], qr[3], p0, 0, 0, 0); p1 = __builtin_amdgcn_mfma_f32_32x32x16_bf16(kf[7], qr[3], p1, 0, 0, 0); } while (0)
    bf16x8 kf[8];
    DMA_K(0, 0); DMA_K(1, 1); DMA_K(2, 2); DMA_V(0, 0); DMA_V(1, 1);
    asm volatile("s_waitcnt vmcnt(0)" ::: "memory");
    __syncthreads();
    if (trail) FBAR();
    f32x16 p0, p1; bf16x8 pa0, pa1, pa2, pa3; float l_reg = 0.f;
    KREAD(0); asm volatile("s_waitcnt lgkmcnt(0)" ::: "memory"); SBAR();
#define EXP8(P, B) do { _Pragma("unroll") for (int r_ = 0; r_ < 8; ++r_) P[(B) + r_] = __builtin_amdgcn_exp2f(P[(B) + r_]); } while (0)
    QKT();
    EXP8(p0, 0); EXP8(p0, 8); EXP8(p1, 0); EXP8(p1, 8);
    FBAR();
    int ks_w = 3, vs_w = 2;
    int kb_r = SHM_K, vb_r = 0;
    s16x4 la[4], ha[4], lb[4], hb[4];
#pragma unroll 1
    for (int x = 0; x < NT; ++x) {
        const int vb = vb0 + vb_r;
        if (x + 1 < NT) KREAD(kb_r);
        pv_rd<0>(la, ha, vb); pv_rd<1>(lb, hb, vb);
        if (x + 3 < NT) DMA_K(x + 3, ks_w);
        if (x + 2 < NT) DMA_V(x + 2, vs_w);
        { float a = fadd_s(p0[0], p0[1]), b = fadd_s(p0[2], p0[3]), c = fadd_s(p1[0], p1[1]), d = fadd_s(p1[2], p1[3]);
#pragma unroll
          for (int r = 4; r < 16; r += 4) { a = fadd_s(a, fadd_s(p0[r], p0[r + 1])); b = fadd_s(b, fadd_s(p0[r + 2], p0[r + 3])); c = fadd_s(c, fadd_s(p1[r], p1[r + 1])); d = fadd_s(d, fadd_s(p1[r + 2], p1[r + 3])); }
          l_reg = fadd_s(l_reg, fadd_s(fadd_s(a, b), fadd_s(c, d))); }
        { u32x4 w;
          w = (u32x4){cvtpk(p0[0], p0[1]), cvtpk(p0[2], p0[3]), cvtpk(p0[4], p0[5]), cvtpk(p0[6], p0[7])}; pa0 = __builtin_bit_cast(bf16x8, w);
          w = (u32x4){cvtpk(p0[8], p0[9]), cvtpk(p0[10], p0[11]), cvtpk(p0[12], p0[13]), cvtpk(p0[14], p0[15])}; pa1 = __builtin_bit_cast(bf16x8, w);
          w = (u32x4){cvtpk(p1[0], p1[1]), cvtpk(p1[2], p1[3]), cvtpk(p1[4], p1[5]), cvtpk(p1[6], p1[7])}; pa2 = __builtin_bit_cast(bf16x8, w);
          w = (u32x4){cvtpk(p1[8], p1[9]), cvtpk(p1[10], p1[11]), cvtpk(p1[12], p1[13]), cvtpk(p1[14], p1[15])}; pa3 = __builtin_bit_cast(bf16x8, w); }
        if (x + 3 < NT) asm volatile("s_waitcnt vmcnt(3)" ::: "memory"); else asm volatile("s_waitcnt vmcnt(0)" ::: "memory");
        FBAR();
        __builtin_amdgcn_s_setprio(2);
#define MIX4() do { _Pragma("unroll") for (int i_ = 0; i_ < 4; ++i_) { __builtin_amdgcn_sched_group_barrier(0x008, 1, 0); __builtin_amdgcn_sched_group_barrier(0x400, 2, 0); } } while (0)
        if (x + 1 < NT) QKT();
        SBAR();
        pv_mm(o[0], la, ha, pa0, pa1, pa2, pa3);
        EXP8(p0, 0);
        MIX4(); SBAR();
        pv_rd<2>(la, ha, vb);
        pv_mm(o[1], lb, hb, pa0, pa1, pa2, pa3);
        EXP8(p0, 8);
        MIX4(); SBAR();
        pv_rd<3>(lb, hb, vb);
        __builtin_amdgcn_s_setprio(0);
        asm volatile("s_waitcnt lgkmcnt(8)" ::: "memory"); SBAR();
        pv_mm(o[2], la, ha, pa0, pa1, pa2, pa3);
        EXP8(p1, 0);
        MIX4(); SBAR();
        asm volatile("s_waitcnt lgkmcnt(0)" ::: "memory"); SBAR();
        pv_mm(o[3], lb, hb, pa0, pa1, pa2, pa3);
        EXP8(p1, 8);
        MIX4(); SBAR();
#undef MIX4
        __builtin_amdgcn_s_setprio(0);
        ks_w = (ks_w + 1) & 3; vs_w = (vs_w + 1) & 3;
        kb_r = (kb_r + SHM_K) & (F_NSLOT * SHM_K - 1); vb_r = (vb_r + SHM_V) & (F_NSLOT * SHM_V - 1);
        FBAR();
    }
    if (!trail) FBAR();
    { auto rr = __builtin_amdgcn_permlane32_swap(__float_as_uint(l_reg), __float_as_uint(l_reg), false, false); l_reg = __uint_as_float(rr[0]) + __uint_as_float(rr[1]); }
    l_out = l_reg;
    __syncthreads();
#undef FBAR
#undef DMA_K
#undef DMA_V
#undef KREAD
#undef QKT
#undef EXP8
}

template <int ABL> __device__ __forceinline__ void attn_unit(int b, int h, int qb, const bf16* QH, const bf16* KH, const bf16* VH, bf16* YC, float* OS, const float* subg, float lam, float oscale, char* lds, bool fast) {
    int tid_ = threadIdx.x; asm volatile("" : "+v"(tid_));
    const int tid = tid_, wid = tid >> 6, lane = tid & 63, r32 = lane & 31, hi = lane >> 5;
    const size_t rowbase = (size_t)b * SEQ, q0 = rowbase + (size_t)qb * 256;
    float* wsf = (float*)(lds + F_OFF_WS) + wid * 64;
#pragma unroll 1
    for (int c = 0; c < 2; ++c) {
        f32x16 o[4]; float l;
        const size_t hcb = (size_t)((b * 16 + h * 2 + c)) * SEQ; const bf16* Qp = QH + (hcb + (size_t)qb * 256) * LDQK; const bf16* Kp = KH + hcb * LDQK; const bf16* Vp = VH + (size_t)(b * 8 + h) * SEQ * LDV;
        if (fast) attn_pass_fast<ABL>(Qp, Kp, Vp, lds, o, l);
        else attn_pass(Qp, Kp, Vp, lds, o, l);
        if (hi == 0) wsf[r32] = l; asm volatile("s_waitcnt lgkmcnt(0)" ::: "memory");
        float rli[16];
#pragma unroll
        for (int r = 0; r < 16; ++r) rli[r] = 1.0f / wsf[crow(r, hi)];
        GAS float* os = (GAS float*)OS + (q0 + wid * QBLK + 4 * hi) * GW + h * 128 + r32;
        asm volatile("" : "+v"(os));
        if (c == 0) {
#pragma unroll
            for (int r = 0; r < 16; ++r) { GAS float* p = os + ((r & 3) + 8 * (r >> 2)) * GW; asm volatile("" : "+v"(p));
#pragma unroll
                for (int d0 = 0; d0 < 4; ++d0) p[d0 * 32] = o[d0][r] * rli[r]; }
        } else {
            float ssq[16], ov[16][4];
#pragma unroll
            for (int r = 0; r < 16; ++r) { const GAS float* p = os + ((r & 3) + 8 * (r >> 2)) * GW; asm volatile("" : "+v"(p));
#pragma unroll
                for (int d0 = 0; d0 < 4; ++d0) ov[r][d0] = p[d0 * 32]; }
#pragma unroll
            for (int r = 0; r < 16; ++r) { float s = 0.f;
#pragma unroll
                for (int d0 = 0; d0 < 4; ++d0) { const float v = ov[r][d0] - lam * (o[d0][r] * rli[r]); o[d0][r] = v; s += v * v; }
                ssq[r] = s; }
#pragma unroll
            for (int r = 0; r < 16; ++r) { float s = ssq[r]; s += __shfl_xor(s, 1); s += __shfl_xor(s, 2); s += __shfl_xor(s, 4); s += __shfl_xor(s, 8); s += __shfl_xor(s, 16);
                ssq[r] = oscale / sqrtf(s * (1.f / 128.f) + 1e-6f); }
            GAS bf16* yo = (GAS bf16*)YC + (q0 + wid * QBLK + 4 * hi) * DM + YC_D + h * 128 + r32;
            asm volatile("" : "+v"(yo));
#pragma unroll
            for (int r = 0; r < 16; ++r) { GAS bf16* p = yo + ((r & 3) + 8 * (r >> 2)) * DM; asm volatile("" : "+v"(p));
#pragma unroll
                for (int d0 = 0; d0 < 4; ++d0) p[d0 * 32] = (bf16)f2bf(o[d0][r] * ssq[r] * subg[d0 * 32 + r32]); }
        }
        asm volatile("s_waitcnt vmcnt(0) lgkmcnt(0)" ::: "memory");
    }
}
#undef KSWZ
#undef SBAR
}

__global__ void __launch_bounds__(NWAVES * 64, 2) hybrid_fwd(Args args) {
    extern __shared__ __attribute__((aligned(16))) unsigned char lds[];
    Frame F;
    F.lds = (LAS unsigned char*)lds;
    F.MISC = (volatile LAS unsigned*)(F.lds + MISC_OFF);
    F.tid = threadIdx.x; F.lane = F.tid & 63; F.wave = __builtin_amdgcn_readfirstlane(F.tid >> 6);
    F.G = gridDim.x; { const int bx = blockIdx.x; F.vcu = (F.G % 8 == 0) ? (bx % 8) * (F.G / 8) + bx / 8 : bx; }
    unsigned char* ws = args.ws;
    F.ctl = (gu32*)(ws + WS_CTL);
    for (int u = F.tid; u < (LDS_BYTES - LDSCTL_OFF) / 4; u += NWAVES * 64) ((LAS unsigned*)(F.lds + LDSCTL_OFF))[u] = 0u;
    __syncthreads();
#if MK_SPLIT
#define GRID_BAR() do { } while (0)
#else
    XcdBarrier bar = xcd_barrier_post((unsigned*)(F.ctl + CW_BAR), F.MISC + 8);
#define GRID_BAR() xcd_barrier(bar)
#endif
    const int lo = args.ph_lo, hi = args.ph_hi;
#ifndef PH_MASK
#define PH_MASK 0x1FF
#endif
#define IN(k) (lo <= (k) && (k) < hi)
#define PM(b) ((PH_MASK >> (b)) & 1)
#ifndef LM
#define LM 15
#endif
#ifndef PROBE_DUP
#define PROBE_DUP 0
#endif
#define DUP(b) ((PROBE_DUP >> (b)) & 1)
#ifndef PROBE_XBAR
#define PROBE_XBAR 0
#endif
#define SEAM(k, DI) do { if ((k) + 1 < hi) { seam_steal(F, args, bar, (DI)); for (int xb_ = 0; xb_ < PROBE_XBAR; ++xb_) GRID_BAR(); } } while (0)

    bf16* const XN = (bf16*)(ws + WS_XN); bf16* const Z = (bf16*)(ws + WS_Z); bf16* const YC = (bf16*)(ws + WS_YC); bf16* const HB = (bf16*)(ws + WS_HB);
    float* const OS = (float*)(ws + WS_OS); const float* const rope = (const float*)(ws + WS_ROPE);
    const float* const x_in = args.in[0]; float* const out = args.out;

    bf16* const XB = XN; float* const SS = (float*)(ws + WS_SS);
    if (PM(8) && IN(0)) { p0_prologue(F, args); xprep_phase(F, x_in, XB, SS); if (DUP(8)) { p0_prologue(F, args); xprep_phase(F, x_in, XB, SS); } SEAM(0, 0); }

#define FRESH() do { int t_ = threadIdx.x; asm volatile("" : "+v"(t_)); F.tid = t_; F.lane = t_ & 63; F.wave = __builtin_amdgcn_readfirstlane(t_ >> 6); } while (0)
    for (int l = 0; l < NLAYER; ++l) {
        const int pb = 1 + 5 * l;
        const float* xcur = (l == 0) ? x_in : out;
        const LAS float* rstab = (const LAS float*)(F.lds + RSTAB_OFF);
        if (PM(0) && IN(pb + 0)) { FRESH();
            pg8::Gemm g{XB, (const bf16*)(ws + WS_WIN) + (size_t)l * DIN * DM, M, DIN, DM}; pg8::StaticOrder S; S.init(M, DIN, F.G, (int)blockIdx.x);
            { pg8::Unit u0; S.next(0, u0); rs_table(F, SS, u0.pm); }
            pg8::EpiZ E{Z, DIN, rstab, (float*)(ws + WS_SV), args.in[13] + l * 64, args.in[14] + l * 64, rope, QSCALE, SEQ - 1, 13, (bf16*)(ws + WS_QH), (bf16*)(ws + WS_KH), (bf16*)(ws + WS_VH)};
            pg8::gemm_phase<pg8::EpiZ, pg8::StaticOrder, true, true>(F.lds + RING_OFF, g, S, E);
            if (DUP(0)) pg8::gemm_phase<pg8::EpiZ, pg8::StaticOrder, true, true>(F.lds + RING_OFF, g, S, E);
            SEAM(pb + 0, 0);
        }
        if (PM(2) && IN(pb + 1)) { FRESH();
            float s1 = 0.f, s2 = 0.f;
            for (int i = 0; i < 64; ++i) { s1 += args.in[15][l * 64 + i] * args.in[16][l * 64 + i]; s2 += args.in[17][l * 64 + i] * args.in[18][l * 64 + i]; }
            const float lam_init = (l == 0) ? 0.2f : 0.35550907f;
            const float lam = expf(s1) - expf(s2) + lam_init;
            float gqm = 0.f, gkm = 0.f;
            for (int i = 0; i < 64; ++i) { gqm = fmaxf(gqm, fabsf(args.in[13][l * 64 + i])); gkm = fmaxf(gkm, fabsf(args.in[14][l * 64 + i])); }
            const bool fastsm = (64.0f * gqm * gkm * QSCALE * 1.02f) < 40.0f;
#ifndef ATT_ABL
#define ATT_ABL 0
#endif
            if (DUP(2)) for (int U = F.vcu; U < BATCH * 8 * (SEQ / 256); U += F.G) {
                const int xg = (U % 256) / 32, i = U / 256, qb = U % 32, bh = xg * 2 + i;
                att::attn_unit<ATT_ABL>(bh >> 3, bh & 7, qb, (const bf16*)(ws + WS_QH), (const bf16*)(ws + WS_KH), (const bf16*)(ws + WS_VH), HB, (float*)(ws + WS_HB + 256 * MiB), args.in[19] + l * 128, lam, 1.0f - lam_init, (char*)lds + RING_OFF, fastsm);
            }
            for (int U = F.vcu; U < BATCH * 8 * (SEQ / 256); U += F.G) {
                const int xg = (U % 256) / 32, i = U / 256, qb = U % 32, bh = xg * 2 + i;
                att::attn_unit<0>(bh >> 3, bh & 7, qb, (const bf16*)(ws + WS_QH), (const bf16*)(ws + WS_KH), (const bf16*)(ws + WS_VH), YC, OS, args.in[19] + l * 128, lam, 1.0f - lam_init, (char*)lds + RING_OFF, fastsm);
            }
        }
        if (PM(1) && IN(pb + 1)) { FRESH();
            for (int rep = 0; rep < 1 + DUP(1); ++rep) { FRESH();
            if (LM & 2) for (int u = F.vcu; u < (M / 128) * 4; u += F.G) gmlp_unit(F, Z, YC, (const float*)(ws + WS_SV), (const bf16*)(ws + WS_GWS) + (size_t)l * 8 * 128 * 128, args.in[6] + l * 8 * 128, args.in[3] + l * GW, args.in[4] + l * GW, u, (char*)lds);
            FRESH();
            if (LM & 4) for (int u = F.vcu; u < M / 32; u += F.G) conv_unit(F, Z, YC, args.in[7] + (size_t)l * 31 * GW, args.in[8] + l * GW, args.in[9] + l * GW, args.in[10] + l * GW, u);
            FRESH();
            if (LM & 8) for (int u = F.vcu; u < (M / 64) * 4; u += F.G) pool_unit(F, Z, YC, (const bf16*)(ws + WS_PWT) + (size_t)l * 4 * 65536, args.in[12] + l * GW, u);
            }
            SEAM(pb + 1, cv_deadline(l, 1));
        }
        if (PM(3) && IN(pb + 2)) { FRESH();
            pg8::Gemm g{YC, (const bf16*)(ws + WS_WOUT) + (size_t)l * DM * DM, M, DM, DM}; pg8::StaticOrder S; S.init(M, DM, F.G, (int)blockIdx.x);
            if (l == 0) { typedef pg8::EpiRes<false, false> E_t; E_t E{x_in, nullptr, DM, XB, SS};
                if (DUP(3)) { E_t E2{x_in, nullptr, DM, HB, OS}; pg8::gemm_phase<E_t, pg8::StaticOrder, true, true>(F.lds + RING_OFF, g, S, E2); }
                pg8::gemm_phase<E_t, pg8::StaticOrder, true, true>(F.lds + RING_OFF, g, S, E); }
            else { typedef pg8::EpiRes<true, false> E_t; E_t E{XB, nullptr, DM, XB, SS};
                if (DUP(3)) { E_t E2{XB, nullptr, DM, HB, OS}; pg8::gemm_phase<E_t, pg8::StaticOrder, true, true>(F.lds + RING_OFF, g, S, E2); }
                pg8::gemm_phase<E_t, pg8::StaticOrder, true, true>(F.lds + RING_OFF, g, S, E); }
            SEAM(pb + 2, cv_deadline(l, 2));
        }
        if (PM(4) && IN(pb + 3)) { FRESH();
            pg8::Gemm g{XB, (const bf16*)(ws + WS_WUP) + (size_t)l * DFF * DM, M, DFF, DM}; pg8::StaticOrder S; S.init(M, DFF, F.G, (int)blockIdx.x);
            { pg8::Unit u0; S.next(0, u0); rs_table(F, SS, u0.pm); }
            pg8::EpiRelu2 E{HB, DFF, rstab};
#ifdef PROBE_SPLIT_UP
            { pg8::StaticOrder S1 = S; S1.i1 = 8; pg8::gemm_phase<pg8::EpiRelu2, pg8::StaticOrder, true, true>(F.lds + RING_OFF, g, S1, E); GRID_BAR();
              pg8::StaticOrder S2 = S; S2.i0 = 8; pg8::gemm_phase<pg8::EpiRelu2, pg8::StaticOrder, true, true>(F.lds + RING_OFF, g, S2, E); }
#else
            pg8::gemm_phase<pg8::EpiRelu2, pg8::StaticOrder, true, true>(F.lds + RING_OFF, g, S, E);
#endif
            if (DUP(4)) { if (DUP(10)) { pg8::EpiRelu2T<true> E2{(bf16*)Z, DFF, rstab}; pg8::gemm_phase<pg8::EpiRelu2T<true>, pg8::StaticOrder, true, true>(F.lds + RING_OFF, g, S, E2); }
                          else pg8::gemm_phase<pg8::EpiRelu2, pg8::StaticOrder, true, true>(F.lds + RING_OFF, g, S, E); }
            SEAM(pb + 3, cv_deadline(l, 3));
        }
        if (PM(5) && IN(pb + 4)) { FRESH();
            pg8::Gemm g{HB, (const bf16*)(ws + WS_WDN) + (size_t)l * DM * DFF, M, DM, DFF}; pg8::StaticOrder S; S.init(M, DM, F.G, (int)blockIdx.x);
            if (l + 1 < NLAYER) { typedef pg8::EpiRes<true, false> E_t; E_t E{XB, nullptr, DM, XB, SS};
                if (DUP(5)) { E_t E2{XB, nullptr, DM, YC, OS}; pg8::gemm_phase<E_t, pg8::StaticOrder, true, true>(F.lds + RING_OFF, g, S, E2); }
                pg8::gemm_phase<E_t, pg8::StaticOrder, true, true>(F.lds + RING_OFF, g, S, E); }
            else { typedef pg8::EpiRes<true, true> E_t; E_t E{XB, out, DM, nullptr, nullptr};
                if (DUP(5)) { E_t E2{XB, (float*)Z, DM, nullptr, nullptr}; pg8::gemm_phase<E_t, pg8::StaticOrder, true, true>(F.lds + RING_OFF, g, S, E2); }
                pg8::gemm_phase<E_t, pg8::StaticOrder, true, true>(F.lds + RING_OFF, g, S, E); }
            SEAM(pb + 4, cv_deadline(l + 1, 0));
        }
    }
#ifdef DIAG_STEAL
    if (blockIdx.x == 0 && threadIdx.x == 0) { asm volatile("s_waitcnt vmcnt(0)" ::: "memory"); const unsigned cnt = xb_ld((unsigned*)(F.ctl + CW_Q + 1024)); out[0] = 1000.0f * (float)cnt / (float)CV_TOTAL; }
#endif
#undef IN
#undef SEAM
}

constexpr int N_PHASES = 1 + 5 * NLAYER;
extern "C" void kernel_launch(void* const* d_in, const int* in_sizes, int n_in, void* d_out, int out_size, void* d_ws, size_t ws_size, hipStream_t stream) {
    static int grid = 0;
    if (grid == 0) {
        if (n_in != 24 || in_sizes[0] != M * DM || out_size != M * DM || ws_size < WS_END) { fprintf(stderr, "kernel_launch: unexpected shapes (n_in %d, in0 %d, out %d, ws %zu; need ws >= %zu); nothing launched\n", n_in, n_in > 0 ? in_sizes[0] : -1, out_size, ws_size, (size_t)WS_END); grid = -1; return; }
        int dev = 0, cus = 0, per_cu = 0;
        if (hipGetDevice(&dev) != hipSuccess || hipDeviceGetAttribute(&cus, hipDeviceAttributeMultiprocessorCount, dev) != hipSuccess) { fprintf(stderr, "kernel_launch: device query failed\n"); grid = -1; return; }
        if (hipFuncSetAttribute((const void*)hybrid_fwd, hipFuncAttributeMaxDynamicSharedMemorySize, LDS_BYTES) != hipSuccess) { fprintf(stderr, "kernel_launch: hipFuncSetAttribute failed\n"); grid = -1; return; }
        if (hipOccupancyMaxActiveBlocksPerMultiprocessor(&per_cu, (const void*)hybrid_fwd, NWAVES * 64, LDS_BYTES) != hipSuccess || per_cu < 1)
            fprintf(stderr, "kernel_launch: note: occupancy query reports %d workgroups per CU\n", per_cu);
        (void)hipGetLastError();
        grid = cus;
        if (grid != 256) { fprintf(stderr, "kernel_launch: built for a 256-CU device (one row panel per workgroup in every GEMM phase); found %d CUs; nothing launched\n", cus); grid = -1; return; }
    }
    if (grid < 0) return;
    if (hipMemsetAsync((char*)d_ws + WS_CTL, 0, CTL_ZERO_BYTES, stream) != hipSuccess) { fprintf(stderr, "kernel_launch: memset failed\n"); return; }
    Args a{};
    for (int i = 0; i < 24; ++i) a.in[i] = (const float*)d_in[i];
    a.out = (float*)d_out; a.ws = (unsigned char*)d_ws;
#if MK_SPLIT
    for (int p = 0; p < N_PHASES; ++p) { a.ph_lo = p; a.ph_hi = p + 1; hipLaunchKernelGGL(hybrid_fwd, dim3(grid), dim3(NWAVES * 64), LDS_BYTES, stream, a); }
#else
    a.ph_lo = 0; a.ph_hi = N_PHASES; hipLaunchKernelGGL(hybrid_fwd, dim3(grid), dim3(NWAVES * 64), LDS_BYTES, stream, a);
#endif
    const hipError_t le = hipPeekAtLastError();
    if (le != hipSuccess) fprintf(stderr, "kernel_launch: launch failed: %s\n", hipGetErrorName(le));
}
```

```cpp
#include <hip/hip_runtime.h>
#include <cstdio>
#include <cstdint>
#include <type_traits>
namespace pg8 {
#define PG8_LAS __attribute__((address_space(3)))
typedef unsigned short bf16_t;
typedef short bf16x8 __attribute__((ext_vector_type(8)));
typedef float f32x4 __attribute__((ext_vector_type(4)));
typedef unsigned u32x4 __attribute__((ext_vector_type(4)));
constexpr int BM = 256, BK = 64, HALF = 128, HTB = HALF * BK * 2  , STAGE_BYTES = 8 * HTB, NXCD = 8, WGM = 8;

__host__ __device__ __forceinline__ int lds_byte(int r, int c) { const int st = (r >> 4) * 2 + (c >> 5), rr = r & 15, cc = c & 31, ob = rr * 64 + cc * 2; return st * 1024 + (ob ^ (((ob >> 9) & 1) << 5)); }
__host__ __device__ __forceinline__ void stage_rc(int b, int& R, int& C) { const int st = b / 1024, sb = b % 1024, swz = sb ^ (((sb >> 9) & 1) << 5); R = (st >> 1) * 16 + swz / 64; C = (st & 1) * 32 + (swz % 64) / 2; }
__host__ __device__ __forceinline__ int perm32(int rho) { const int n = rho >> 4, i = rho & 15; return 8 * (i >> 2) + 4 * n + (i & 3); }

struct Unit { int pm, pn; };
struct Gemm { const bf16_t* A; const bf16_t* Bt; int M, N, K; };

struct StaticOrder {
    int nM, nN, nwg, G, c, i0 = 0, i1 = 1 << 30;
    __host__ __device__ __forceinline__ void init(int M, int N, int G_, int c_) { nM = M / BM; nN = N / BM; nwg = nM * nN; G = G_; c = c_; }
    __host__ __device__ __forceinline__ bool next(int i_, Unit& u) const {
        const int i = i_ + i0; if (i >= i1) return false;
        const long L = (long)i * G + c; if (L >= nwg) return false;
        int wgid = (int)L; { const int q = nwg / NXCD, r = nwg % NXCD, xcd = wgid % NXCD, off = wgid / NXCD; wgid = (xcd < r ? xcd * (q + 1) : r * (q + 1) + (xcd - r) * q) + off; }
        const int nig = WGM * nN, gid = wgid / nig, fm = gid * WGM, gsz = (nM - fm) < WGM ? (nM - fm) : WGM;
        u.pm = fm + ((wgid % nig) % gsz); u.pn = (wgid % nig) / gsz; return true;
    }
    __device__ __forceinline__ void a_ready(const Unit&) const {}
    __device__ __forceinline__ void done(const Unit&) const {}
};

__device__ __forceinline__ unsigned cvt_pk_bf16(float lo, float hi) { unsigned r; asm volatile("v_cvt_pk_bf16_f32 %0, %1, %2" : "=v"(r) : "v"(lo), "v"(hi)); return r; }
typedef float f32x2 __attribute__((ext_vector_type(2)));
__device__ __forceinline__ f32x2 gelu_pk(f32x2 v) {
    const f32x2 av = __builtin_elementwise_abs(v), d = av * 0.2316418882f + 1.0f;
    f32x2 t; t.x = __builtin_amdgcn_rcpf(d.x); t.y = __builtin_amdgcn_rcpf(d.y);
    f32x2 q = t * 0.5307027145f + (-0.7265760135f); q = q * t + 0.7107068705f; q = q * t + (-0.142248368f); q = q * t + 0.127414796f; q = q * t;
    const f32x2 s = (v * v) * (-0.72134752044f);
    f32x2 e; e.x = __builtin_amdgcn_exp2f(s.x); e.y = __builtin_amdgcn_exp2f(s.y);
    const f32x2 m = v * (q * e), r = v - m;
    f32x2 o; o.x = v.x < 0.f ? m.x : r.x; o.y = v.y < 0.f ? m.y : r.y; return o;
}

template <int ACT  > struct EpiBf16 {
    static constexpr bool PERM = true, AFTER_DRAIN = false; static_assert(ACT == 0 || ACT == 1, "EpiBf16: ACT is 0 (none) or 1 (gelu_pk)");
    bf16_t* O; int ldc; const float* bias; int split_cols; size_t split_stride; float scale0;
    __device__ __forceinline__ void operator()(const f32x4 (&acc)[2][2][4][2], const Unit& u, int wr, int wc, int fr, int fq) const {
        const int row0 = u.pm * BM + wr * 64 + fr; int colt = u.pn * BM; bf16_t* base = O;
        float sc = 1.f; if (split_cols) { const int t = colt / split_cols; base += (size_t)t * split_stride; colt -= t * split_cols; if (t == 0) sc = scale0; }
        const int col0 = colt + wc * 32 + 8 * fq, bcol0 = u.pn * BM + wc * 32 + 8 * fq;
        f32x4 bv[2][2];
#pragma unroll
        for (int bj = 0; bj < 2; ++bj)
#pragma unroll
            for (int n = 0; n < 2; ++n) bv[bj][n] = bias ? *(const f32x4*)(bias + bcol0 + bj * HALF + 4 * n) : (f32x4){0.f, 0.f, 0.f, 0.f};
#pragma unroll
        for (int ai = 0; ai < 2; ++ai)
#pragma unroll
            for (int m = 0; m < 4; ++m) { bf16_t* rowp = base + (size_t)(row0 + ai * HALF + m * 16) * ldc + col0;
#pragma unroll
                for (int bj = 0; bj < 2; ++bj) { f32x4 v0 = acc[ai][bj][m][0] + bv[bj][0], v1 = acc[ai][bj][m][1] + bv[bj][1];
                    if (ACT == 1) { f32x2 a = gelu_pk((f32x2){v0[0], v0[1]}), b = gelu_pk((f32x2){v0[2], v0[3]}), c = gelu_pk((f32x2){v1[0], v1[1]}), d = gelu_pk((f32x2){v1[2], v1[3]});
                        v0 = (f32x4){a.x, a.y, b.x, b.y}; v1 = (f32x4){c.x, c.y, d.x, d.y}; }
                    v0 = v0 * sc; v1 = v1 * sc; u32x4 w; w.x = cvt_pk_bf16(v0[0], v0[1]); w.y = cvt_pk_bf16(v0[2], v0[3]); w.z = cvt_pk_bf16(v1[0], v1[1]); w.w = cvt_pk_bf16(v1[2], v1[3]);
                    *(u32x4*)(rowp + bj * HALF) = w; } }
    }
};

struct EpiZ {
    static constexpr bool PERM = true, AFTER_DRAIN = false;
    bf16_t* O; int ldc; const PG8_LAS float* rs; float* sv; const float* qg; const float* kg; const float* rope; float qscale; int seqmask, seqshift; bf16_t* qh; bf16_t* kh; bf16_t* vh;
    __device__ __forceinline__ void operator()(const f32x4 (&acc)[2][2][4][2], const Unit& u, int wr, int wc, int fr, int fq) const {
        const int pn = u.pn, row0 = u.pm * BM + wr * 64 + fr;
        if (pn < 8) {
            const int col0 = pn * BM + wc * 32 + 8 * fq; const bool st = pn >= 4;
#pragma unroll
            for (int ai = 0; ai < 2; ++ai)
#pragma unroll
                for (int m = 0; m < 4; ++m) { const int row = row0 + ai * HALF + m * 16; bf16_t* rowp = O + (size_t)row * ldc + col0; const float rsv = rs[ai * HALF + wr * 64 + m * 16 + fr]; float s1 = 0.f, s2 = 0.f;
#pragma unroll
                    for (int bj = 0; bj < 2; ++bj) { f32x4 v0 = acc[ai][bj][m][0] * rsv, v1 = acc[ai][bj][m][1] * rsv;
                        { f32x2 a = gelu_pk((f32x2){v0[0], v0[1]}), b = gelu_pk((f32x2){v0[2], v0[3]}), c = gelu_pk((f32x2){v1[0], v1[1]}), d = gelu_pk((f32x2){v1[2], v1[3]});
                          v0 = (f32x4){a.x, a.y, b.x, b.y}; v1 = (f32x4){c.x, c.y, d.x, d.y}; }
                        s1 += ((v0[0] + v0[1]) + (v0[2] + v0[3])) + ((v1[0] + v1[1]) + (v1[2] + v1[3]));
                        s2 += ((v0[0] * v0[0] + v0[1] * v0[1]) + (v0[2] * v0[2] + v0[3] * v0[3])) + ((v1[0] * v1[0] + v1[1] * v1[1]) + (v1[2] * v1[2] + v1[3] * v1[3]));
                        u32x4 w; w.x = cvt_pk_bf16(v0[0], v0[1]); w.y = cvt_pk_bf16(v0[2], v0[3]); w.z = cvt_pk_bf16(v1[0], v1[1]); w.w = cvt_pk_bf16(v1[2], v1[3]);
                        *(u32x4*)(rowp + bj * HALF) = w; }
                    if (st) { s1 += __shfl_xor(s1, 16); s2 += __shfl_xor(s2, 16); s1 += __shfl_xor(s1, 32); s2 += __shfl_xor(s2, 32);
                        if (fq == 0) *(f32x2*)(sv + ((size_t)row * 16 + (pn - 4) * 4 + wc) * 2) = (f32x2){s1, s2}; } }
        } else if (pn < 16) {
            const int col0 = 2048 + (pn - 8) * HALF + wc * 32 + 8 * fq;
#pragma unroll
            for (int ai = 0; ai < 2; ++ai)
#pragma unroll
                for (int m = 0; m < 4; ++m) { bf16_t* rowp = O + (size_t)(row0 + ai * HALF + m * 16) * ldc + col0; const float rsv = rs[ai * HALF + wr * 64 + m * 16 + fr], nrs = -1.4426950408889634f * rsv;
                    float h[8];
#pragma unroll
                    for (int n = 0; n < 2; ++n)
#pragma unroll
                        for (int e = 0; e < 4; ++e) h[n * 4 + e] = acc[ai][0][m][n][e] * rsv * __builtin_amdgcn_rcpf(1.0f + __builtin_amdgcn_exp2f(acc[ai][1][m][n][e] * nrs));
                    u32x4 w; w.x = cvt_pk_bf16(h[0], h[1]); w.y = cvt_pk_bf16(h[2], h[3]); w.z = cvt_pk_bf16(h[4], h[5]); w.w = cvt_pk_bf16(h[6], h[7]);
                    *(u32x4*)rowp = w; }
        } else if (pn < 20) {
            const int col0 = pn * BM + wc * 32 + 8 * fq;
#pragma unroll
            for (int ai = 0; ai < 2; ++ai)
#pragma unroll
                for (int m = 0; m < 4; ++m) { bf16_t* rowp = O + (size_t)(row0 + ai * HALF + m * 16) * ldc + col0; const float rsv = rs[ai * HALF + wr * 64 + m * 16 + fr];
#pragma unroll
                    for (int bj = 0; bj < 2; ++bj) { const f32x4 v0 = acc[ai][bj][m][0] * rsv, v1 = acc[ai][bj][m][1] * rsv;
                        u32x4 w; w.x = cvt_pk_bf16(v0[0], v0[1]); w.y = cvt_pk_bf16(v0[2], v0[3]); w.z = cvt_pk_bf16(v1[0], v1[1]); w.w = cvt_pk_bf16(v1[2], v1[3]);
                        *(u32x4*)(rowp + bj * HALF) = w; } }
        } else if (pn >= 28) {
#pragma unroll
            for (int ai = 0; ai < 2; ++ai)
#pragma unroll
                for (int m = 0; m < 4; ++m) { const int row = row0 + ai * HALF + m * 16, b = row >> seqshift, t = row & seqmask; const float rsv = rs[ai * HALF + wr * 64 + m * 16 + fr];
#pragma unroll
                    for (int bj = 0; bj < 2; ++bj) { const f32x4 v0 = acc[ai][bj][m][0] * rsv, v1 = acc[ai][bj][m][1] * rsv;
                        u32x4 w; w.x = cvt_pk_bf16(v0[0], v0[1]); w.y = cvt_pk_bf16(v0[2], v0[3]); w.z = cvt_pk_bf16(v1[0], v1[1]); w.w = cvt_pk_bf16(v1[2], v1[3]);
                        *(u32x4*)(vh + ((size_t)((b * 8 + (pn - 28) * 2 + bj)) << seqshift | (size_t)t) * 128 + wc * 32 + 8 * fq) = w; } }
        } else {
            const bool isq = pn < 24; const int hc = (pn - (isq ? 20 : 24)) * 4 + wc; bf16_t* const dst = isq ? qh : kh;
            const float* gp = isq ? qg : kg; const float sc = isq ? qscale : 1.0f;
            f32x4 g[2][2];
#pragma unroll
            for (int n = 0; n < 2; ++n) { g[0][n] = *(const f32x4*)(gp + (fq < 2 ? 4 * fq + 8 * n : 8 * fq + 4 * n)) * sc; g[1][n] = *(const f32x4*)(gp + 32 + 8 * fq + 4 * n) * sc; }
#pragma unroll
            for (int ai = 0; ai < 2; ++ai)
#pragma unroll
                for (int m = 0; m < 4; ++m) { const int row = row0 + ai * HALF + m * 16; bf16_t* rowp = dst + (((size_t)((row >> seqshift) * 16 + hc)) << seqshift | (size_t)(row & seqmask)) * 64 + 8 * fq; const float rsv = rs[ai * HALF + wr * 64 + m * 16 + fr];
                    f32x4 v[2][2]; float s = 0.f;
#pragma unroll
                    for (int bj = 0; bj < 2; ++bj)
#pragma unroll
                        for (int n = 0; n < 2; ++n) { v[bj][n] = acc[ai][bj][m][n] * rsv; s += (v[bj][n][0] * v[bj][n][0] + v[bj][n][1] * v[bj][n][1]) + (v[bj][n][2] * v[bj][n][2] + v[bj][n][3] * v[bj][n][3]); }
                    s += __shfl_xor(s, 16); s += __shfl_xor(s, 32);
                    const float rn = 1.0f / sqrtf(s * (1.f / 64.f) + 1e-6f);
#pragma unroll
                    for (int bj = 0; bj < 2; ++bj)
#pragma unroll
                        for (int n = 0; n < 2; ++n) v[bj][n] = v[bj][n] * rn * g[bj][n];
                    if (fq < 2) {
                        const float* rp = rope + (size_t)(row & seqmask) * 16 + fq * 8; const f32x4 cs0 = *(const f32x4*)rp, cs1 = *(const f32x4*)(rp + 4);
                        const f32x4 x1 = v[0][0], x2 = v[0][1]; const f32x4 cc = (f32x4){cs0[0], cs0[2], cs1[0], cs1[2]}, sn = (f32x4){cs0[1], cs0[3], cs1[1], cs1[3]};
                        v[0][0] = x1 * cc - x2 * sn; v[0][1] = x2 * cc + x1 * sn; }
#pragma unroll
                    for (int bj = 0; bj < 2; ++bj) { u32x4 w; w.x = cvt_pk_bf16(v[bj][0][0], v[bj][0][1]); w.y = cvt_pk_bf16(v[bj][0][2], v[bj][0][3]); w.z = cvt_pk_bf16(v[bj][1][0], v[bj][1][1]); w.w = cvt_pk_bf16(v[bj][1][2], v[bj][1][3]);
                        *(u32x4*)(rowp + bj * 32) = w; } }
        }
    }
};
template <bool NOSTORE = false> struct EpiRelu2T {
    static constexpr bool PERM = true, AFTER_DRAIN = false;
    bf16_t* O; int ldc; const PG8_LAS float* rs;
    __device__ __forceinline__ void operator()(const f32x4 (&acc)[2][2][4][2], const Unit& u, int wr, int wc, int fr, int fq) const {
        const int row0 = u.pm * BM + wr * 64 + fr; const int col0 = u.pn * BM + wc * 32 + 8 * fq;
#pragma unroll
        for (int ai = 0; ai < 2; ++ai)
#pragma unroll
            for (int m = 0; m < 4; ++m) { bf16_t* rowp = O + (size_t)(row0 + ai * HALF + m * 16) * ldc + col0; const float rsv = rs[ai * HALF + wr * 64 + m * 16 + fr];
#pragma unroll
                for (int bj = 0; bj < 2; ++bj) { f32x4 v0 = acc[ai][bj][m][0] * rsv, v1 = acc[ai][bj][m][1] * rsv;
                    v0 = __builtin_elementwise_max(v0, (f32x4){0.f, 0.f, 0.f, 0.f}); v1 = __builtin_elementwise_max(v1, (f32x4){0.f, 0.f, 0.f, 0.f}); v0 = v0 * v0; v1 = v1 * v1;
                    u32x4 w; w.x = cvt_pk_bf16(v0[0], v0[1]); w.y = cvt_pk_bf16(v0[2], v0[3]); w.z = cvt_pk_bf16(v1[0], v1[1]); w.w = cvt_pk_bf16(v1[2], v1[3]);
                    if (!NOSTORE || w.x == 0x12345678u) *(u32x4*)(rowp + bj * HALF) = w; } }
    }
};
typedef EpiRelu2T<false> EpiRelu2;
template <bool BASE_BF16, bool OUT_F32> struct EpiRes {
    static constexpr bool PERM = true, AFTER_DRAIN = false;
    const void* base; float* out; int ldc; bf16_t* xb; float* ss;
    __device__ __forceinline__ void operator()(const f32x4 (&acc)[2][2][4][2], const Unit& u, int wr, int wc, int fr, int fq) const {
        const int row0 = u.pm * BM + wr * 64 + fr, col0 = u.pn * BM + wc * 32 + 8 * fq;
        if constexpr (BASE_BF16) {
            u32x4 bw[2][4][2];
#pragma unroll
            for (int ai = 0; ai < 2; ++ai)
#pragma unroll
                for (int m = 0; m < 4; ++m) { const size_t off = (size_t)(row0 + ai * HALF + m * 16) * ldc + col0;
#pragma unroll
                    for (int bj = 0; bj < 2; ++bj) bw[ai][m][bj] = *(const u32x4*)((const bf16_t*)base + off + bj * HALF); }
#pragma unroll
            for (int ai = 0; ai < 2; ++ai) {
                float sq[4];
#pragma unroll
                for (int m = 0; m < 4; ++m) { const size_t off = (size_t)(row0 + ai * HALF + m * 16) * ldc + col0; float s = 0.f;
#pragma unroll
                    for (int bj = 0; bj < 2; ++bj) { const u32x4 w0 = bw[ai][m][bj];
                        const f32x4 b0 = (f32x4){__builtin_bit_cast(float, w0.x << 16), __builtin_bit_cast(float, w0.x & 0xffff0000u), __builtin_bit_cast(float, w0.y << 16), __builtin_bit_cast(float, w0.y & 0xffff0000u)};
                        const f32x4 b1 = (f32x4){__builtin_bit_cast(float, w0.z << 16), __builtin_bit_cast(float, w0.z & 0xffff0000u), __builtin_bit_cast(float, w0.w << 16), __builtin_bit_cast(float, w0.w & 0xffff0000u)};
                        const f32x4 o0 = b0 + acc[ai][bj][m][0], o1 = b1 + acc[ai][bj][m][1];
                        if constexpr (OUT_F32) { *(f32x4*)(out + off + bj * HALF) = o0; *(f32x4*)(out + off + bj * HALF + 4) = o1; }
                        else { u32x4 w; w.x = cvt_pk_bf16(o0[0], o0[1]); w.y = cvt_pk_bf16(o0[2], o0[3]); w.z = cvt_pk_bf16(o1[0], o1[1]); w.w = cvt_pk_bf16(o1[2], o1[3]); *(u32x4*)(xb + off + bj * HALF) = w;
                            s += ((o0[0] * o0[0] + o0[1] * o0[1]) + (o0[2] * o0[2] + o0[3] * o0[3])) + ((o1[0] * o1[0] + o1[1] * o1[1]) + (o1[2] * o1[2] + o1[3] * o1[3])); } }
                    sq[m] = s; }
                if constexpr (!OUT_F32) {
#pragma unroll
                    for (int m = 0; m < 4; ++m) { float s = sq[m]; s += __shfl_xor(s, 16); s += __shfl_xor(s, 32); if (fq == 0) ss[(size_t)(row0 + ai * HALF + m * 16) * 64 + u.pn * 4 + wc] = s; } }
            }
        } else {
#pragma unroll
        for (int ai = 0; ai < 2; ++ai) {
            f32x4 bs[4][2][2];
#pragma unroll
            for (int m = 0; m < 4; ++m) { const size_t off = (size_t)(row0 + ai * HALF + m * 16) * ldc + col0;
#pragma unroll
                for (int bj = 0; bj < 2; ++bj) { bs[m][bj][0] = *(const f32x4*)((const float*)base + off + bj * HALF); bs[m][bj][1] = *(const f32x4*)((const float*)base + off + bj * HALF + 4); } }
            float sq[4];
#pragma unroll
            for (int m = 0; m < 4; ++m) { const size_t off = (size_t)(row0 + ai * HALF + m * 16) * ldc + col0; float s = 0.f;
#pragma unroll
                for (int bj = 0; bj < 2; ++bj) { const f32x4 o0 = bs[m][bj][0] + acc[ai][bj][m][0], o1 = bs[m][bj][1] + acc[ai][bj][m][1];
                    if constexpr (OUT_F32) { *(f32x4*)(out + off + bj * HALF) = o0; *(f32x4*)(out + off + bj * HALF + 4) = o1; }
                    else { u32x4 w; w.x = cvt_pk_bf16(o0[0], o0[1]); w.y = cvt_pk_bf16(o0[2], o0[3]); w.z = cvt_pk_bf16(o1[0], o1[1]); w.w = cvt_pk_bf16(o1[2], o1[3]); *(u32x4*)(xb + off + bj * HALF) = w;
                        s += ((o0[0] * o0[0] + o0[1] * o0[1]) + (o0[2] * o0[2] + o0[3] * o0[3])) + ((o1[0] * o1[0] + o1[1] * o1[1]) + (o1[2] * o1[2] + o1[3] * o1[3])); } }
                sq[m] = s; }
            if constexpr (!OUT_F32) {
#pragma unroll
                for (int m = 0; m < 4; ++m) { float s = sq[m]; s += __shfl_xor(s, 16); s += __shfl_xor(s, 32); if (fq == 0) ss[(size_t)(row0 + ai * HALF + m * 16) * 64 + u.pn * 4 + wc] = s; } }
            asm volatile("" ::: "memory");
        }
        }
    }
};
template <class Epi, class Sched, bool ALIGN_EPI = false, bool SP2 = false>
__device__ __forceinline__ void gemm_phase(PG8_LAS unsigned char* lds, const Gemm g, const Sched& S, const Epi& E) {
    int tid_ = threadIdx.x; asm volatile("" : "+v"(tid_));
    const int tid = tid_, wid = __builtin_amdgcn_readfirstlane(tid >> 6), lane = tid & 63, wr = wid >> 2, wc = wid & 3, fr = lane & 15, fq = lane >> 4;
    const int K = g.K, nt = K / BK;
    unsigned voffA[2], voffB[2];
#pragma unroll
    for (int i = 0; i < 2; ++i) { int R, C; stage_rc(tid * 16 + i * 8192, R, C); const int Rb = Epi::PERM ? ((R & ~31) + perm32(R & 31)) : R;
        voffA[i] = (unsigned)(R * K + C) * 2u; voffB[i] = (unsigned)(Rb * K + C) * 2u; }
    const size_t kstep = (size_t)(BK * 2);
    const size_t hstep = (size_t)HALF * K * 2;
    const size_t tstep = 2 * hstep;
    const unsigned ldsw = (unsigned)wid * 1024u;
    const int aoff = lds_byte(wr * 64 + fr, fq * 8), boff = lds_byte(wc * 32 + fr, fq * 8);
#define PG8_SA(b, h) (((b) * 2 + (h)) * HTB)
#define PG8_SB(b, h) ((4 + (b) * 2 + (h)) * HTB)
#define PG8_STAGE(bufoff, gbase, voff) do { _Pragma("unroll") for (int _i = 0; _i < 2; ++_i) \
        __builtin_amdgcn_global_load_lds((const unsigned*)((const char*)(gbase) + (voff)[_i]), (PG8_LAS unsigned*)(lds + (bufoff) + ldsw + _i * 8192), 16, 0, 0); } while (0)
#define PG8_LDA(dst, b, h) do { _Pragma("unroll") for (int m = 0; m < 4; ++m) _Pragma("unroll") for (int k = 0; k < 2; ++k) dst[m][k] = *(const PG8_LAS bf16x8*)(lds + PG8_SA(b, h) + aoff + m * 2048 + k * 1024); } while (0)
#define PG8_LDB(dst, b, h) do { _Pragma("unroll") for (int n = 0; n < 2; ++n) _Pragma("unroll") for (int k = 0; k < 2; ++k) dst[n][k] = *(const PG8_LAS bf16x8*)(lds + PG8_SB(b, h) + boff + n * 2048 + k * 1024); } while (0)
#define PG8_MMA(ai, bj, At, Bt) do { __builtin_amdgcn_s_setprio(PG8_PRIO_MMA); _Pragma("unroll") for (int m = 0; m < 4; ++m) _Pragma("unroll") for (int n = 0; n < 2; ++n) _Pragma("unroll") for (int k = 0; k < 2; ++k) \
        acc[ai][bj][m][n] = __builtin_amdgcn_mfma_f32_16x16x32_bf16(Bt[n][k], At[m][k], acc[ai][bj][m][n], 0, 0, 0); __builtin_amdgcn_s_setprio(PG8_PRIO_LOAD); } while (0)
#ifndef PG8_PRIO_MMA
#define PG8_PRIO_MMA 1
#define PG8_PRIO_LOAD 0
#endif
#define PG8_WAIT_V(n) asm volatile("s_waitcnt vmcnt(" #n ")" ::: "memory")
#define PG8_WAIT_L(n) asm volatile("s_waitcnt lgkmcnt(" #n ")" ::: "memory")
#define PG8_BAR __builtin_amdgcn_s_barrier()
#define PG8_SCHED __builtin_amdgcn_sched_barrier(0)
    Unit cur, nxt; int ui = 0;
    if (!S.next(0, cur)) return;
    f32x4 acc[2][2][4][2];
#pragma unroll
    for (int a = 0; a < 2; ++a)
#pragma unroll
        for (int b = 0; b < 2; ++b)
#pragma unroll
            for (int m = 0; m < 4; ++m)
#pragma unroll
                for (int n = 0; n < 2; ++n) acc[a][b][m][n] = (f32x4){0.f, 0.f, 0.f, 0.f};
    bf16x8 At[4][2], B0[2][2], B1[2][2];
    const char* cA = (const char*)g.A + (size_t)cur.pm * tstep; const char* cB = (const char*)g.Bt + (size_t)cur.pn * tstep;
    S.a_ready(cur);
    if constexpr (SP2) {
        PG8_STAGE(PG8_SB(0, 0), cB, voffB); PG8_STAGE(PG8_SB(0, 1), cB + hstep, voffB); PG8_STAGE(PG8_SA(0, 0), cA, voffA); PG8_STAGE(PG8_SA(0, 1), cA + hstep, voffA);
        if (wr == 1) PG8_BAR;
        PG8_WAIT_V(2); PG8_BAR;
        PG8_STAGE(PG8_SB(1, 0), cB + kstep, voffB); PG8_STAGE(PG8_SA(1, 0), cA + kstep, voffA); PG8_STAGE(PG8_SB(1, 1), cB + hstep + kstep, voffB);
        PG8_WAIT_V(6); PG8_BAR;
    } else {
        PG8_STAGE(PG8_SB(0, 0), cB, voffB); PG8_STAGE(PG8_SA(0, 0), cA, voffA); PG8_STAGE(PG8_SB(0, 1), cB + hstep, voffB); PG8_STAGE(PG8_SA(0, 1), cA + hstep, voffA);
        if (wr == 1) PG8_BAR;
        PG8_WAIT_V(4); PG8_BAR;
        PG8_STAGE(PG8_SB(1, 0), cB + kstep, voffB); PG8_STAGE(PG8_SA(1, 0), cA + kstep, voffA); PG8_STAGE(PG8_SB(1, 1), cB + hstep + kstep, voffB);
        PG8_WAIT_V(6); PG8_BAR;
    }
    for (;;) {
        const bool has_next = S.next(ui + 1, nxt);
        const char* nA = has_next ? (const char*)g.A + (size_t)nxt.pm * tstep : cA; const char* nB = has_next ? (const char*)g.Bt + (size_t)nxt.pn * tstep : cB;
        for (int t = 0; t < nt; t += 2) {
            const bool last = (t == nt - 2);
            const char* a1 = cA + (size_t)(t + 1) * kstep;
            const char* a2 = last ? nA : cA + (size_t)(t + 2) * kstep; const char* b2 = last ? nB : cB + (size_t)(t + 2) * kstep;
            const char* a3 = a2 + kstep; const char* b3 = b2 + kstep;
            if (last && has_next) S.a_ready(nxt);
            if constexpr (SP2) {
            PG8_LDB(B0, 0, 0); PG8_LDB(B1, 0, 1); PG8_SCHED; PG8_LDA(At, 0, 0); PG8_STAGE(PG8_SA(1, 1), a1 + hstep, voffA);
            PG8_WAIT_V(8); PG8_WAIT_L(0); PG8_BAR; PG8_MMA(0, 0, At, B0); PG8_MMA(0, 1, At, B1); PG8_BAR; PG8_SCHED;
            PG8_LDA(At, 0, 1); PG8_STAGE(PG8_SB(0, 0), b2, voffB); PG8_STAGE(PG8_SB(0, 1), b2 + hstep, voffB); PG8_STAGE(PG8_SA(0, 0), a2, voffA);
            PG8_WAIT_V(8); PG8_WAIT_L(0); PG8_BAR; PG8_MMA(1, 0, At, B0); PG8_MMA(1, 1, At, B1); PG8_BAR; PG8_SCHED;
            PG8_LDB(B0, 1, 0); PG8_LDB(B1, 1, 1); PG8_SCHED; PG8_LDA(At, 1, 0); PG8_STAGE(PG8_SA(0, 1), a2 + hstep, voffA);
            PG8_WAIT_V(8); PG8_WAIT_L(0); PG8_BAR; PG8_MMA(0, 0, At, B0); PG8_MMA(0, 1, At, B1); PG8_BAR; PG8_SCHED;
            PG8_LDA(At, 1, 1); PG8_STAGE(PG8_SB(1, 0), b3, voffB); PG8_STAGE(PG8_SB(1, 1), b3 + hstep, voffB); PG8_STAGE(PG8_SA(1, 0), a3, voffA);
            PG8_WAIT_V(8); PG8_WAIT_L(0); PG8_BAR; PG8_MMA(1, 0, At, B0); PG8_MMA(1, 1, At, B1); PG8_BAR; PG8_SCHED;
            } else {
            PG8_LDB(B0, 0, 0); PG8_SCHED; PG8_LDA(At, 0, 0); PG8_STAGE(PG8_SA(1, 1), a1 + hstep, voffA);
            PG8_WAIT_L(8); PG8_BAR; PG8_WAIT_L(0); PG8_MMA(0, 0, At, B0); PG8_BAR; PG8_SCHED;
            PG8_LDB(B1, 0, 1); PG8_STAGE(PG8_SB(0, 0), b2, voffB);
            PG8_BAR; PG8_WAIT_L(0); PG8_MMA(0, 1, At, B1); PG8_BAR;
            PG8_LDA(At, 0, 1); PG8_STAGE(PG8_SA(0, 0), a2, voffA);
            PG8_BAR; PG8_WAIT_L(0); PG8_MMA(1, 0, At, B0); PG8_BAR; PG8_SCHED;
            PG8_STAGE(PG8_SB(0, 1), b2 + hstep, voffB);
            PG8_WAIT_V(6); PG8_BAR; PG8_MMA(1, 1, At, B1); PG8_BAR;
            PG8_LDB(B0, 1, 0); PG8_SCHED; PG8_LDA(At, 1, 0); PG8_STAGE(PG8_SA(0, 1), a2 + hstep, voffA);
            PG8_WAIT_L(8); PG8_BAR; PG8_WAIT_L(0); PG8_MMA(0, 0, At, B0); PG8_BAR; PG8_SCHED;
            PG8_LDB(B1, 1, 1); PG8_STAGE(PG8_SB(1, 0), b3, voffB);
            PG8_BAR; PG8_WAIT_L(0); PG8_MMA(0, 1, At, B1); PG8_BAR;
            PG8_LDA(At, 1, 1); PG8_STAGE(PG8_SA(1, 0), a3, voffA);
            PG8_BAR; PG8_WAIT_L(0); PG8_MMA(1, 0, At, B0); PG8_BAR; PG8_SCHED;
            PG8_STAGE(PG8_SB(1, 1), b3 + hstep, voffB);
            PG8_WAIT_V(6); PG8_BAR; PG8_MMA(1, 1, At, B1); PG8_BAR;
            }
        }
        if constexpr (ALIGN_EPI) { if (wr == 0) PG8_BAR; }
        if constexpr (!Epi::AFTER_DRAIN) { E(acc, cur, wr, wc, fr, fq); S.done(cur); }
        if (!has_next) break;
#pragma unroll
        for (int a = 0; a < 2; ++a)
#pragma unroll
            for (int b = 0; b < 2; ++b)
#pragma unroll
                for (int m = 0; m < 4; ++m)
#pragma unroll
                    for (int n = 0; n < 2; ++n) acc[a][b][m][n] = (f32x4){0.f, 0.f, 0.f, 0.f};
        cur = nxt; cA = nA; cB = nB; ++ui;
        if constexpr (ALIGN_EPI) { if (wr == 1) PG8_BAR; }
    }
    PG8_WAIT_V(0);
    if constexpr (!ALIGN_EPI) { if (wr == 0) PG8_BAR; }
    PG8_BAR;
    if constexpr (Epi::AFTER_DRAIN) { E.fused(acc, cur, wr, wc, fr, fq, lds, wid, lane); S.done(cur); }
#undef PG8_SA
#undef PG8_SB
#undef PG8_STAGE
#undef PG8_LDA
#undef PG8_LDB
#undef PG8_MMA
#undef PG8_WAIT_V
#undef PG8_WAIT_L
#undef PG8_BAR
#undef PG8_SCHED
}
}

constexpr int NWAVES = 8;
constexpr int BATCH = 2, SEQ = 8192, DM = 4096, NLAYER = 2, GW = 1024, DIN = 8192, DFF = 16384;
constexpr int M = BATCH * SEQ;
constexpr int ZC_A = 0, ZC_B = 2048, ZC_C = 4096, ZC_Q = 5120, ZC_K = 6144, ZC_V = 7168;
constexpr int YC_A = 0, YC_B = 1024, YC_C = 2048, YC_D = 3072;
constexpr float QSCALE = 0.125f * 1.4426950408889634f;
#ifndef MK_SPLIT
#define MK_SPLIT 0
#endif

constexpr size_t MiB = 1u << 20;
constexpr size_t WS_CTL = 0, CTL_ZERO_BYTES = 64 * 1024;
constexpr size_t WS_ROPE = 1 * MiB;
constexpr size_t WS_PWT = 2 * MiB;
constexpr size_t WS_GWS = 3 * MiB;
constexpr size_t WS_SS = 4 * MiB;
constexpr size_t WS_SV = 8 * MiB;
constexpr size_t WS_WIN = 16 * MiB;
constexpr size_t WS_WOUT = 144 * MiB;
constexpr size_t WS_WUP = 208 * MiB;
constexpr size_t WS_WDN = 464 * MiB;
constexpr size_t WS_XN = 720 * MiB;
constexpr size_t WS_Z = 848 * MiB;
constexpr size_t WS_YC = 1104 * MiB;
constexpr size_t WS_HB = 1232 * MiB;
constexpr size_t WS_OS = 1744 * MiB;
constexpr size_t WS_QH = 1808 * MiB;
constexpr size_t WS_KH = 1840 * MiB;
constexpr size_t WS_VH = 1872 * MiB;
constexpr size_t WS_END = 1904 * MiB;
constexpr int CW_BAR = 1024;

constexpr int RING_OFF = 0, RING_BYTES = 131072;
constexpr int LDSCTL_OFF = RING_BYTES, MISC_OFF = LDSCTL_OFF + 320;
constexpr int RSTAB_OFF = RING_BYTES + 1024;
constexpr int LDS_BYTES = 147456;

#define GAS __attribute__((address_space(1)))
#define LAS __attribute__((address_space(3)))
typedef unsigned short bf16;
typedef unsigned v4u __attribute__((ext_vector_type(4)));
typedef float f32x4 __attribute__((ext_vector_type(4)));
typedef short bf16x8 __attribute__((ext_vector_type(8)));
typedef GAS unsigned gu32;
typedef GAS unsigned long long gu64;
#define RLX_AGENT __ATOMIC_RELAXED, __HIP_MEMORY_SCOPE_AGENT
#define LDS_WAIT() asm volatile("s_waitcnt lgkmcnt(0)" ::: "memory")
#define VM_WAIT() asm volatile("s_waitcnt vmcnt(0)" ::: "memory")
__device__ __forceinline__ unsigned long long rt() { return __builtin_amdgcn_s_memrealtime(); }
__device__ __forceinline__ unsigned f2bf(float f) { unsigned u = __builtin_bit_cast(unsigned, f); return (u + 0x7fffu + ((u >> 16) & 1u)) >> 16; }
__device__ __forceinline__ unsigned pk2(float lo, float hi) { return f2bf(lo) | (f2bf(hi) << 16); }

#define XB_TMO      128
#define XB_XCNT(j)  (256  + 64 * (j))
#define XB_XSUB(j)  (1280 + 64 * (j))
#define XB_XGEN(j)  (2304 + 64 * (j))
#define XB_TOP      3328
#define XB_TOPGEN   3392
#define XCD_BAR_WORDS 3456
#define XB_SPIN_CAP (1u << 18)

__device__ __forceinline__ unsigned xb_ld(unsigned* p)              { return __hip_atomic_load(p, __ATOMIC_RELAXED, __HIP_MEMORY_SCOPE_AGENT); }
__device__ __forceinline__ unsigned xb_add(unsigned* p, unsigned v) { return __hip_atomic_fetch_add(p, v, __ATOMIC_RELAXED, __HIP_MEMORY_SCOPE_AGENT); }
__device__ __forceinline__ unsigned xb_xcc_id() { return (unsigned)__builtin_amdgcn_s_getreg((3 << 11) | 20) & 0xFu; }
#define XB_SPIN(cond, bar) do { unsigned _sp = 0; while (cond) { __builtin_amdgcn_s_sleep(1); \
    if ((++_sp & 255u) == 0u) { if (xb_ld(&(bar)[XB_TMO])) break; if (_sp > XB_SPIN_CAP) { atomicAdd(&(bar)[XB_TMO], 1u); break; } } } } while (0)

struct XcdBarrier {
    unsigned* bar; unsigned x;
    volatile LAS unsigned* st;
};

__device__ __forceinline__ XcdBarrier xcd_barrier_post(unsigned* bar, volatile LAS unsigned* st) {
    XcdBarrier b; b.bar = bar; b.x = xb_xcc_id(); b.st = st;
    if (threadIdx.x == 0) (void)xb_add(&bar[XB_XCNT(b.x)], 1u);
    return b;
}
__device__ __forceinline__ void xcd_barrier_complete(unsigned* bar, unsigned x, unsigned& nloc, unsigned& nx) {
    const unsigned G = gridDim.x * gridDim.y * gridDim.z;
    unsigned sum, cnt, mine, sp = 0u;
    for (;;) {
        sum = 0u; cnt = 0u; mine = 0u;
#pragma unroll
        for (unsigned j = 0; j < 16; ++j) { const unsigned c = xb_ld(&bar[XB_XCNT(j)]); sum += c; cnt += (c > 0u) ? 1u : 0u; mine = (j == x) ? c : mine; }
        if (sum == G) break;
        __builtin_amdgcn_s_sleep(1);
        if ((++sp & 255u) == 0u) { if (xb_ld(&bar[XB_TMO])) break; if (sp > XB_SPIN_CAP) { atomicAdd(&bar[XB_TMO], 1u); break; } }
    }
    nloc = mine > 0u ? mine : 1u; nx = cnt > 0u ? cnt : 1u;
}

__device__ __forceinline__ void xcd_barrier_leader(const XcdBarrier& b) {
        unsigned* bar = b.bar;
        __builtin_amdgcn_s_waitcnt(0);
        unsigned nloc = b.st[0], nx = b.st[1];
        if (nloc == 0u) { xcd_barrier_complete(bar, b.x, nloc, nx); b.st[0] = nloc; b.st[1] = nx; }
        const unsigned old = xb_add(&bar[XB_XSUB(b.x)], 1u);
        const unsigned gen = old / nloc;
        if (old + 1u == (gen + 1u) * nloc) {
            __builtin_amdgcn_fence(__ATOMIC_RELEASE, "agent");
            asm volatile("s_waitcnt vmcnt(0)" ::: "memory");
            const unsigned og = xb_add(&bar[XB_TOP], 1u);
            const unsigned tg = og / nx;
            if (og + 1u == (tg + 1u) * nx) xb_add(&bar[XB_TOPGEN], 1u);
            else XB_SPIN(xb_ld(&bar[XB_TOPGEN]) == tg, bar);
            __builtin_amdgcn_fence(__ATOMIC_ACQUIRE, "agent");
            xb_add(&bar[XB_XGEN(b.x)], 1u);
            asm volatile("s_waitcnt vmcnt(0)" ::: "memory");
        } else {
            XB_SPIN(xb_ld(&bar[XB_XGEN(b.x)]) == gen, bar);
            __builtin_amdgcn_fence(__ATOMIC_ACQUIRE, "agent");
            asm volatile("s_waitcnt vmcnt(0)" ::: "memory");
        }
}
__device__ __forceinline__ void xcd_barrier(const XcdBarrier& b) {
    asm volatile("s_waitcnt vmcnt(0)" ::: "memory");
    __syncthreads();
    if (threadIdx.x == 0) xcd_barrier_leader(b);
    __syncthreads();
}

typedef unsigned u32x2 __attribute__((ext_vector_type(2)));
typedef float f32x2v __attribute__((ext_vector_type(2)));
struct Frame {
    LAS unsigned char* lds;
    volatile LAS unsigned* MISC;
    gu32* ctl;
    int tid, lane, wave;
    int vcu, G;
};
struct Args { const float* in[24]; float* out; unsigned char* ws; int ph_lo, ph_hi; };

__device__ __forceinline__ float wave_sum(float v) {
#pragma unroll
    for (int o = 1; o < 64; o <<= 1) v += __shfl_xor(v, o);
    return v;
}
__device__ __forceinline__ float bf_lo(unsigned w) { return __builtin_bit_cast(float, w << 16); }
__device__ __forceinline__ float bf_hi(unsigned w) { return __builtin_bit_cast(float, w & 0xffff0000u); }
__device__ __forceinline__ float sigmoidf_fast(float x) { return __builtin_amdgcn_rcpf(1.0f + __builtin_amdgcn_exp2f(-1.4426950408889634f * x)); }

__device__ __forceinline__ int zin_dest(int n) {
    if (n < 2048 || (n >= 4096 && n < 5120) || n >= 7168) return n;
    if (n < 4096) { const int j = n - 2048, half = j >> 10, c = j & 1023; return 2048 + 256 * (c >> 7) + 128 * half + (c & 127); }
    const int base = (n < 6144) ? 5120 : 6144, j = n - base, hc = j >> 6, d = j & 63;
    const int pos = (d < 16) ? ((d & 3) | ((d & 4) << 1) | ((d & 8) >> 1)) : d;
    return base + 256 * (hc >> 2) + 32 * (hc & 3) + (d < 32 ? pos : 128 + (d - 32));
}
template <bool PERMZ>
__device__ __forceinline__ void p0_transpose_item(const float* W, int K, int N, bf16* WT, LAS float* scr, int item, int lane, const float* gain = nullptr) {
    const int nblk = N / 32, kb = item / nblk, nb = item % nblk, k0 = 64 * kb, n0 = 32 * nb;
    const GAS float* Wg = (const GAS float*)W;
    const int c = lane & 7;
    f32x4 g0 = (f32x4){1.f, 1.f, 1.f, 1.f}, g1 = g0;
    if (gain) { g0 = *(const GAS f32x4*)(gain + k0 + 8 * c); g1 = *(const GAS f32x4*)(gain + k0 + 8 * c + 4); }
    float tv[32];
#pragma unroll
    for (int i = 0; i < 32; ++i) { const int kk = 2 * i + (lane >> 5); tv[i] = __builtin_nontemporal_load(Wg + (size_t)(k0 + kk) * N + n0 + (lane & 31)); }
#pragma unroll
    for (int i = 0; i < 32; ++i) { const int kk = 2 * i + (lane >> 5); scr[kk * 33 + (lane & 31)] = tv[i]; }
    LDS_WAIT(); asm volatile("" ::: "memory");
#pragma unroll
    for (int j = 0; j < 4; ++j) { const int n = (lane >> 3) + 8 * j; const LAS float* s = scr + (8 * c) * 33 + n;
        v4u o; o.x = pk2(s[0 * 33] * g0.x, s[1 * 33] * g0.y); o.y = pk2(s[2 * 33] * g0.z, s[3 * 33] * g0.w); o.z = pk2(s[4 * 33] * g1.x, s[5 * 33] * g1.y); o.w = pk2(s[6 * 33] * g1.z, s[7 * 33] * g1.w);
        const int dn = PERMZ ? zin_dest(n0 + n) : n0 + n;
        *(GAS v4u*)(WT + (size_t)dn * K + k0 + 8 * c) = o; }
    LDS_WAIT(); asm volatile("" ::: "memory");
}
template <bool PERMZ>
__device__ __forceinline__ void p0_transpose_pair(const float* W, int K, int N, bf16* WT, LAS float* scr, int item, int lane, const float* gain = nullptr) {
    const int nblk = N / 32, kb = item / nblk, nb = item % nblk, k0 = 64 * kb, n0 = 32 * nb;
    const GAS float* Wg = (const GAS float*)W;
    const int c = lane & 7;
    f32x4 g0 = (f32x4){1.f, 1.f, 1.f, 1.f}, g1 = g0;
    if (gain) { g0 = *(const GAS f32x4*)(gain + k0 + 8 * c); g1 = *(const GAS f32x4*)(gain + k0 + 8 * c + 4); }
    float tv[2][32];
#pragma unroll
    for (int h = 0; h < 2; ++h)
#pragma unroll
        for (int i = 0; i < 32; ++i) { const int kk = 2 * i + (lane >> 5); tv[h][i] = __builtin_nontemporal_load(Wg + (size_t)(k0 + kk) * N + n0 + 32 * h + (lane & 31)); }
#pragma unroll
    for (int h = 0; h < 2; ++h) {
#pragma unroll
        for (int i = 0; i < 32; ++i) { const int kk = 2 * i + (lane >> 5); scr[kk * 33 + (lane & 31)] = tv[h][i]; }
        LDS_WAIT(); asm volatile("" ::: "memory");
#pragma unroll
        for (int j = 0; j < 4; ++j) { const int n = (lane >> 3) + 8 * j; const LAS float* s = scr + (8 * c) * 33 + n;
            v4u o; o.x = pk2(s[0 * 33] * g0.x, s[1 * 33] * g0.y); o.y = pk2(s[2 * 33] * g0.z, s[3 * 33] * g0.w); o.z = pk2(s[4 * 33] * g1.x, s[5 * 33] * g1.y); o.w = pk2(s[6 * 33] * g1.z, s[7 * 33] * g1.w);
            const int dn = PERMZ ? zin_dest(n0 + 32 * h + n) : n0 + 32 * h + n;
            __builtin_nontemporal_store(o, (GAS v4u*)(WT + (size_t)dn * K + k0 + 8 * c)); }
        LDS_WAIT(); asm volatile("" ::: "memory");
    }
}
constexpr int CV_IN = (DM / 64) * (DIN / 32), CV_OUT = (DM / 64) * (DM / 32), CV_UP = (DM / 64) * (DFF / 32), CV_DN = (DFF / 64) * (DM / 32), CV_L = CV_IN + CV_OUT + CV_UP + CV_DN;
constexpr int CV_TOTAL = NLAYER * CV_L - CV_IN, CV_CHUNK = 16, CV_NCHUNK = CV_TOTAL / CV_CHUNK;
constexpr unsigned CV_EXH = 0xFFFFFFFFu;
constexpr int CW_Q = 8192;
constexpr int QST_OFF = LDSCTL_OFF + 4096;
static_assert(CV_TOTAL % (CV_CHUNK * 256) == 0 && CV_IN % (CV_CHUNK * 256) == 0 && CV_OUT % (CV_CHUNK * 256) == 0 && CV_UP % (CV_CHUNK * 256) == 0, "chunking");
__device__ __forceinline__ constexpr int cv_deadline(int l, int which) { return l * CV_L + (which == 0 ? CV_IN : which == 1 ? CV_IN + CV_OUT : which == 2 ? CV_IN + CV_OUT + CV_UP : CV_L) - CV_IN; }
__device__ __forceinline__ void cv_item(const Args& a, LAS float* scr, int I, int lane) {
    unsigned char* ws = a.ws;
    const int J = I + CV_IN, l = (J >= CV_L) ? 1 : 0; int r = J - l * CV_L;
    if (r < CV_IN) { p0_transpose_pair<true>(a.in[2] + (size_t)l * DM * DIN, DM, DIN, (bf16*)(ws + WS_WIN) + (size_t)l * DIN * DM, scr, r, lane, a.in[1] + (size_t)l * DM); return; } r -= CV_IN;
    if (r < CV_OUT) { p0_transpose_pair<false>(a.in[20] + (size_t)l * DM * DM, DM, DM, (bf16*)(ws + WS_WOUT) + (size_t)l * DM * DM, scr, r, lane); return; } r -= CV_OUT;
    if (r < CV_UP) { p0_transpose_pair<false>(a.in[22] + (size_t)l * DM * DFF, DM, DFF, (bf16*)(ws + WS_WUP) + (size_t)l * DFF * DM, scr, r, lane, a.in[21] + (size_t)l * DM); return; } r -= CV_UP;
    p0_transpose_pair<false>(a.in[23] + (size_t)l * DFF * DM, DFF, DM, (bf16*)(ws + WS_WDN) + (size_t)l * DM * DFF, scr, r, lane);
}
#ifndef NO_WAIT_STEAL
#define NO_WAIT_STEAL 0
#endif
__device__ __forceinline__ void seam_steal(const Frame& F, const Args& a, const XcdBarrier& b, int DI) {
    volatile LAS unsigned* QS = (volatile LAS unsigned*)(F.lds + QST_OFF);
    LAS float* scr = (LAS float*)(F.lds + RING_OFF + F.wave * 16384);
    const unsigned cu = blockIdx.x, DJ = (unsigned)DI / 256u, TJ = (unsigned)CV_TOTAL / 256u;
    __syncthreads();
    const unsigned e0 = (unsigned)__builtin_amdgcn_readfirstlane((int)QS[0]);
    unsigned cur = (unsigned)__builtin_amdgcn_readfirstlane((int)QS[8 + 2 * F.wave]), end = (unsigned)__builtin_amdgcn_readfirstlane((int)QS[9 + 2 * F.wave]);
    int mode = 0;
#ifdef DIAG_STEAL
    unsigned stolen = 0u;
#endif
    for (;;) {
        if (mode == 1 && (unsigned)__builtin_amdgcn_readfirstlane((int)QS[0]) != e0) break;
        if (cur == end) {
            bool arrive = false;
            if (end == CV_EXH) { if (mode == 0) arrive = true; else { __builtin_amdgcn_s_sleep(8); continue; } }
            else {
                if (mode == 0 && (unsigned)__builtin_amdgcn_readfirstlane((int)QS[1]) >= DJ) arrive = true;
                else {
                    unsigned j0 = 0u; if (F.lane == 0) j0 = __hip_atomic_fetch_add((LAS unsigned*)(F.lds + QST_OFF + 4), 2u, __ATOMIC_RELAXED, __HIP_MEMORY_SCOPE_WORKGROUP);
                    j0 = (unsigned)__builtin_amdgcn_readfirstlane((int)j0);
                    if (j0 >= TJ) { cur = end = CV_EXH; continue; }
                    cur = j0; end = j0 + 2u;
                }
            }
            if (arrive) {
                asm volatile("s_waitcnt vmcnt(0)" ::: "memory");
                __syncthreads();
                if (F.wave == 0 || NO_WAIT_STEAL) { if (threadIdx.x == 0) { xcd_barrier_leader(b); QS[0] = e0 + 1u; } break; }
                mode = 1; continue;
            }
        }
        cv_item(a, scr, (int)(16u * (256u * (cur >> 4) + cu) + (cur & 15u)), F.lane); cur += 2u;
#ifdef DIAG_STEAL
        stolen += 2u * (unsigned)mode;
#endif
    }
    if (F.lane == 0) { QS[8 + 2 * F.wave] = cur; QS[9 + 2 * F.wave] = end; }
#ifdef DIAG_STEAL
    if (F.lane == 0 && stolen) __hip_atomic_fetch_add((unsigned*)(F.ctl + CW_Q + 1024), stolen, RLX_AGENT);
#endif
    __syncthreads();
}
__device__ __forceinline__ void p0_prologue(const Frame& F, const Args& a) {
    LAS float* scr = (LAS float*)(F.lds + RING_OFF + F.wave * 16384);
    unsigned char* ws = a.ws;
    const int gw = F.vcu * NWAVES + F.wave, NGW = F.G * NWAVES;
    constexpr int I_PW1 = (256 / 64) * (256 / 32), I_PW = 4 * I_PW1;
    for (int it = gw; it < CV_IN + NLAYER * I_PW; it += NGW) {
        if (it < CV_IN) { p0_transpose_item<true>(a.in[2], DM, DIN, (bf16*)(ws + WS_WIN), scr, it, F.lane, a.in[1]); continue; }
        const int r = it - CV_IN, lg = r / I_PW1, ri = r % I_PW1;
        p0_transpose_item<false>(a.in[11] + (size_t)lg * 65536, 256, 256, (bf16*)(ws + WS_PWT) + (size_t)lg * 65536, scr, ri, F.lane);
    }
    const int gt = F.vcu * (NWAVES * 64) + F.tid, NGT = F.G * NWAVES * 64;
    { const GAS float* src = (const GAS float*)a.in[5]; GAS unsigned* dst = (GAS unsigned*)(ws + WS_GWS);
      for (int i = gt; i < NLAYER * 8 * 128 * 128 / 2; i += NGT) dst[i] = pk2(src[2 * i], src[2 * i + 1]); }
    { GAS float* rope = (GAS float*)(ws + WS_ROPE);
      for (int e = gt; e < SEQ * 8; e += NGT) {
          const int pos = e >> 3, i = e & 7;
          const float invf = (i == 0) ? 1.0f : (i == 1) ? 0x1.8d275ep-3f : (i == 2) ? 0x1.341190p-5f : (i == 3) ? 0x1.ddee9cp-8f : (i == 4) ? 0x1.72ba44p-10f : (i == 5) ? 0x1.1f91f0p-12f : (i == 6) ? 0x1.be218ap-15f : 0x1.5a0f50p-17f;
          const float angf = (float)pos * invf;
          const double ad = (double)angf;
          const double kq = __builtin_rint(ad * 0.63661977236758134308);
          const double y = __builtin_fma(-kq, 1.57079632679489661923, ad);
          const double y2 = y * y;
          const double sn = y * (1.0 + y2 * (-1.0 / 6 + y2 * (1.0 / 120 + y2 * (-1.0 / 5040 + y2 * (1.0 / 362880 + y2 * (-1.0 / 39916800))))));
          const double cs = 1.0 + y2 * (-0.5 + y2 * (1.0 / 24 + y2 * (-1.0 / 720 + y2 * (1.0 / 40320 + y2 * (-1.0 / 3628800 + y2 * (1.0 / 479001600))))));
          const int q = ((int)kq) & 3;
          const double c = (q == 0) ? cs : (q == 1) ? -sn : (q == 2) ? -cs : sn;
          const double s = (q == 0) ? sn : (q == 1) ? cs : (q == 2) ? -sn : -cs;
          rope[2 * e] = (float)c; rope[2 * e + 1] = (float)s;
      } }
}

__device__ __forceinline__ void xprep_phase(const Frame& F, const float* x, bf16* XB, float* SS) {
    const int gw = F.vcu * NWAVES + F.wave, NGW = F.G * NWAVES;
    for (int m = gw; m < M; m += NGW) {
        const GAS f32x4* xr = (const GAS f32x4*)(x + (size_t)m * DM) + F.lane;
        f32x4 v[16]; float s = 0.f;
#pragma unroll
        for (int j = 0; j < 16; ++j) { v[j] = __builtin_nontemporal_load(xr + 64 * j); s += (v[j].x * v[j].x + v[j].y * v[j].y) + (v[j].z * v[j].z + v[j].w * v[j].w); }
        GAS u32x2* o8 = (GAS u32x2*)(XB + (size_t)m * DM) + F.lane;
#pragma unroll
        for (int j = 0; j < 16; ++j) { u32x2 w; w.x = pk2(v[j].x, v[j].y); w.y = pk2(v[j].z, v[j].w); o8[64 * j] = w; }
        ((GAS float*)SS)[(size_t)m * 64 + F.lane] = s;
    }
}
__device__ __forceinline__ void rs_table(const Frame& F, const float* SS, int pm) {
    LAS float* tab = (LAS float*)(F.lds + RSTAB_OFF);
    if (F.tid < 256) { const GAS f32x4* p = (const GAS f32x4*)(SS + (size_t)(pm * 256 + F.tid) * 64); float s = 0.f;
#pragma unroll
        for (int j = 0; j < 16; ++j) { const f32x4 v = p[j]; s += (v.x + v.y) + (v.z + v.w); }
        tab[F.tid] = 1.0f / sqrtf(s * (1.f / DM) + 1e-6f); }
    __syncthreads();
}

__device__ __forceinline__ int vimg_st(int k, int c) { const int kk = (k & ~0xC) | ((k & 4) << 1) | ((k & 8) >> 1); return ((kk >> 3) * 4 + (c >> 5)) * 512 + ((kk & 7) * 32 + (c & 31)) * 2; }
__device__ __forceinline__ int vimg_rd_base(int lane) { return ((lane & 3) << 3) | (((lane >> 2) & 3) << 6) | (((lane >> 4) & 1) << 5) | (((lane >> 5) & 1) << 8); }
typedef __attribute__((ext_vector_type(4))) short s16x4;
typedef __attribute__((ext_vector_type(16))) float f32x16;
template <int OFF> __device__ __forceinline__ s16x4 vimg_tr(int vb) { s16x4 r; asm volatile("ds_read_b64_tr_b16 %0, %1 offset:%2" : "=&v"(r) : "v"(vb), "i"(OFF) : "memory"); return r; }
__device__ __forceinline__ void unpack8(const v4u a, float (&v)[8]) { v[0] = bf_lo(a.x); v[1] = bf_hi(a.x); v[2] = bf_lo(a.y); v[3] = bf_hi(a.y); v[4] = bf_lo(a.z); v[5] = bf_hi(a.z); v[6] = bf_lo(a.w); v[7] = bf_hi(a.w); }

__device__ __forceinline__ void gmlp_unit(const Frame& F, const bf16* Z, bf16* YC, const float* SV, const bf16* Wsb, const float* bs, const float* lng, const float* lnb, int unit, char* ldsg) {
    const int chunk = unit >> 2, hp = unit & 3, r0 = chunk * 128, tid = F.tid, lane = F.lane, w = F.wave, r32 = lane & 31, hi = lane >> 5;
    LAS float* st = (LAS float*)(F.lds + RING_OFF);
    LAS unsigned char* VI = F.lds + RING_OFF + 1024;
    LAS float* OT = (LAS float*)(F.lds + RING_OFF + 1024 + 32768);
    if (tid < 128) { const GAS f32x4* p = (const GAS f32x4*)(SV + (size_t)(r0 + tid) * 32); float s1 = 0.f, s2 = 0.f;
#pragma unroll
        for (int j = 0; j < 8; ++j) { const f32x4 v = p[j]; s1 += v.x + v.z; s2 += v.y + v.w; }
        const float mean = s1 * (1.f / 1024.f), var = s2 * (1.f / 1024.f) - mean * mean;
        st[tid * 2] = mean; st[tid * 2 + 1] = 1.0f / sqrtf(fmaxf(var, 0.f) + 1e-5f); }
    __syncthreads();
    const int d0 = w & 3, ib0 = (w >> 2) * 2;
    const int vb = (int)(uintptr_t)(ldsg + RING_OFF + 1024) + vimg_rd_base(lane) + d0 * 512;
#pragma unroll 1
    for (int hq = 0; hq < 2; ++hq) {
        const int h = hp * 2 + hq;
        bf16x8 wa[8], wb[8];
        { const GAS bf16* wrow = (const GAS bf16*)Wsb + (size_t)(h * 128 + 32 * ib0 + r32) * 128 + 8 * hi;
#pragma unroll
          for (int ks = 0; ks < 8; ++ks) { wa[ks] = *(const GAS bf16x8*)(wrow + 16 * ks); wb[ks] = *(const GAS bf16x8*)(wrow + 32 * 128 + 16 * ks); } }
        { const int j = tid >> 2, cq = tid & 3; const float mean = st[j * 2], rstd = st[j * 2 + 1];
          const GAS v4u* p = (const GAS v4u*)(Z + (size_t)(r0 + j) * DIN + ZC_A + 1024 + h * 128 + cq * 32);
          const GAS f32x4* gp = (const GAS f32x4*)(lng + h * 128 + cq * 32); const GAS f32x4* bp = (const GAS f32x4*)(lnb + h * 128 + cq * 32);
          v4u a[4];
#pragma unroll
          for (int k4 = 0; k4 < 4; ++k4) a[k4] = p[k4];
#pragma unroll
          for (int k4 = 0; k4 < 4; ++k4) { float v[8]; unpack8(a[k4], v); const f32x4 g0 = gp[2 * k4], g1 = gp[2 * k4 + 1], b0 = bp[2 * k4], b1 = bp[2 * k4 + 1];
              v4u o; o.x = pk2((v[0] - mean) * rstd * g0.x + b0.x, (v[1] - mean) * rstd * g0.y + b0.y); o.y = pk2((v[2] - mean) * rstd * g0.z + b0.z, (v[3] - mean) * rstd * g0.w + b0.w);
              o.z = pk2((v[4] - mean) * rstd * g1.x + b1.x, (v[5] - mean) * rstd * g1.y + b1.y); o.w = pk2((v[6] - mean) * rstd * g1.z + b1.z, (v[7] - mean) * rstd * g1.w + b1.w);
              *(LAS v4u*)(VI + (j >> 6) * 16384 + vimg_st(j & 63, cq * 32 + k4 * 8)) = o; } }
        __syncthreads();
        f32x16 acc[2]; acc[0] = f32x16{}; acc[1] = f32x16{};
#define GM_RD(KS) lo_[KS] = vimg_tr<((KS) >> 2) * 16384 + ((KS) & 3) * 4096>(vb), hi_[KS] = vimg_tr<((KS) >> 2) * 16384 + ((KS) & 3) * 4096 + 2048>(vb)
#define GM_MM(KS) do { const bf16x8 b_ = (bf16x8){lo_[KS][0], lo_[KS][1], lo_[KS][2], lo_[KS][3], hi_[KS][0], hi_[KS][1], hi_[KS][2], hi_[KS][3]}; \
        acc[0] = __builtin_amdgcn_mfma_f32_32x32x16_bf16(wa[KS], b_, acc[0], 0, 0, 0); acc[1] = __builtin_amdgcn_mfma_f32_32x32x16_bf16(wb[KS], b_, acc[1], 0, 0, 0); } while (0)
        { s16x4 lo_[8], hi_[8];
          GM_RD(0); GM_RD(1); GM_RD(2); GM_RD(3); GM_RD(4); GM_RD(5); GM_RD(6); GM_RD(7);
          asm volatile("s_waitcnt lgkmcnt(0)" ::: "memory"); __builtin_amdgcn_sched_barrier(0);
          GM_MM(0); GM_MM(1); GM_MM(2); GM_MM(3); GM_MM(4); GM_MM(5); GM_MM(6); GM_MM(7); }
#undef GM_RD
#undef GM_MM
#define GM_STEP(KS) do { } while (0)
#undef GM_STEP
#pragma unroll
        for (int t = 0; t < 2; ++t)
#pragma unroll
            for (int r = 0; r < 16; ++r) OT[(32 * (ib0 + t) + (r & 3) + 8 * (r >> 2) + 4 * hi) * 132 + 32 * d0 + r32] = acc[t][r];
        __syncthreads();
        { const int i = tid >> 2, cq = tid & 3; const float b = bs[h * 128 + i];
          const GAS v4u* up = (const GAS v4u*)(Z + (size_t)(r0 + i) * DIN + ZC_A + h * 128 + cq * 32); GAS v4u* yp = (GAS v4u*)(YC + (size_t)(r0 + i) * DM + YC_A + h * 128 + cq * 32);
          v4u a[4];
#pragma unroll
          for (int k4 = 0; k4 < 4; ++k4) a[k4] = up[k4];
#pragma unroll
          for (int k4 = 0; k4 < 4; ++k4) { float u[8]; unpack8(a[k4], u); const f32x4 o0 = *(const LAS f32x4*)(OT + i * 132 + cq * 32 + k4 * 8), o1 = *(const LAS f32x4*)(OT + i * 132 + cq * 32 + k4 * 8 + 4);
              v4u o; o.x = pk2((o0.x + b) * u[0], (o0.y + b) * u[1]); o.y = pk2((o0.z + b) * u[2], (o0.w + b) * u[3]); o.z = pk2((o1.x + b) * u[4], (o1.y + b) * u[5]); o.w = pk2((o1.z + b) * u[6], (o1.w + b) * u[7]);
              yp[k4] = o; } }
    }
    __syncthreads();
}

template <int R> __device__ __forceinline__ void conv_rows(const unsigned (&hraw)[62], const f32x2v (&w)[31], f32x2v (&acc)[31], const f32x2v bias, LAS float* cvp, int rlo, int rhi) {
    const unsigned hv = (R >= rlo && R < rhi) ? hraw[R] : 0u;
    const f32x2v h = (f32x2v){bf_lo(hv), bf_hi(hv)};
#pragma unroll
    for (int k = 0; k < 31; ++k) { const int o = R - k; if (o >= 0 && o <= 31) acc[(o + 31) % 31] = acc[(o + 31) % 31] + h * w[k]; }
    if constexpr (R >= 30) { constexpr int o = R - 30; *(LAS f32x2v*)(cvp + o * GW) = acc[o % 31] + bias; acc[o % 31] = (f32x2v){0.f, 0.f}; }
    if constexpr (R + 1 < 62) conv_rows<R + 1>(hraw, w, acc, bias, cvp, rlo, rhi);
}
__device__ __forceinline__ void conv_unit(const Frame& F, const bf16* Z, bf16* YC, const float* cw, const float* cb, const float* lng, const float* lnb, int unit) {
    const int t0 = unit * 32, bstart = (t0 / SEQ) * SEQ, bend = bstart + SEQ, tid = F.tid, lane = F.lane, c0 = 2 * tid;
    LAS float* CV = (LAS float*)(F.lds + RING_OFF);
    unsigned hraw[62];
    { const GAS bf16* zp = (const GAS bf16*)Z + (ptrdiff_t)(t0 - 15) * DIN + ZC_B + c0;
#pragma unroll
      for (int r = 0; r < 62; ++r) { hraw[r] = *(const GAS unsigned*)zp; zp += DIN; asm volatile("" : "+v"(zp)); } }
    f32x2v w[31], acc[31];
    { const GAS float* wp = (const GAS float*)cw + c0;
#pragma unroll
      for (int k = 0; k < 31; ++k) { w[k] = *(const GAS f32x2v*)wp; acc[k] = (f32x2v){0.f, 0.f}; wp += GW; asm volatile("" : "+v"(wp)); } }
    const f32x2v bias = *(const GAS f32x2v*)(cb + c0);
    conv_rows<0>(hraw, w, acc, bias, CV + c0, bstart - (t0 - 15), bend - (t0 - 15));
    __syncthreads();
    { f32x4 x[4][4]; float sm[4], qv[4];
#pragma unroll
      for (int oo = 0; oo < 4; ++oo) { const int o = F.wave * 4 + oo; float s_ = 0.f;
#pragma unroll
          for (int j = 0; j < 4; ++j) { x[oo][j] = *(const LAS f32x4*)(CV + o * GW + lane * 4 + 256 * j); s_ += (x[oo][j].x + x[oo][j].y) + (x[oo][j].z + x[oo][j].w); }
          sm[oo] = s_; }
#pragma unroll
      for (int st = 1; st < 64; st <<= 1) {
#pragma unroll
          for (int oo = 0; oo < 4; ++oo) sm[oo] += __shfl_xor(sm[oo], st); }
#pragma unroll
      for (int oo = 0; oo < 4; ++oo) { const float mean = sm[oo] * (1.f / GW); float q = 0.f;
#pragma unroll
          for (int j = 0; j < 4; ++j) { x[oo][j] = x[oo][j] - mean; q += (x[oo][j].x * x[oo][j].x + x[oo][j].y * x[oo][j].y) + (x[oo][j].z * x[oo][j].z + x[oo][j].w * x[oo][j].w); }
          qv[oo] = q; }
#pragma unroll
      for (int st = 1; st < 64; st <<= 1) {
#pragma unroll
          for (int oo = 0; oo < 4; ++oo) qv[oo] += __shfl_xor(qv[oo], st); }
#pragma unroll
      for (int j = 0; j < 4; ++j) { const int c = lane * 4 + 256 * j; const f32x4 gv = *(const GAS f32x4*)(lng + c), bv = *(const GAS f32x4*)(lnb + c);
#pragma unroll
          for (int oo = 0; oo < 4; ++oo) { const int o = F.wave * 4 + oo; const float rstd = 1.0f / sqrtf(qv[oo] * (1.f / GW) + 1e-5f);
              f32x4 y = x[oo][j] * rstd * gv + bv; y.x *= sigmoidf_fast(y.x); y.y *= sigmoidf_fast(y.y); y.z *= sigmoidf_fast(y.z); y.w *= sigmoidf_fast(y.w);
              u32x2 wv; wv.x = pk2(y.x, y.y); wv.y = pk2(y.z, y.w);
              *(GAS u32x2*)(YC + (size_t)(t0 + o) * DM + YC_B + c) = wv; } } }
    __syncthreads();
}

__device__ __forceinline__ void pool_unit(const Frame& F, const bf16* Z, bf16* YC, const bf16* PWT, const float* scale, int unit) {
    const int g = unit & 3, tile = unit >> 2, t0 = tile * 64, bstart = (t0 / SEQ) * SEQ, tid = F.tid, lane = F.lane, fr = lane & 15, fq = lane >> 4, w = F.wave;
    const int wh = 1 << g;
    LAS bf16* ZT = (LAS bf16*)(F.lds + RING_OFF);
    LAS bf16* P = (LAS bf16*)(F.lds + RING_OFF + 80 * 264 * 2);
    const GAS bf16* pw = (const GAS bf16*)PWT + (size_t)g * 65536;
    bf16x8 Bf[8][2];
#pragma unroll
    for (int kk = 0; kk < 8; ++kk)
#pragma unroll
        for (int n = 0; n < 2; ++n) Bf[kk][n] = *(const GAS bf16x8*)(pw + (size_t)(32 * w + 16 * n + fr) * 256 + 32 * kk + 8 * fq);
    { const GAS bf16* zc = (const GAS bf16*)Z + ZC_C + g * 256; v4u a[5];
#pragma unroll
      for (int i = 0; i < 5; ++i) { const int q = tid + 512 * i, rr = q >> 5, cc = q & 31; int row = t0 - 8 + rr; row = row < bstart ? bstart : (row >= bstart + SEQ ? bstart + SEQ - 1 : row);
          a[i] = *(const GAS v4u*)(zc + (size_t)row * DIN + cc * 8); }
#pragma unroll
      for (int i = 0; i < 5; ++i) { const int q = tid + 512 * i, rr = q >> 5, cc = q & 31; *(LAS v4u*)(ZT + rr * 264 + cc * 8) = a[i]; } }
    __syncthreads();
    { const int cc = tid & 31, rg = tid >> 5;
      auto body = [&](auto GC) __attribute__((always_inline)) { constexpr int WH = 1 << decltype(GC)::value, NU = 2 * WH + 3;
          const int pos0 = t0 - bstart + 4 * rg - WH;
          v4u raw[NU];
#pragma unroll
          for (int i = 0; i < NU; ++i) raw[i] = *(const LAS v4u*)(ZT + (4 * rg - WH + i + 8) * 264 + cc * 8);
          float sw[8];
#pragma unroll
          for (int e = 0; e < 8; ++e) sw[e] = 0.f;
#pragma unroll
          for (int i = 0; i < 2 * WH; ++i) { const unsigned ps = (unsigned)(pos0 + i); float v[8]; unpack8(raw[i], v); const float mk = ps < (unsigned)SEQ ? 1.f : 0.f;
#pragma unroll
              for (int e = 0; e < 8; ++e) sw[e] += v[e] * mk; }
#pragma unroll
          for (int o = 0; o < 4; ++o) {
              if (o > 0) { float va[8], vr[8]; unpack8(raw[2 * WH - 1 + o], va); unpack8(raw[o - 1], vr);
                  const float ma = (unsigned)(pos0 + 2 * WH - 1 + o) < (unsigned)SEQ ? 1.f : 0.f, mr = (unsigned)(pos0 + o - 1) < (unsigned)SEQ ? 1.f : 0.f;
#pragma unroll
                  for (int e = 0; e < 8; ++e) sw[e] += va[e] * ma - vr[e] * mr; }
              const int pos = pos0 + WH + o; const int lo = pos - WH > 0 ? pos - WH : 0, hi = pos + WH < SEQ ? pos + WH : SEQ; const float inv = 1.0f / (float)(hi - lo);
              float v[8]; unpack8(raw[WH + o], v);
              v4u ov; ov.x = pk2(sw[0] * inv - v[0], sw[1] * inv - v[1]); ov.y = pk2(sw[2] * inv - v[2], sw[3] * inv - v[3]); ov.z = pk2(sw[4] * inv - v[4], sw[5] * inv - v[5]); ov.w = pk2(sw[6] * inv - v[6], sw[7] * inv - v[7]);
              *(LAS v4u*)(P + (4 * rg + o) * 264 + cc * 8) = ov; } };
      if (g == 0) body(std::integral_constant<int, 0>{}); else if (g == 1) body(std::integral_constant<int, 1>{}); else if (g == 2) body(std::integral_constant<int, 2>{}); else body(std::integral_constant<int, 3>{}); }
    __syncthreads();
    f32x4 acc[4][2];
#pragma unroll
    for (int m = 0; m < 4; ++m)
#pragma unroll
        for (int n = 0; n < 2; ++n) acc[m][n] = (f32x4){0.f, 0.f, 0.f, 0.f};
#pragma unroll
    for (int kk = 0; kk < 8; ++kk) {
        bf16x8 Af[4];
#pragma unroll
        for (int m = 0; m < 4; ++m) Af[m] = *(const LAS bf16x8*)(P + (16 * m + fr) * 264 + 32 * kk + 8 * fq);
#pragma unroll
        for (int m = 0; m < 4; ++m)
#pragma unroll
            for (int n = 0; n < 2; ++n) acc[m][n] = __builtin_amdgcn_mfma_f32_16x16x32_bf16(Bf[kk][n], Af[m], acc[m][n], 0, 0, 0);
    }
#pragma unroll
    for (int n = 0; n < 2; ++n) { const int d = 32 * w + 16 * n + 4 * fq; const f32x4 sc = *(const GAS f32x4*)(scale + g * 256 + d);
#pragma unroll
        for (int m = 0; m < 4; ++m) { const f32x4 v = acc[m][n] * sc; u32x2 wv; wv.x = pk2(v[0], v[1]); wv.y = pk2(v[2], v[3]);
            *(GAS u32x2*)(YC + (size_t)(t0 + 16 * m + fr) * DM + YC_C + g * 256 + d) = wv; } }
    __syncthreads();
}

namespace att {
typedef __attribute__((ext_vector_type(8))) short bf16x8;
typedef __attribute__((ext_vector_type(4))) short s16x4;
typedef __attribute__((ext_vector_type(16))) float f32x16;
typedef __attribute__((ext_vector_type(4))) unsigned u32x4;
constexpr int QBLK = 32, KVBLK = 64, NW = 8, LDQK = 64, LDV = 128;
constexpr int SHM_V = KVBLK * 128 * 2, SHM_K = KVBLK * 64 * 2;
constexpr int OFF_V = 0, OFF_K = 2 * SHM_V, OFF_WS = OFF_K + 2 * SHM_K, ATT_LDS = OFF_WS + NW * 64 * 4;
constexpr float THR = 8.0f;
#define KSWZ(row, colB) ((row) * 128 + ((colB) ^ ((((row) >> 1) & 7) << 4)))
#define SBAR() __builtin_amdgcn_sched_barrier(0)
__device__ __forceinline__ int crow(int r, int hi) { return (r & 3) + 8 * (r >> 2) + 4 * hi; }
__device__ __forceinline__ unsigned cvtpk(float lo, float hi) { unsigned r; asm volatile("v_cvt_pk_bf16_f32 %0, %1, %2" : "=v"(r) : "v"(lo), "v"(hi)); return r; }

__device__ __forceinline__ void partialSM(f32x16& p0, f32x16& p1, float& m_reg, float& alpha) {
    float pmax = p0[0];
#pragma unroll
    for (int r = 1; r < 16; ++r) pmax = fmaxf(pmax, p0[r]);
#pragma unroll
    for (int r = 0; r < 16; ++r) pmax = fmaxf(pmax, p1[r]);
    { auto rr = __builtin_amdgcn_permlane32_swap(__float_as_uint(pmax), __float_as_uint(pmax), false, false);
      pmax = fmaxf(__uint_as_float(rr[0]), __uint_as_float(rr[1])); }
    if (__builtin_expect(__all(pmax - m_reg <= THR), 1)) { alpha = 1.f; }
    else { const float mn = fmaxf(m_reg, pmax); alpha = __builtin_amdgcn_exp2f(m_reg - mn); m_reg = mn; }
    const float mm = m_reg;
#pragma unroll
    for (int r = 0; r < 16; ++r) { p0[r] -= mm; p1[r] -= mm; }
#pragma unroll
    for (int r = 0; r < 16; ++r) p0[r] = __builtin_amdgcn_exp2f(p0[r]);
}
__device__ __forceinline__ void finishSM(f32x16& p0, f32x16& p1, float alpha, float& l_reg, bf16x8& pa0, bf16x8& pa1, bf16x8& pa2, bf16x8& pa3) {
#pragma unroll
    for (int r = 0; r < 16; ++r) p1[r] = __builtin_amdgcn_exp2f(p1[r]);
    float ps = 0.f;
#pragma unroll
    for (int r = 0; r < 16; ++r) ps += p0[r];
#pragma unroll
    for (int r = 0; r < 16; ++r) ps += p1[r];
    { auto rr = __builtin_amdgcn_permlane32_swap(__float_as_uint(ps), __float_as_uint(ps), false, false);
      ps = __uint_as_float(rr[0]) + __uint_as_float(rr[1]); }
    l_reg = l_reg * alpha + ps;
#define PK4(P, BASE, OUT) do { unsigned a0 = cvtpk(P[BASE + 0], P[BASE + 1]), a1 = cvtpk(P[BASE + 2], P[BASE + 3]);   \
    unsigned b0 = cvtpk(P[BASE + 4], P[BASE + 5]), b1 = cvtpk(P[BASE + 6], P[BASE + 7]);                              \
    auto r0 = __builtin_amdgcn_permlane32_swap(a0, b0, false, false); auto r1 = __builtin_amdgcn_permlane32_swap(a1, b1, false, false); \
    u32x4 w = {r0[0], r1[0], r0[1], r1[1]}; OUT = *reinterpret_cast<bf16x8*>(&w); } while (0)
    PK4(p0, 0, pa0); PK4(p0, 8, pa1); PK4(p1, 0, pa2); PK4(p1, 8, pa3);
#undef PK4
}
__device__ __forceinline__ void qkt(f32x16& p0, f32x16& p1, const char* Ks, const bf16x8* qr, int r32, int hi) {
    p0 = f32x16{}; p1 = f32x16{};
#pragma unroll
    for (int d0 = 0; d0 < 4; ++d0) { const int cb = (d0 * 16 + hi * 8) * 2;
        const bf16x8 b0 = *reinterpret_cast<const bf16x8*>(Ks + KSWZ(r32, cb));
        const bf16x8 b1 = *reinterpret_cast<const bf16x8*>(Ks + KSWZ(32 + r32, cb));
        p0 = __builtin_amdgcn_mfma_f32_32x32x16_bf16(b0, qr[d0], p0, 0, 0, 0);
        p1 = __builtin_amdgcn_mfma_f32_32x32x16_bf16(b1, qr[d0], p1, 0, 0, 0); }
}
__device__ __forceinline__ int v_st(int k, int c) { const int kk = (k & ~0xC) | ((k & 4) << 1) | ((k & 8) >> 1); return ((kk >> 3) * 4 + (c >> 5)) * 512 + ((kk & 7) * 32 + (c & 31)) * 2; }
__device__ __forceinline__ int v_rd_base(int lane) { return ((lane & 3) << 3) | (((lane >> 2) & 3) << 6) | (((lane >> 4) & 1) << 5) | (((lane >> 5) & 1) << 8); }
constexpr int v_rd_off(int d0, int ks, int half) { return d0 * 512 + ks * 4096 + half * 2048; }
template <int OFF> __device__ __forceinline__ s16x4 tr_read(int vb) {
    s16x4 r; asm volatile("ds_read_b64_tr_b16 %0, %1 offset:%2" : "=&v"(r) : "v"(vb), "i"(OFF) : "memory"); return r;
}
template <int D0> __device__ __forceinline__ void pv_one(f32x16& od, int vb, bf16x8 pa0, bf16x8 pa1, bf16x8 pa2, bf16x8 pa3) {
    const s16x4 l0 = tr_read<v_rd_off(D0, 0, 0)>(vb), h0 = tr_read<v_rd_off(D0, 0, 1)>(vb), l1 = tr_read<v_rd_off(D0, 1, 0)>(vb), h1 = tr_read<v_rd_off(D0, 1, 1)>(vb);
    const s16x4 l2 = tr_read<v_rd_off(D0, 2, 0)>(vb), h2 = tr_read<v_rd_off(D0, 2, 1)>(vb), l3 = tr_read<v_rd_off(D0, 3, 0)>(vb), h3 = tr_read<v_rd_off(D0, 3, 1)>(vb);
    asm volatile("s_waitcnt lgkmcnt(0)" ::: "memory"); SBAR();
#define PK(L, H) (bf16x8){L[0], L[1], L[2], L[3], H[0], H[1], H[2], H[3]}
    od = __builtin_amdgcn_mfma_f32_32x32x16_bf16(pa0, PK(l0, h0), od, 0, 0, 0);
    od = __builtin_amdgcn_mfma_f32_32x32x16_bf16(pa1, PK(l1, h1), od, 0, 0, 0);
    od = __builtin_amdgcn_mfma_f32_32x32x16_bf16(pa2, PK(l2, h2), od, 0, 0, 0);
    od = __builtin_amdgcn_mfma_f32_32x32x16_bf16(pa3, PK(l3, h3), od, 0, 0, 0);
#undef PK
}
__device__ __forceinline__ void pv_d0(f32x16* o, int vb, bf16x8 pa0, bf16x8 pa1, bf16x8 pa2, bf16x8 pa3) {
    pv_one<0>(o[0], vb, pa0, pa1, pa2, pa3); pv_one<1>(o[1], vb, pa0, pa1, pa2, pa3); pv_one<2>(o[2], vb, pa0, pa1, pa2, pa3); pv_one<3>(o[3], vb, pa0, pa1, pa2, pa3);
}

__device__ __forceinline__ void attn_pass(const bf16* __restrict__ Qb, const bf16* __restrict__ Kh, const bf16* __restrict__ Vh, char* lds, f32x16 (&o)[4], float& l_out) {
    int tid_ = threadIdx.x; asm volatile("" : "+v"(tid_));
    const int tid = tid_, wid = tid >> 6, lane = tid & 63, r32 = lane & 31, hi = lane >> 5;
    char* V_lds = lds + OFF_V; char* K_lds = lds + OFF_K;
    float* ws = (float*)(lds + OFF_WS) + wid * 64; float* al_l = ws + 32;
    float m_reg = -1e30f, l_reg = 0.f; bf16x8 qr[4];
#pragma unroll
    for (int d = 0; d < 4; ++d) o[d] = f32x16{};
    const GAS bf16* Qw = (const GAS bf16*)Qb + (size_t)(wid * QBLK + r32) * LDQK + hi * 8;
#pragma unroll
    for (int d0 = 0; d0 < 4; ++d0) qr[d0] = *(const GAS bf16x8*)(Qw + d0 * 16);
    const int sr = tid >> 4, sc = (tid & 15) * 8, vst0 = v_st(sr, sc), vst1 = v_st(32 + sr, sc);
    const int kr = tid >> 3, kc = (tid & 7) * 16, kst = KSWZ(kr, kc);
    const int vb0 = (int)(uintptr_t)V_lds + v_rd_base(lane);
    const GAS bf16* Kg = (const GAS bf16*)Kh + (size_t)kr * LDQK + (tid & 7) * 8;
    const GAS bf16* Vg = (const GAS bf16*)Vh + (size_t)sr * LDV + sc;
    struct { bf16x8 vs0, vs1, ks0; } sr_[2];
#define SLOAD(i, k0) do { sr_[i].vs0 = *(const GAS bf16x8*)(Vg + (size_t)(k0) * LDV); sr_[i].vs1 = *(const GAS bf16x8*)(Vg + (size_t)((k0) + 32) * LDV); \
    sr_[i].ks0 = *(const GAS bf16x8*)(Kg + (size_t)(k0) * LDQK); } while (0)
#define SWRITE(b, i) do { *(bf16x8*)(V_lds + (b) * SHM_V + vst0) = sr_[i].vs0; *(bf16x8*)(V_lds + (b) * SHM_V + vst1) = sr_[i].vs1; \
    *(bf16x8*)(K_lds + (b) * SHM_K + kst) = sr_[i].ks0; } while (0)
#define SWAIT() asm volatile("s_waitcnt vmcnt(3)" ::: "memory")
#define RESC(a) do { if (__any((a) < 1.f)) { if (hi == 0) al_l[r32] = (a); asm volatile("s_waitcnt lgkmcnt(0)" ::: "memory"); \
    _Pragma("unroll") for (int d = 0; d < 4; ++d) _Pragma("unroll") for (int r = 0; r < 16; ++r) o[d][r] *= al_l[crow(r, hi)]; } } while (0)
    f32x16 pA0, pA1, pB0, pB1; float alA, alB; bf16x8 pa0, pa1, pa2, pa3; constexpr int NT = SEQ / KVBLK;
    constexpr int SE = 0, SO = 1;
    SLOAD(SE, 0); asm volatile("s_waitcnt vmcnt(0)" ::: "memory"); SWRITE(0, SE); __syncthreads();
    qkt(pA0, pA1, K_lds, qr, r32, hi); partialSM(pA0, pA1, m_reg, alA);
    SLOAD(SO, KVBLK); SLOAD(SE, 2 * KVBLK);
    SWAIT(); SWRITE(1, SO); __syncthreads();
    for (int j = 1; j + 1 < NT; j += 2) {
        SBAR(); qkt(pB0, pB1, K_lds + SHM_K, qr, r32, hi);
        finishSM(pA0, pA1, alA, l_reg, pa0, pa1, pa2, pa3); SBAR();
        SLOAD(SO, (j + 2) * KVBLK); SBAR();
        pv_d0(o, vb0, pa0, pa1, pa2, pa3); partialSM(pB0, pB1, m_reg, alB);
        __syncthreads(); SWAIT(); SWRITE(0, SE);
        RESC(alB); __syncthreads();
        SBAR(); qkt(pA0, pA1, K_lds, qr, r32, hi);
        finishSM(pB0, pB1, alB, l_reg, pa0, pa1, pa2, pa3); SBAR();
        if (j + 3 < NT) SLOAD(SE, (j + 3) * KVBLK); SBAR();
        pv_d0(o, vb0 + SHM_V, pa0, pa1, pa2, pa3); partialSM(pA0, pA1, m_reg, alA);
        __syncthreads(); SWAIT(); SWRITE(1, SO);
        RESC(alA); __syncthreads();
    }
    SBAR(); qkt(pB0, pB1, K_lds + SHM_K, qr, r32, hi);
    finishSM(pA0, pA1, alA, l_reg, pa0, pa1, pa2, pa3); SBAR();
    pv_d0(o, vb0, pa0, pa1, pa2, pa3); partialSM(pB0, pB1, m_reg, alB);
    __syncthreads(); RESC(alB);
    finishSM(pB0, pB1, alB, l_reg, pa0, pa1, pa2, pa3); SBAR();
    pv_d0(o, vb0 + SHM_V, pa0, pa1, pa2, pa3);
    l_out = l_reg;
    __syncthreads();
#undef SLOAD
#undef SWRITE
#undef SWAIT
#undef RESC
}

constexpr int F_OFF_WS = 4 * SHM_V + 4 * SHM_K;
template <int G> __device__ __forceinline__ void pv_rd(s16x4 (&lo)[4], s16x4 (&hh)[4], int vb) {
    lo[0] = tr_read<v_rd_off(G, 0, 0)>(vb); hh[0] = tr_read<v_rd_off(G, 0, 1)>(vb); lo[1] = tr_read<v_rd_off(G, 1, 0)>(vb); hh[1] = tr_read<v_rd_off(G, 1, 1)>(vb);
    lo[2] = tr_read<v_rd_off(G, 2, 0)>(vb); hh[2] = tr_read<v_rd_off(G, 2, 1)>(vb); lo[3] = tr_read<v_rd_off(G, 3, 0)>(vb); hh[3] = tr_read<v_rd_off(G, 3, 1)>(vb);
}
__device__ __forceinline__ void pv_mm(f32x16& od, const s16x4 (&lo)[4], const s16x4 (&hh)[4], bf16x8 pa0, bf16x8 pa1, bf16x8 pa2, bf16x8 pa3) {
#define PK(L, H) (bf16x8){L[0], L[1], L[2], L[3], H[0], H[1], H[2], H[3]}
    od = __builtin_amdgcn_mfma_f32_32x32x16_bf16(pa0, PK(lo[0], hh[0]), od, 0, 0, 0);
    od = __builtin_amdgcn_mfma_f32_32x32x16_bf16(pa1, PK(lo[1], hh[1]), od, 0, 0, 0);
    od = __builtin_amdgcn_mfma_f32_32x32x16_bf16(pa2, PK(lo[2], hh[2]), od, 0, 0, 0);
    od = __builtin_amdgcn_mfma_f32_32x32x16_bf16(pa3, PK(lo[3], hh[3]), od, 0, 0, 0);
#undef PK
}
template <int OFF> __device__ __forceinline__ bf16x8 lds_rd128(int addr) { bf16x8 r; asm volatile("ds_read_b128 %0, %1 offset:%2" : "=&v"(r) : "v"(addr), "i"(OFF) : "memory"); return r; }
__device__ __forceinline__ float fadd_s(float a, float b) { float r; asm("v_add_f32_e32 %0, %1, %2" : "=v"(r) : "v"(a), "v"(b)); return r; }
constexpr int F_NSLOT = 4;
constexpr int F2_OFF_V = 0, F2_OFF_K = F_NSLOT * SHM_V, F2_END = F2_OFF_K + F_NSLOT * SHM_K;
static_assert(F2_END <= F_OFF_WS, "attention rings below the per-wave scratch");
template <int ABL> __device__ __forceinline__ void attn_pass_fast(const bf16* __restrict__ Qb, const bf16* __restrict__ Kh, const bf16* __restrict__ Vh, char* lds, f32x16 (&o)[4], float& l_out) {
    int tid_ = threadIdx.x; asm volatile("" : "+v"(tid_));
    const int tid = tid_, wid = __builtin_amdgcn_readfirstlane(tid >> 6), lane = tid & 63, r32 = lane & 31, hi = lane >> 5; const bool trail = wid >= 4;
    LAS unsigned char* ldsl = (LAS unsigned char*)(unsigned)(uintptr_t)lds;
    bf16x8 qr[4];
#pragma unroll
    for (int d = 0; d < 4; ++d) o[d] = f32x16{};
    const GAS bf16* Qw = (const GAS bf16*)Qb + (size_t)(wid * QBLK + r32) * LDQK + hi * 8;
#pragma unroll
    for (int d0 = 0; d0 < 4; ++d0) qr[d0] = *(const GAS bf16x8*)(Qw + d0 * 16);
    const int krow = wid * 8 + (lane >> 3), kpos = lane & 7;
    const GAS bf16* Kg = (const GAS bf16*)Kh + (size_t)krow * LDQK + ((kpos ^ ((krow >> 1) & 7)) * 8);
    const int vsub0 = 4 * wid + (lane >> 5), vsub1 = vsub0 + 2;
    const int vkk0 = (vsub0 >> 2) * 8 + ((lane & 31) >> 2), vkk1 = (vsub1 >> 2) * 8 + ((lane & 31) >> 2);
    const GAS bf16* Vg0 = (const GAS bf16*)Vh + (size_t)vkk0 * LDV + (vsub0 & 3) * 32 + (lane & 3) * 8;
    const GAS bf16* Vg1 = (const GAS bf16*)Vh + (size_t)vkk1 * LDV + (vsub1 & 3) * 32 + (lane & 3) * 8;
    const int vb0 = (int)(unsigned)(uintptr_t)(lds + F2_OFF_V) + v_rd_base(lane);
    const int kbase = (int)(unsigned)(uintptr_t)(lds + F2_OFF_K);
    const int ka0 = kbase + KSWZ(r32, (0 * 16 + hi * 8) * 2), ka1 = kbase + KSWZ(r32, (1 * 16 + hi * 8) * 2), ka2 = kbase + KSWZ(r32, (2 * 16 + hi * 8) * 2), ka3 = kbase + KSWZ(r32, (3 * 16 + hi * 8) * 2);
    constexpr int NT = SEQ / KVBLK;
#define FBAR() do { asm volatile("s_waitcnt lgkmcnt(0)\n\ts_barrier" ::: "memory"); SBAR(); } while (0)
#define DMA_K(t, slot) __builtin_amdgcn_global_load_lds((const GAS unsigned*)(Kg + (size_t)(t) * KVBLK * LDQK), (LAS unsigned*)(ldsl + F2_OFF_K + (slot) * SHM_K + wid * 1024), 16, 0, 0)
#define DMA_V(t, slot) do { __builtin_amdgcn_global_load_lds((const GAS unsigned*)(Vg0 + (size_t)(t) * KVBLK * LDV), (LAS unsigned*)(ldsl + F2_OFF_V + (slot) * SHM_V + wid * 2048), 16, 0, 0); \
    __builtin_amdgcn_global_load_lds((const GAS unsigned*)(Vg1 + (size_t)(t) * KVBLK * LDV), (LAS unsigned*)(ldsl + F2_OFF_V + (slot) * SHM_V + wid * 2048 + 1024), 16, 0, 0); } while (0)
#define KREAD(kb) do { kf[0] = lds_rd128<0>(ka0 + (kb)); kf[1] = lds_rd128<4096>(ka0 + (kb)); kf[2] = lds_rd128<0>(ka1 + (kb)); kf[3] = lds_rd128<4096>(ka1 + (kb)); \
    kf[4] = lds_rd128<0>(ka2 + (kb)); kf[5] = lds_rd128<4096>(ka2 + (kb)); kf[6] = lds_rd128<0>(ka3 + (kb)); kf[7] = lds_rd128<4096>(ka3 + (kb)); } while (0)
#define QKT() do { p0 = __builtin_amdgcn_mfma_f32_32x32x16_bf16(kf[0], qr[0], f32x16{}, 0, 0, 0); p1 = __builtin_amdgcn_mfma_f32_32x32x16_bf16(kf[1], qr[0], f32x16{}, 0, 0, 0); \
    p0 = __builtin_amdgcn_mfma_f32_32x32x16_bf16(kf[2], qr[1], p0, 0, 0, 0); p1 = __builtin_amdgcn_mfma_f32_32x32x16_bf16(kf[3], qr[1], p1, 0, 0, 0); \
    p0 = __builtin_amdgcn_mfma_f32_32x32x16_bf16(kf[4], qr[2], p0, 0, 0, 0); p1 = __builtin_amdgcn_mfma_f32_32x32x16_bf16(kf[5], qr[2], p1, 0, 0, 0); \
    p0 = __builtin_amdgcn_mfma_f32_32x32x16_bf16(kf[6], qr[3], p0, 0, 0, 0); p1 = __builtin_amdgcn_mfma_f32_32x32x16_bf16(kf[7], qr[3], p1, 0, 0, 0); } while (0)
    bf16x8 kf[8];
    DMA_K(0, 0); DMA_K(1, 1); DMA_K(2, 2); DMA_V(0, 0); DMA_V(1, 1);
    asm volatile("s_waitcnt vmcnt(0)" ::: "memory");
    __syncthreads();
    if (trail) FBAR();
    f32x16 p0, p1; bf16x8 pa0, pa1, pa2, pa3; float l_reg = 0.f;
    KREAD(0); asm volatile("s_waitcnt lgkmcnt(0)" ::: "memory"); SBAR();
#define EXP8(P, B) do { _Pragma("unroll") for (int r_ = 0; r_ < 8; ++r_) P[(B) + r_] = __builtin_amdgcn_exp2f(P[(B) + r_]); } while (0)
    QKT();
    EXP8(p0, 0); EXP8(p0, 8); EXP8(p1, 0); EXP8(p1, 8);
    FBAR();
    int ks_w = 3, vs_w = 2;
    int kb_r = SHM_K, vb_r = 0;
    s16x4 la[4], ha[4], lb[4], hb[4];
#pragma unroll 1
    for (int x = 0; x < NT; ++x) {
        const int vb = vb0 + vb_r;
        if (x + 1 < NT) KREAD(kb_r);
        pv_rd<0>(la, ha, vb); pv_rd<1>(lb, hb, vb);
        if (x + 3 < NT) DMA_K(x + 3, ks_w);
        if (x + 2 < NT) DMA_V(x + 2, vs_w);
        { float a = fadd_s(p0[0], p0[1]), b = fadd_s(p0[2], p0[3]), c = fadd_s(p1[0], p1[1]), d = fadd_s(p1[2], p1[3]);
#pragma unroll
          for (int r = 4; r < 16; r += 4) { a = fadd_s(a, fadd_s(p0[r], p0[r + 1])); b = fadd_s(b, fadd_s(p0[r + 2], p0[r + 3])); c = fadd_s(c, fadd_s(p1[r], p1[r + 1])); d = fadd_s(d, fadd_s(p1[r + 2], p1[r + 3])); }
          l_reg = fadd_s(l_reg, fadd_s(fadd_s(a, b), fadd_s(c, d))); }
        { u32x4 w;
          w = (u32x4){cvtpk(p0[0], p0[1]), cvtpk(p0[2], p0[3]), cvtpk(p0[4], p0[5]), cvtpk(p0[6], p0[7])}; pa0 = __builtin_bit_cast(bf16x8, w);
          w = (u32x4){cvtpk(p0[8], p0[9]), cvtpk(p0[10], p0[11]), cvtpk(p0[12], p0[13]), cvtpk(p0[14], p0[15])}; pa1 = __builtin_bit_cast(bf16x8, w);
          w = (u32x4){cvtpk(p1[0], p1[1]), cvtpk(p1[2], p1[3]), cvtpk(p1[4], p1[5]), cvtpk(p1[6], p1[7])}; pa2 = __builtin_bit_cast(bf16x8, w);
          w = (u32x4){cvtpk(p1[8], p1[9]), cvtpk(p1[10], p1[11]), cvtpk(p1[12], p1[13]), cvtpk(p1[14], p1[15])}; pa3 = __builtin_bit_cast(bf16x8, w); }
        if (x + 3 < NT) asm volatile("s_waitcnt vmcnt(3)" ::: "memory"); else asm volatile("s_waitcnt vmcnt(0)" ::: "memory");
        FBAR();
        __builtin_amdgcn_s_setprio(2);
#define MIX4() do { _Pragma("unroll") for (int i_ = 0; i_ < 4; ++i_) { __builtin_amdgcn_sched_group_barrier(0x008, 1, 0); __builtin_amdgcn_sched_group_barrier(0x400, 2, 0); } } while (0)
        if (x + 1 < NT) QKT();
        SBAR();
        pv_mm(o[0], la, ha, pa0, pa1, pa2, pa3);
        EXP8(p0, 0);
        MIX4(); SBAR();
        pv_rd<2>(la, ha, vb);
        pv_mm(o[1], lb, hb, pa0, pa1, pa2, pa3);
        EXP8(p0, 8);
        MIX4(); SBAR();
        pv_rd<3>(lb, hb, vb);
        __builtin_amdgcn_s_setprio(0);
        asm volatile("s_waitcnt lgkmcnt(8)" ::: "memory"); SBAR();
        pv_mm(o[2], la, ha, pa0, pa1, pa2, pa3);
        EXP8(p1, 0);
        MIX4(); SBAR();
        asm volatile("s_waitcnt lgkmcnt(0)" ::: "memory"); SBAR();
        pv_mm(o[3], lb, hb, pa0, pa1, pa2, pa3);
        EXP8(p1, 8);
        MIX4(); SBAR();
#undef MIX4
        __builtin_amdgcn_s_setprio(0);
        ks_w = (ks_w + 1) & 3; vs_w = (vs_w + 1) & 3;
        kb_r = (kb_r + SHM_K) & (F_NSLOT * SHM_K - 1); vb_r = (vb_r + SHM_V) & (F_NSLOT * SHM_V - 1);
        FBAR();
    }
    if (!trail) FBAR();
    { auto rr = __builtin_amdgcn_permlane32_swap(__float_as_uint(l_reg), __float_as_uint(l_reg), false, false); l_reg = __uint_as_float(rr[0]) + __uint_as_float(rr[1]); }
    l_out = l_reg;
    __syncthreads();
#undef FBAR
#undef DMA_K
#undef DMA_V
#undef KREAD
#undef QKT
#undef EXP8
}

template <int ABL> __device__ __forceinline__ void attn_unit(int b, int h, int qb, const bf16* QH, const bf16* KH, const bf16* VH, bf16* YC, float* OS, const float* subg, float lam, float oscale, char* lds, bool fast) {
    int tid_ = threadIdx.x; asm volatile("" : "+v"(tid_));
    const int tid = tid_, wid = tid >> 6, lane = tid & 63, r32 = lane & 31, hi = lane >> 5;
    const size_t rowbase = (size_t)b * SEQ, q0 = rowbase + (size_t)qb * 256;
    float* wsf = (float*)(lds + F_OFF_WS) + wid * 64;
#pragma unroll 1
    for (int c = 0; c < 2; ++c) {
        f32x16 o[4]; float l;
        const size_t hcb = (size_t)((b * 16 + h * 2 + c)) * SEQ; const bf16* Qp = QH + (hcb + (size_t)qb * 256) * LDQK; const bf16* Kp = KH + hcb * LDQK; const bf16* Vp = VH + (size_t)(b * 8 + h) * SEQ * LDV;
        if (fast) attn_pass_fast<ABL>(Qp, Kp, Vp, lds, o, l);
        else attn_pass(Qp, Kp, Vp, lds, o, l);
        if (hi == 0) wsf[r32] = l; asm volatile("s_waitcnt lgkmcnt(0)" ::: "memory");
        float rli[16];
#pragma unroll
        for (int r = 0; r < 16; ++r) rli[r] = 1.0f / wsf[crow(r, hi)];
        GAS float* os = (GAS float*)OS + (q0 + wid * QBLK + 4 * hi) * GW + h * 128 + r32;
        asm volatile("" : "+v"(os));
        if (c == 0) {
#pragma unroll
            for (int r = 0; r < 16; ++r) { GAS float* p = os + ((r & 3) + 8 * (r >> 2)) * GW; asm volatile("" : "+v"(p));
#pragma unroll
                for (int d0 = 0; d0 < 4; ++d0) p[d0 * 32] = o[d0][r] * rli[r]; }
        } else {
            float ssq[16], ov[16][4];
#pragma unroll
            for (int r = 0; r < 16; ++r) { const GAS float* p = os + ((r & 3) + 8 * (r >> 2)) * GW; asm volatile("" : "+v"(p));
#pragma unroll
                for (int d0 = 0; d0 < 4; ++d0) ov[r][d0] = p[d0 * 32]; }
#pragma unroll
            for (int r = 0; r < 16; ++r) { float s = 0.f;
#pragma unroll
                for (int d0 = 0; d0 < 4; ++d0) { const float v = ov[r][d0] - lam * (o[d0][r] * rli[r]); o[d0][r] = v; s += v * v; }
                ssq[r] = s; }
#pragma unroll
            for (int r = 0; r < 16; ++r) { float s = ssq[r]; s += __shfl_xor(s, 1); s += __shfl_xor(s, 2); s += __shfl_xor(s, 4); s += __shfl_xor(s, 8); s += __shfl_xor(s, 16);
                ssq[r] = oscale / sqrtf(s * (1.f / 128.f) + 1e-6f); }
            GAS bf16* yo = (GAS bf16*)YC + (q0 + wid * QBLK + 4 * hi) * DM + YC_D + h * 128 + r32;
            asm volatile("" : "+v"(yo));
#pragma unroll
            for (int r = 0; r < 16; ++r) { GAS bf16* p = yo + ((r & 3) + 8 * (r >> 2)) * DM; asm volatile("" : "+v"(p));
#pragma unroll
                for (int d0 = 0; d0 < 4; ++d0) p[d0 * 32] = (bf16)f2bf(o[d0][r] * ssq[r] * subg[d0 * 32 + r32]); }
        }
        asm volatile("s_waitcnt vmcnt(0) lgkmcnt(0)" ::: "memory");
    }
}
#undef KSWZ
#undef SBAR
}

__global__ void __launch_bounds__(NWAVES * 64, 2) hybrid_fwd(Args args) {
    extern __shared__ __attribute__((aligned(16))) unsigned char lds[];
    Frame F;
    F.lds = (LAS unsigned char*)lds;
    F.MISC = (volatile LAS unsigned*)(F.lds + MISC_OFF);
    F.tid = threadIdx.x; F.lane = F.tid & 63; F.wave = __builtin_amdgcn_readfirstlane(F.tid >> 6);
    F.G = gridDim.x; { const int bx = blockIdx.x; F.vcu = (F.G % 8 == 0) ? (bx % 8) * (F.G / 8) + bx / 8 : bx; }
    unsigned char* ws = args.ws;
    F.ctl = (gu32*)(ws + WS_CTL);
    for (int u = F.tid; u < (LDS_BYTES - LDSCTL_OFF) / 4; u += NWAVES * 64) ((LAS unsigned*)(F.lds + LDSCTL_OFF))[u] = 0u;
    __syncthreads();
#if MK_SPLIT
#define GRID_BAR() do { } while (0)
#else
    XcdBarrier bar = xcd_barrier_post((unsigned*)(F.ctl + CW_BAR), F.MISC + 8);
#define GRID_BAR() xcd_barrier(bar)
#endif
    const int lo = args.ph_lo, hi = args.ph_hi;
#ifndef PH_MASK
#define PH_MASK 0x1FF
#endif
#define IN(k) (lo <= (k) && (k) < hi)
#define PM(b) ((PH_MASK >> (b)) & 1)
#ifndef LM
#define LM 15
#endif
#ifndef PROBE_DUP
#define PROBE_DUP 0
#endif
#define DUP(b) ((PROBE_DUP >> (b)) & 1)
#ifndef PROBE_XBAR
#define PROBE_XBAR 0
#endif
#define SEAM(k, DI) do { if ((k) + 1 < hi) { seam_steal(F, args, bar, (DI)); for (int xb_ = 0; xb_ < PROBE_XBAR; ++xb_) GRID_BAR(); } } while (0)

    bf16* const XN = (bf16*)(ws + WS_XN); bf16* const Z = (bf16*)(ws + WS_Z); bf16* const YC = (bf16*)(ws + WS_YC); bf16* const HB = (bf16*)(ws + WS_HB);
    float* const OS = (float*)(ws + WS_OS); const float* const rope = (const float*)(ws + WS_ROPE);
    const float* const x_in = args.in[0]; float* const out = args.out;

    bf16* const XB = XN; float* const SS = (float*)(ws + WS_SS);
    if (PM(8) && IN(0)) { p0_prologue(F, args); xprep_phase(F, x_in, XB, SS); if (DUP(8)) { p0_prologue(F, args); xprep_phase(F, x_in, XB, SS); } SEAM(0, 0); }

#define FRESH() do { int t_ = threadIdx.x; asm volatile("" : "+v"(t_)); F.tid = t_; F.lane = t_ & 63; F.wave = __builtin_amdgcn_readfirstlane(t_ >> 6); } while (0)
    for (int l = 0; l < NLAYER; ++l) {
        const int pb = 1 + 5 * l;
        const float* xcur = (l == 0) ? x_in : out;
        const LAS float* rstab = (const LAS float*)(F.lds + RSTAB_OFF);
        if (PM(0) && IN(pb + 0)) { FRESH();
            pg8::Gemm g{XB, (const bf16*)(ws + WS_WIN) + (size_t)l * DIN * DM, M, DIN, DM}; pg8::StaticOrder S; S.init(M, DIN, F.G, (int)blockIdx.x);
            { pg8::Unit u0; S.next(0, u0); rs_table(F, SS, u0.pm); }
            pg8::EpiZ E{Z, DIN, rstab, (float*)(ws + WS_SV), args.in[13] + l * 64, args.in[14] + l * 64, rope, QSCALE, SEQ - 1, 13, (bf16*)(ws + WS_QH), (bf16*)(ws + WS_KH), (bf16*)(ws + WS_VH)};
            pg8::gemm_phase<pg8::EpiZ, pg8::StaticOrder, true, true>(F.lds + RING_OFF, g, S, E);
            if (DUP(0)) pg8::gemm_phase<pg8::EpiZ, pg8::StaticOrder, true, true>(F.lds + RING_OFF, g, S, E);
            SEAM(pb + 0, 0);
        }
        if (PM(2) && IN(pb + 1)) { FRESH();
            float s1 = 0.f, s2 = 0.f;
            for (int i = 0; i < 64; ++i) { s1 += args.in[15][l * 64 + i] * args.in[16][l * 64 + i]; s2 += args.in[17][l * 64 + i] * args.in[18][l * 64 + i]; }
            const float lam_init = (l == 0) ? 0.2f : 0.35550907f;
            const float lam = expf(s1) - expf(s2) + lam_init;
            float gqm = 0.f, gkm = 0.f;
            for (int i = 0; i < 64; ++i) { gqm = fmaxf(gqm, fabsf(args.in[13][l * 64 + i])); gkm = fmaxf(gkm, fabsf(args.in[14][l * 64 + i])); }
            const bool fastsm = (64.0f * gqm * gkm * QSCALE * 1.02f) < 40.0f;
#ifndef ATT_ABL
#define ATT_ABL 0
#endif
            if (DUP(2)) for (int U = F.vcu; U < BATCH * 8 * (SEQ / 256); U += F.G) {
                const int xg = (U % 256) / 32, i = U / 256, qb = U % 32, bh = xg * 2 + i;
                att::attn_unit<ATT_ABL>(bh >> 3, bh & 7, qb, (const bf16*)(ws + WS_QH), (const bf16*)(ws + WS_KH), (const bf16*)(ws + WS_VH), HB, (float*)(ws + WS_HB + 256 * MiB), args.in[19] + l * 128, lam, 1.0f - lam_init, (char*)lds + RING_OFF, fastsm);
            }
            for (int U = F.vcu; U < BATCH * 8 * (SEQ / 256); U += F.G) {
                const int xg = (U % 256) / 32, i = U / 256, qb = U % 32, bh = xg * 2 + i;
                att::attn_unit<0>(bh >> 3, bh & 7, qb, (const bf16*)(ws + WS_QH), (const bf16*)(ws + WS_KH), (const bf16*)(ws + WS_VH), YC, OS, args.in[19] + l * 128, lam, 1.0f - lam_init, (char*)lds + RING_OFF, fastsm);
            }
        }
        if (PM(1) && IN(pb + 1)) { FRESH();
            for (int rep = 0; rep < 1 + DUP(1); ++rep) { FRESH();
            if (LM & 2) for (int u = F.vcu; u < (M / 128) * 4; u += F.G) gmlp_unit(F, Z, YC, (const float*)(ws + WS_SV), (const bf16*)(ws + WS_GWS) + (size_t)l * 8 * 128 * 128, args.in[6] + l * 8 * 128, args.in[3] + l * GW, args.in[4] + l * GW, u, (char*)lds);
            FRESH();
            if (LM & 4) for (int u = F.vcu; u < M / 32; u += F.G) conv_unit(F, Z, YC, args.in[7] + (size_t)l * 31 * GW, args.in[8] + l * GW, args.in[9] + l * GW, args.in[10] + l * GW, u);
            FRESH();
            if (LM & 8) for (int u = F.vcu; u < (M / 64) * 4; u += F.G) pool_unit(F, Z, YC, (const bf16*)(ws + WS_PWT) + (size_t)l * 4 * 65536, args.in[12] + l * GW, u);
            }
            SEAM(pb + 1, cv_deadline(l, 1));
        }
        if (PM(3) && IN(pb + 2)) { FRESH();
            pg8::Gemm g{YC, (const bf16*)(ws + WS_WOUT) + (size_t)l * DM * DM, M, DM, DM}; pg8::StaticOrder S; S.init(M, DM, F.G, (int)blockIdx.x);
            if (l == 0) { typedef pg8::EpiRes<false, false> E_t; E_t E{x_in, nullptr, DM, XB, SS};
                if (DUP(3)) { E_t E2{x_in, nullptr, DM, HB, OS}; pg8::gemm_phase<E_t, pg8::StaticOrder, true, true>(F.lds + RING_OFF, g, S, E2); }
                pg8::gemm_phase<E_t, pg8::StaticOrder, true, true>(F.lds + RING_OFF, g, S, E); }
            else { typedef pg8::EpiRes<true, false> E_t; E_t E{XB, nullptr, DM, XB, SS};
                if (DUP(3)) { E_t E2{XB, nullptr, DM, HB, OS}; pg8::gemm_phase<E_t, pg8::StaticOrder, true, true>(F.lds + RING_OFF, g, S, E2); }
                pg8::gemm_phase<E_t, pg8::StaticOrder, true, true>(F.lds + RING_OFF, g, S, E); }
            SEAM(pb + 2, cv_deadline(l, 2));
        }
        if (PM(4) && IN(pb + 3)) { FRESH();
            pg8::Gemm g{XB, (const bf16*)(ws + WS_WUP) + (size_t)l * DFF * DM, M, DFF, DM}; pg8::StaticOrder S; S.init(M, DFF, F.G, (int)blockIdx.x);
            { pg8::Unit u0; S.next(0, u0); rs_table(F, SS, u0.pm); }
            pg8::EpiRelu2 E{HB, DFF, rstab};
#ifdef PROBE_SPLIT_UP
            { pg8::StaticOrder S1 = S; S1.i1 = 8; pg8::gemm_phase<pg8::EpiRelu2, pg8::StaticOrder, true, true>(F.lds + RING_OFF, g, S1, E); GRID_BAR();
              pg8::StaticOrder S2 = S; S2.i0 = 8; pg8::gemm_phase<pg8::EpiRelu2, pg8::StaticOrder, true, true>(F.lds + RING_OFF, g, S2, E); }
#else
            pg8::gemm_phase<pg8::EpiRelu2, pg8::StaticOrder, true, true>(F.lds + RING_OFF, g, S, E);
#endif
            if (DUP(4)) { if (DUP(10)) { pg8::EpiRelu2T<true> E2{(bf16*)Z, DFF, rstab}; pg8::gemm_phase<pg8::EpiRelu2T<true>, pg8::StaticOrder, true, true>(F.lds + RING_OFF, g, S, E2); }
                          else pg8::gemm_phase<pg8::EpiRelu2, pg8::StaticOrder, true, true>(F.lds + RING_OFF, g, S, E); }
            SEAM(pb + 3, cv_deadline(l, 3));
        }
        if (PM(5) && IN(pb + 4)) { FRESH();
            pg8::Gemm g{HB, (const bf16*)(ws + WS_WDN) + (size_t)l * DM * DFF, M, DM, DFF}; pg8::StaticOrder S; S.init(M, DM, F.G, (int)blockIdx.x);
            if (l + 1 < NLAYER) { typedef pg8::EpiRes<true, false> E_t; E_t E{XB, nullptr, DM, XB, SS};
                if (DUP(5)) { E_t E2{XB, nullptr, DM, YC, OS}; pg8::gemm_phase<E_t, pg8::StaticOrder, true, true>(F.lds + RING_OFF, g, S, E2); }
                pg8::gemm_phase<E_t, pg8::StaticOrder, true, true>(F.lds + RING_OFF, g, S, E); }
            else { typedef pg8::EpiRes<true, true> E_t; E_t E{XB, out, DM, nullptr, nullptr};
                if (DUP(5)) { E_t E2{XB, (float*)Z, DM, nullptr, nullptr}; pg8::gemm_phase<E_t, pg8::StaticOrder, true, true>(F.lds + RING_OFF, g, S, E2); }
                pg8::gemm_phase<E_t, pg8::StaticOrder, true, true>(F.lds + RING_OFF, g, S, E); }
            SEAM(pb + 4, cv_deadline(l + 1, 0));
        }
    }
#ifdef DIAG_STEAL
    if (blockIdx.x == 0 && threadIdx.x == 0) { asm volatile("s_waitcnt vmcnt(0)" ::: "memory"); const unsigned cnt = xb_ld((unsigned*)(F.ctl + CW_Q + 1024)); out[0] = 1000.0f * (float)cnt / (float)CV_TOTAL; }
#endif
#undef IN
#undef SEAM
}

constexpr int N_PHASES = 1 + 5 * NLAYER;
extern "C" void kernel_launch(void* const* d_in, const int* in_sizes, int n_in, void* d_out, int out_size, void* d_ws, size_t ws_size, hipStream_t stream) {
    static int grid = 0;
    if (grid == 0) {
        if (n_in != 24 || in_sizes[0] != M * DM || out_size != M * DM || ws_size < WS_END) { fprintf(stderr, "kernel_launch: unexpected shapes (n_in %d, in0 %d, out %d, ws %zu; need ws >= %zu); nothing launched\n", n_in, n_in > 0 ? in_sizes[0] : -1, out_size, ws_size, (size_t)WS_END); grid = -1; return; }
        int dev = 0, cus = 0, per_cu = 0;
        if (hipGetDevice(&dev) != hipSuccess || hipDeviceGetAttribute(&cus, hipDeviceAttributeMultiprocessorCount, dev) != hipSuccess) { fprintf(stderr, "kernel_launch: device query failed\n"); grid = -1; return; }
        if (hipFuncSetAttribute((const void*)hybrid_fwd, hipFuncAttributeMaxDynamicSharedMemorySize, LDS_BYTES) != hipSuccess) { fprintf(stderr, "kernel_launch: hipFuncSetAttribute failed\n"); grid = -1; return; }
        if (hipOccupancyMaxActiveBlocksPerMultiprocessor(&per_cu, (const void*)hybrid_fwd, NWAVES * 64, LDS_BYTES) != hipSuccess || per_cu < 1)
            fprintf(stderr, "kernel_launch: note: occupancy query reports %d workgroups per CU\n", per_cu);
        (void)hipGetLastError();
        grid = cus;
        if (grid != 256) { fprintf(stderr, "kernel_launch: built for a 256-CU device (one row panel per workgroup in every GEMM phase); found %d CUs; nothing launched\n", cus); grid = -1; return; }
    }
    if (grid < 0) return;
    if (hipMemsetAsync((char*)d_ws + WS_CTL, 0, CTL_ZERO_BYTES, stream) != hipSuccess) { fprintf(stderr, "kernel_launch: memset failed\n"); return; }
    Args a{};
    for (int i = 0; i < 24; ++i) a.in[i] = (const float*)d_in[i];
    a.out = (float*)d_out; a.ws = (unsigned char*)d_ws;
#if MK_SPLIT
    for (int p = 0; p < N_PHASES; ++p) { a.ph_lo = p; a.ph_hi = p + 1; hipLaunchKernelGGL(hybrid_fwd, dim3(grid), dim3(NWAVES * 64), LDS_BYTES, stream, a); }
#else
    a.ph_lo = 0; a.ph_hi = N_PHASES; hipLaunchKernelGGL(hybrid_fwd, dim3(grid), dim3(NWAVES * 64), LDS_BYTES, stream, a);
#endif
    const hipError_t le = hipPeekAtLastError();
    if (le != hipSuccess) fprintf(stderr, "kernel_launch: launch failed: %s\n", hipGetErrorName(le));
}
```

```cpp
#include <hip/hip_runtime.h>
#include <cstdio>
#include <cstdint>
#include <type_traits>
namespace pg8 {
#define PG8_LAS __attribute__((address_space(3)))
typedef unsigned short bf16_t;
typedef short bf16x8 __attribute__((ext_vector_type(8)));
typedef float f32x4 __attribute__((ext_vector_type(4)));
typedef unsigned u32x4 __attribute__((ext_vector_type(4)));
constexpr int BM = 256, BK = 64, HALF = 128, HTB = HALF * BK * 2  , STAGE_BYTES = 8 * HTB, NXCD = 8, WGM = 8;

__host__ __device__ __forceinline__ int lds_byte(int r, int c) { const int st = (r >> 4) * 2 + (c >> 5), rr = r & 15, cc = c & 31, ob = rr * 64 + cc * 2; return st * 1024 + (ob ^ (((ob >> 9) & 1) << 5)); }
__host__ __device__ __forceinline__ void stage_rc(int b, int& R, int& C) { const int st = b / 1024, sb = b % 1024, swz = sb ^ (((sb >> 9) & 1) << 5); R = (st >> 1) * 16 + swz / 64; C = (st & 1) * 32 + (swz % 64) / 2; }
__host__ __device__ __forceinline__ int perm32(int rho) { const int n = rho >> 4, i = rho & 15; return 8 * (i >> 2) + 4 * n + (i & 3); }

struct Unit { int pm, pn; };
struct Gemm { const bf16_t* A; const bf16_t* Bt; int M, N, K; };

struct StaticOrder {
    int nM, nN, nwg, G, c, i0 = 0, i1 = 1 << 30;
    __host__ __device__ __forceinline__ void init(int M, int N, int G_, int c_) { nM = M / BM; nN = N / BM; nwg = nM * nN; G = G_; c = c_; }
    __host__ __device__ __forceinline__ bool next(int i_, Unit& u) const {
        const int i = i_ + i0; if (i >= i1) return false;
        const long L = (long)i * G + c; if (L >= nwg) return false;
        int wgid = (int)L; { const int q = nwg / NXCD, r = nwg % NXCD, xcd = wgid % NXCD, off = wgid / NXCD; wgid = (xcd < r ? xcd * (q + 1) : r * (q + 1) + (xcd - r) * q) + off; }
        const int nig = WGM * nN, gid = wgid / nig, fm = gid * WGM, gsz = (nM - fm) < WGM ? (nM - fm) : WGM;
        u.pm = fm + ((wgid % nig) % gsz); u.pn = (wgid % nig) / gsz; return true;
    }
    __device__ __forceinline__ void a_ready(const Unit&) const {}
    __device__ __forceinline__ void done(const Unit&) const {}
};

__device__ __forceinline__ unsigned cvt_pk_bf16(float lo, float hi) { unsigned r; asm volatile("v_cvt_pk_bf16_f32 %0, %1, %2" : "=v"(r) : "v"(lo), "v"(hi)); return r; }
typedef float f32x2 __attribute__((ext_vector_type(2)));
__device__ __forceinline__ f32x2 gelu_pk(f32x2 v) {
    const f32x2 av = __builtin_elementwise_abs(v), d = av * 0.2316418882f + 1.0f;
    f32x2 t; t.x = __builtin_amdgcn_rcpf(d.x); t.y = __builtin_amdgcn_rcpf(d.y);
    f32x2 q = t * 0.5307027145f + (-0.7265760135f); q = q * t + 0.7107068705f; q = q * t + (-0.142248368f); q = q * t + 0.127414796f; q = q * t;
    const f32x2 s = (v * v) * (-0.72134752044f);
    f32x2 e; e.x = __builtin_amdgcn_exp2f(s.x); e.y = __builtin_amdgcn_exp2f(s.y);
    const f32x2 m = v * (q * e), r = v - m;
    f32x2 o; o.x = v.x < 0.f ? m.x : r.x; o.y = v.y < 0.f ? m.y : r.y; return o;
}

template <int ACT  > struct EpiBf16 {
    static constexpr bool PERM = true, AFTER_DRAIN = false; static_assert(ACT == 0 || ACT == 1, "EpiBf16: ACT is 0 (none) or 1 (gelu_pk)");
    bf16_t* O; int ldc; const float* bias; int split_cols; size_t split_stride; float scale0;
    __device__ __forceinline__ void operator()(const f32x4 (&acc)[2][2][4][2], const Unit& u, int wr, int wc, int fr, int fq) const {
        const int row0 = u.pm * BM + wr * 64 + fr; int colt = u.pn * BM; bf16_t* base = O;
        float sc = 1.f; if (split_cols) { const int t = colt / split_cols; base += (size_t)t * split_stride; colt -= t * split_cols; if (t == 0) sc = scale0; }
        const int col0 = colt + wc * 32 + 8 * fq, bcol0 = u.pn * BM + wc * 32 + 8 * fq;
        f32x4 bv[2][2];
#pragma unroll
        for (int bj = 0; bj < 2; ++bj)
#pragma unroll
            for (int n = 0; n < 2; ++n) bv[bj][n] = bias ? *(const f32x4*)(bias + bcol0 + bj * HALF + 4 * n) : (f32x4){0.f, 0.f, 0.f, 0.f};
#pragma unroll
        for (int ai = 0; ai < 2; ++ai)
#pragma unroll
            for (int m = 0; m < 4; ++m) { bf16_t* rowp = base + (size_t)(row0 + ai * HALF + m * 16) * ldc + col0;
#pragma unroll
                for (int bj = 0; bj < 2; ++bj) { f32x4 v0 = acc[ai][bj][m][0] + bv[bj][0], v1 = acc[ai][bj][m][1] + bv[bj][1];
                    if (ACT == 1) { f32x2 a = gelu_pk((f32x2){v0[0], v0[1]}), b = gelu_pk((f32x2){v0[2], v0[3]}), c = gelu_pk((f32x2){v1[0], v1[1]}), d = gelu_pk((f32x2){v1[2], v1[3]});
                        v0 = (f32x4){a.x, a.y, b.x, b.y}; v1 = (f32x4){c.x, c.y, d.x, d.y}; }
                    v0 = v0 * sc; v1 = v1 * sc; u32x4 w; w.x = cvt_pk_bf16(v0[0], v0[1]); w.y = cvt_pk_bf16(v0[2], v0[3]); w.z = cvt_pk_bf16(v1[0], v1[1]); w.w = cvt_pk_bf16(v1[2], v1[3]);
                    *(u32x4*)(rowp + bj * HALF) = w; } }
    }
};

struct EpiZ {
    static constexpr bool PERM = true, AFTER_DRAIN = false;
    bf16_t* O; int ldc; const PG8_LAS float* rs; float* sv; const float* qg; const float* kg; const float* rope; float qscale; int seqmask, seqshift; bf16_t* qh; bf16_t* kh; bf16_t* vh;
    __device__ __forceinline__ void operator()(const f32x4 (&acc)[2][2][4][2], const Unit& u, int wr, int wc, int fr, int fq) const {
        const int pn = u.pn, row0 = u.pm * BM + wr * 64 + fr;
        if (pn < 8) {
            const int col0 = pn * BM + wc * 32 + 8 * fq; const bool st = pn >= 4;
#pragma unroll
            for (int ai = 0; ai < 2; ++ai)
#pragma unroll
                for (int m = 0; m < 4; ++m) { const int row = row0 + ai * HALF + m * 16; bf16_t* rowp = O + (size_t)row * ldc + col0; const float rsv = rs[ai * HALF + wr * 64 + m * 16 + fr]; float s1 = 0.f, s2 = 0.f;
#pragma unroll
                    for (int bj = 0; bj < 2; ++bj) { f32x4 v0 = acc[ai][bj][m][0] * rsv, v1 = acc[ai][bj][m][1] * rsv;
                        { f32x2 a = gelu_pk((f32x2){v0[0], v0[1]}), b = gelu_pk((f32x2){v0[2], v0[3]}), c = gelu_pk((f32x2){v1[0], v1[1]}), d = gelu_pk((f32x2){v1[2], v1[3]});
                          v0 = (f32x4){a.x, a.y, b.x, b.y}; v1 = (f32x4){c.x, c.y, d.x, d.y}; }
                        s1 += ((v0[0] + v0[1]) + (v0[2] + v0[3])) + ((v1[0] + v1[1]) + (v1[2] + v1[3]));
                        s2 += ((v0[0] * v0[0] + v0[1] * v0[1]) + (v0[2] * v0[2] + v0[3] * v0[3])) + ((v1[0] * v1[0] + v1[1] * v1[1]) + (v1[2] * v1[2] + v1[3] * v1[3]));
                        u32x4 w; w.x = cvt_pk_bf16(v0[0], v0[1]); w.y = cvt_pk_bf16(v0[2], v0[3]); w.z = cvt_pk_bf16(v1[0], v1[1]); w.w = cvt_pk_bf16(v1[2], v1[3]);
                        *(u32x4*)(rowp + bj * HALF) = w; }
                    if (st) { s1 += __shfl_xor(s1, 16); s2 += __shfl_xor(s2, 16); s1 += __shfl_xor(s1, 32); s2 += __shfl_xor(s2, 32);
                        if (fq == 0) *(f32x2*)(sv + ((size_t)row * 16 + (pn - 4) * 4 + wc) * 2) = (f32x2){s1, s2}; } }
        } else if (pn < 16) {
            const int col0 = 2048 + (pn - 8) * HALF + wc * 32 + 8 * fq;
#pragma unroll
            for (int ai = 0; ai < 2; ++ai)
#pragma unroll
                for (int m = 0; m < 4; ++m) { bf16_t* rowp = O + (size_t)(row0 + ai * HALF + m * 16) * ldc + col0; const float rsv = rs[ai * HALF + wr * 64 + m * 16 + fr], nrs = -1.4426950408889634f * rsv;
                    float h[8];
#pragma unroll
                    for (int n = 0; n < 2; ++n)
#pragma unroll
                        for (int e = 0; e < 4; ++e) h[n * 4 + e] = acc[ai][0][m][n][e] * rsv * __builtin_amdgcn_rcpf(1.0f + __builtin_amdgcn_exp2f(acc[ai][1][m][n][e] * nrs));
                    u32x4 w; w.x = cvt_pk_bf16(h[0], h[1]); w.y = cvt_pk_bf16(h[2], h[3]); w.z = cvt_pk_bf16(h[4], h[5]); w.w = cvt_pk_bf16(h[6], h[7]);
                    *(u32x4*)rowp = w; }
        } else if (pn < 20) {
            const int col0 = pn * BM + wc * 32 + 8 * fq;
#pragma unroll
            for (int ai = 0; ai < 2; ++ai)
#pragma unroll
                for (int m = 0; m < 4; ++m) { bf16_t* rowp = O + (size_t)(row0 + ai * HALF + m * 16) * ldc + col0; const float rsv = rs[ai * HALF + wr * 64 + m * 16 + fr];
#pragma unroll
                    for (int bj = 0; bj < 2; ++bj) { const f32x4 v0 = acc[ai][bj][m][0] * rsv, v1 = acc[ai][bj][m][1] * rsv;
                        u32x4 w; w.x = cvt_pk_bf16(v0[0], v0[1]); w.y = cvt_pk_bf16(v0[2], v0[3]); w.z = cvt_pk_bf16(v1[0], v1[1]); w.w = cvt_pk_bf16(v1[2], v1[3]);
                        *(u32x4*)(rowp + bj * HALF) = w; } }
        } else if (pn >= 28) {
#pragma unroll
            for (int ai = 0; ai < 2; ++ai)
#pragma unroll
                for (int m = 0; m < 4; ++m) { const int row = row0 + ai * HALF + m * 16, b = row >> seqshift, t = row & seqmask; const float rsv = rs[ai * HALF + wr * 64 + m * 16 + fr];
#pragma unroll
                    for (int bj = 0; bj < 2; ++bj) { const f32x4 v0 = acc[ai][bj][m][0] * rsv, v1 = acc[ai][bj][m][1] * rsv;
                        u32x4 w; w.x = cvt_pk_bf16(v0[0], v0[1]); w.y = cvt_pk_bf16(v0[2], v0[3]); w.z = cvt_pk_bf16(v1[0], v1[1]); w.w = cvt_pk_bf16(v1[2], v1[3]);
                        *(u32x4*)(vh + ((size_t)((b * 8 + (pn - 28) * 2 + bj)) << seqshift | (size_t)t) * 128 + wc * 32 + 8 * fq) = w; } }
        } else {
            const bool isq = pn < 24; const int hc = (pn - (isq ? 20 : 24)) * 4 + wc; bf16_t* const dst = isq ? qh : kh;
            const float* gp = isq ? qg : kg; const float sc = isq ? qscale : 1.0f;
            f32x4 g[2][2];
#pragma unroll
            for (int n = 0; n < 2; ++n) { g[0][n] = *(const f32x4*)(gp + (fq < 2 ? 4 * fq + 8 * n : 8 * fq + 4 * n)) * sc; g[1][n] = *(const f32x4*)(gp + 32 + 8 * fq + 4 * n) * sc; }
#pragma unroll
            for (int ai = 0; ai < 2; ++ai)
#pragma unroll
                for (int m = 0; m < 4; ++m) { const int row = row0 + ai * HALF + m * 16; bf16_t* rowp = dst + (((size_t)((row >> seqshift) * 16 + hc)) << seqshift | (size_t)(row & seqmask)) * 64 + 8 * fq; const float rsv = rs[ai * HALF + wr * 64 + m * 16 + fr];
                    f32x4 v[2][2]; float s = 0.f;
#pragma unroll
                    for (int bj = 0; bj < 2; ++bj)
#pragma unroll
                        for (int n = 0; n < 2; ++n) { v[bj][n] = acc[ai][bj][m][n] * rsv; s += (v[bj][n][0] * v[bj][n][0] + v[bj][n][1] * v[bj][n][1]) + (v[bj][n][2] * v[bj][n][2] + v[bj][n][3] * v[bj][n][3]); }
                    s += __shfl_xor(s, 16); s += __shfl_xor(s, 32);
                    const float rn = 1.0f / sqrtf(s * (1.f / 64.f) + 1e-6f);
#pragma unroll
                    for (int bj = 0; bj < 2; ++bj)
#pragma unroll
                        for (int n = 0; n < 2; ++n) v[bj][n] = v[bj][n] * rn * g[bj][n];
                    if (fq < 2) {
                        const float* rp = rope + (size_t)(row & seqmask) * 16 + fq * 8; const f32x4 cs0 = *(const f32x4*)rp, cs1 = *(const f32x4*)(rp + 4);
                        const f32x4 x1 = v[0][0], x2 = v[0][1]; const f32x4 cc = (f32x4){cs0[0], cs0[2], cs1[0], cs1[2]}, sn = (f32x4){cs0[1], cs0[3], cs1[1], cs1[3]};
                        v[0][0] = x1 * cc - x2 * sn; v[0][1] = x2 * cc + x1 * sn; }
#pragma unroll
                    for (int bj = 0; bj < 2; ++bj) { u32x4 w; w.x = cvt_pk_bf16(v[bj][0][0], v[bj][0][1]); w.y = cvt_pk_bf16(v[bj][0][2], v[bj][0][3]); w.z = cvt_pk_bf16(v[bj][1][0], v[bj][1][1]); w.w = cvt_pk_bf16(v[bj][1][2], v[bj][1][3]);
                        *(u32x4*)(rowp + bj * 32) = w; } }
        }
    }
};
template <bool NOSTORE = false> struct EpiRelu2T {
    static constexpr bool PERM = true, AFTER_DRAIN = false;
    bf16_t* O; int ldc; const PG8_LAS float* rs;
    __device__ __forceinline__ void operator()(const f32x4 (&acc)[2][2][4][2], const Unit& u, int wr, int wc, int fr, int fq) const {
        const int row0 = u.pm * BM + wr * 64 + fr; const int col0 = u.pn * BM + wc * 32 + 8 * fq;
#pragma unroll
        for (int ai = 0; ai < 2; ++ai)
#pragma unroll
            for (int m = 0; m < 4; ++m) { bf16_t* rowp = O + (size_t)(row0 + ai * HALF + m * 16) * ldc + col0; const float rsv = rs[ai * HALF + wr * 64 + m * 16 + fr];
#pragma unroll
                for (int bj = 0; bj < 2; ++bj) { f32x4 v0 = acc[ai][bj][m][0] * rsv, v1 = acc[ai][bj][m][1] * rsv;
                    v0 = __builtin_elementwise_max(v0, (f32x4){0.f, 0.f, 0.f, 0.f}); v1 = __builtin_elementwise_max(v1, (f32x4){0.f, 0.f, 0.f, 0.f}); v0 = v0 * v0; v1 = v1 * v1;
                    u32x4 w; w.x = cvt_pk_bf16(v0[0], v0[1]); w.y = cvt_pk_bf16(v0[2], v0[3]); w.z = cvt_pk_bf16(v1[0], v1[1]); w.w = cvt_pk_bf16(v1[2], v1[3]);
                    if (!NOSTORE || w.x == 0x12345678u) *(u32x4*)(rowp + bj * HALF) = w; } }
    }
};
typedef EpiRelu2T<false> EpiRelu2;
template <bool BASE_BF16, bool OUT_F32> struct EpiRes {
    static constexpr bool PERM = true, AFTER_DRAIN = false;
    const void* base; float* out; int ldc; bf16_t* xb; float* ss;
    __device__ __forceinline__ void operator()(const f32x4 (&acc)[2][2][4][2], const Unit& u, int wr, int wc, int fr, int fq) const {
        const int row0 = u.pm * BM + wr * 64 + fr, col0 = u.pn * BM + wc * 32 + 8 * fq;
        if constexpr (BASE_BF16) {
            u32x4 bw[2][4][2];
#pragma unroll
            for (int ai = 0; ai < 2; ++ai)
#pragma unroll
                for (int m = 0; m < 4; ++m) { const size_t off = (size_t)(row0 + ai * HALF + m * 16) * ldc + col0;
#pragma unroll
                    for (int bj = 0; bj < 2; ++bj) bw[ai][m][bj] = __builtin_nontemporal_load((const u32x4*)((const bf16_t*)base + off + bj * HALF)); }
#pragma unroll
            for (int ai = 0; ai < 2; ++ai) {
                float sq[4];
#pragma unroll
                for (int m = 0; m < 4; ++m) { const size_t off = (size_t)(row0 + ai * HALF + m * 16) * ldc + col0; float s = 0.f;
#pragma unroll
                    for (int bj = 0; bj < 2; ++bj) { const u32x4 w0 = bw[ai][m][bj];
                        const f32x4 b0 = (f32x4){__builtin_bit_cast(float, w0.x << 16), __builtin_bit_cast(float, w0.x & 0xffff0000u), __builtin_bit_cast(float, w0.y << 16), __builtin_bit_cast(float, w0.y & 0xffff0000u)};
                        const f32x4 b1 = (f32x4){__builtin_bit_cast(float, w0.z << 16), __builtin_bit_cast(float, w0.z & 0xffff0000u), __builtin_bit_cast(float, w0.w << 16), __builtin_bit_cast(float, w0.w & 0xffff0000u)};
                        const f32x4 o0 = b0 + acc[ai][bj][m][0], o1 = b1 + acc[ai][bj][m][1];
                        if constexpr (OUT_F32) { *(f32x4*)(out + off + bj * HALF) = o0; *(f32x4*)(out + off + bj * HALF + 4) = o1; }
                        else { u32x4 w; w.x = cvt_pk_bf16(o0[0], o0[1]); w.y = cvt_pk_bf16(o0[2], o0[3]); w.z = cvt_pk_bf16(o1[0], o1[1]); w.w = cvt_pk_bf16(o1[2], o1[3]); *(u32x4*)(xb + off + bj * HALF) = w;
                            s += ((o0[0] * o0[0] + o0[1] * o0[1]) + (o0[2] * o0[2] + o0[3] * o0[3])) + ((o1[0] * o1[0] + o1[1] * o1[1]) + (o1[2] * o1[2] + o1[3] * o1[3])); } }
                    sq[m] = s; }
                if constexpr (!OUT_F32) {
#pragma unroll
                    for (int m = 0; m < 4; ++m) { float s = sq[m]; s += __shfl_xor(s, 16); s += __shfl_xor(s, 32); if (fq == 0) ss[(size_t)(row0 + ai * HALF + m * 16) * 64 + u.pn * 4 + wc] = s; } }
            }
        } else {
#pragma unroll
        for (int ai = 0; ai < 2; ++ai) {
            f32x4 bs[4][2][2];
#pragma unroll
            for (int m = 0; m < 4; ++m) { const size_t off = (size_t)(row0 + ai * HALF + m * 16) * ldc + col0;
#pragma unroll
                for (int bj = 0; bj < 2; ++bj) { bs[m][bj][0] = *(const f32x4*)((const float*)base + off + bj * HALF); bs[m][bj][1] = *(const f32x4*)((const float*)base + off + bj * HALF + 4); } }
            float sq[4];
#pragma unroll
            for (int m = 0; m < 4; ++m) { const size_t off = (size_t)(row0 + ai * HALF + m * 16) * ldc + col0; float s = 0.f;
#pragma unroll
                for (int bj = 0; bj < 2; ++bj) { const f32x4 o0 = bs[m][bj][0] + acc[ai][bj][m][0], o1 = bs[m][bj][1] + acc[ai][bj][m][1];
                    if constexpr (OUT_F32) { *(f32x4*)(out + off + bj * HALF) = o0; *(f32x4*)(out + off + bj * HALF + 4) = o1; }
                    else { u32x4 w; w.x = cvt_pk_bf16(o0[0], o0[1]); w.y = cvt_pk_bf16(o0[2], o0[3]); w.z = cvt_pk_bf16(o1[0], o1[1]); w.w = cvt_pk_bf16(o1[2], o1[3]); *(u32x4*)(xb + off + bj * HALF) = w;
                        s += ((o0[0] * o0[0] + o0[1] * o0[1]) + (o0[2] * o0[2] + o0[3] * o0[3])) + ((o1[0] * o1[0] + o1[1] * o1[1]) + (o1[2] * o1[2] + o1[3] * o1[3])); } }
                sq[m] = s; }
            if constexpr (!OUT_F32) {
#pragma unroll
                for (int m = 0; m < 4; ++m) { float s = sq[m]; s += __shfl_xor(s, 16); s += __shfl_xor(s, 32); if (fq == 0) ss[(size_t)(row0 + ai * HALF + m * 16) * 64 + u.pn * 4 + wc] = s; } }
            asm volatile("" ::: "memory");
        }
        }
    }
};
template <class Epi, class Sched, bool ALIGN_EPI = false, bool SP2 = false>
__device__ __forceinline__ void gemm_phase(PG8_LAS unsigned char* lds, const Gemm g, const Sched& S, const Epi& E) {
    int tid_ = threadIdx.x; asm volatile("" : "+v"(tid_));
    const int tid = tid_, wid = __builtin_amdgcn_readfirstlane(tid >> 6), lane = tid & 63, wr = wid >> 2, wc = wid & 3, fr = lane & 15, fq = lane >> 4;
    const int K = g.K, nt = K / BK;
    unsigned voffA[2], voffB[2];
#pragma unroll
    for (int i = 0; i < 2; ++i) { int R, C; stage_rc(tid * 16 + i * 8192, R, C); const int Rb = Epi::PERM ? ((R & ~31) + perm32(R & 31)) : R;
        voffA[i] = (unsigned)(R * K + C) * 2u; voffB[i] = (unsigned)(Rb * K + C) * 2u; }
    const size_t kstep = (size_t)(BK * 2);
    const size_t hstep = (size_t)HALF * K * 2;
    const size_t tstep = 2 * hstep;
    const unsigned ldsw = (unsigned)wid * 1024u;
    const int aoff = lds_byte(wr * 64 + fr, fq * 8), boff = lds_byte(wc * 32 + fr, fq * 8);
#define PG8_SA(b, h) (((b) * 2 + (h)) * HTB)
#define PG8_SB(b, h) ((4 + (b) * 2 + (h)) * HTB)
#define PG8_STAGE(bufoff, gbase, voff) do { _Pragma("unroll") for (int _i = 0; _i < 2; ++_i) \
        __builtin_amdgcn_global_load_lds((const unsigned*)((const char*)(gbase) + (voff)[_i]), (PG8_LAS unsigned*)(lds + (bufoff) + ldsw + _i * 8192), 16, 0, 0); } while (0)
#define PG8_LDA(dst, b, h) do { _Pragma("unroll") for (int m = 0; m < 4; ++m) _Pragma("unroll") for (int k = 0; k < 2; ++k) dst[m][k] = *(const PG8_LAS bf16x8*)(lds + PG8_SA(b, h) + aoff + m * 2048 + k * 1024); } while (0)
#define PG8_LDB(dst, b, h) do { _Pragma("unroll") for (int n = 0; n < 2; ++n) _Pragma("unroll") for (int k = 0; k < 2; ++k) dst[n][k] = *(const PG8_LAS bf16x8*)(lds + PG8_SB(b, h) + boff + n * 2048 + k * 1024); } while (0)
#define PG8_MMA(ai, bj, At, Bt) do { __builtin_amdgcn_s_setprio(PG8_PRIO_MMA); _Pragma("unroll") for (int m = 0; m < 4; ++m) _Pragma("unroll") for (int n = 0; n < 2; ++n) _Pragma("unroll") for (int k = 0; k < 2; ++k) \
        acc[ai][bj][m][n] = __builtin_amdgcn_mfma_f32_16x16x32_bf16(Bt[n][k], At[m][k], acc[ai][bj][m][n], 0, 0, 0); __builtin_amdgcn_s_setprio(PG8_PRIO_LOAD); } while (0)
#ifndef PG8_PRIO_MMA
#define PG8_PRIO_MMA 1
#define PG8_PRIO_LOAD 0
#endif
#define PG8_WAIT_V(n) asm volatile("s_waitcnt vmcnt(" #n ")" ::: "memory")
#define PG8_WAIT_L(n) asm volatile("s_waitcnt lgkmcnt(" #n ")" ::: "memory")
#define PG8_BAR __builtin_amdgcn_s_barrier()
#define PG8_SCHED __builtin_amdgcn_sched_barrier(0)
    Unit cur, nxt; int ui = 0;
    if (!S.next(0, cur)) return;
    f32x4 acc[2][2][4][2];
#pragma unroll
    for (int a = 0; a < 2; ++a)
#pragma unroll
        for (int b = 0; b < 2; ++b)
#pragma unroll
            for (int m = 0; m < 4; ++m)
#pragma unroll
                for (int n = 0; n < 2; ++n) acc[a][b][m][n] = (f32x4){0.f, 0.f, 0.f, 0.f};
    bf16x8 At[4][2], B0[2][2], B1[2][2];
    const char* cA = (const char*)g.A + (size_t)cur.pm * tstep; const char* cB = (const char*)g.Bt + (size_t)cur.pn * tstep;
    S.a_ready(cur);
    if constexpr (SP2) {
        PG8_STAGE(PG8_SB(0, 0), cB, voffB); PG8_STAGE(PG8_SB(0, 1), cB + hstep, voffB); PG8_STAGE(PG8_SA(0, 0), cA, voffA); PG8_STAGE(PG8_SA(0, 1), cA + hstep, voffA);
        if (wr == 1) PG8_BAR;
        PG8_WAIT_V(2); PG8_BAR;
        PG8_STAGE(PG8_SB(1, 0), cB + kstep, voffB); PG8_STAGE(PG8_SA(1, 0), cA + kstep, voffA); PG8_STAGE(PG8_SB(1, 1), cB + hstep + kstep, voffB);
        PG8_WAIT_V(6); PG8_BAR;
    } else {
        PG8_STAGE(PG8_SB(0, 0), cB, voffB); PG8_STAGE(PG8_SA(0, 0), cA, voffA); PG8_STAGE(PG8_SB(0, 1), cB + hstep, voffB); PG8_STAGE(PG8_SA(0, 1), cA + hstep, voffA);
        if (wr == 1) PG8_BAR;
        PG8_WAIT_V(4); PG8_BAR;
        PG8_STAGE(PG8_SB(1, 0), cB + kstep, voffB); PG8_STAGE(PG8_SA(1, 0), cA + kstep, voffA); PG8_STAGE(PG8_SB(1, 1), cB + hstep + kstep, voffB);
        PG8_WAIT_V(6); PG8_BAR;
    }
    for (;;) {
        const bool has_next = S.next(ui + 1, nxt);
        const char* nA = has_next ? (const char*)g.A + (size_t)nxt.pm * tstep : cA; const char* nB = has_next ? (const char*)g.Bt + (size_t)nxt.pn * tstep : cB;
        for (int t = 0; t < nt; t += 2) {
            const bool last = (t == nt - 2);
            const char* a1 = cA + (size_t)(t + 1) * kstep;
            const char* a2 = last ? nA : cA + (size_t)(t + 2) * kstep; const char* b2 = last ? nB : cB + (size_t)(t + 2) * kstep;
            const char* a3 = a2 + kstep; const char* b3 = b2 + kstep;
            if (last && has_next) S.a_ready(nxt);
            if constexpr (SP2) {
            PG8_LDB(B0, 0, 0); PG8_LDB(B1, 0, 1); PG8_SCHED; PG8_LDA(At, 0, 0); PG8_STAGE(PG8_SA(1, 1), a1 + hstep, voffA);
            PG8_WAIT_V(8); PG8_WAIT_L(0); PG8_BAR; PG8_MMA(0, 0, At, B0); PG8_MMA(0, 1, At, B1); PG8_BAR; PG8_SCHED;
            PG8_LDA(At, 0, 1); PG8_STAGE(PG8_SB(0, 0), b2, voffB); PG8_STAGE(PG8_SB(0, 1), b2 + hstep, voffB); PG8_STAGE(PG8_SA(0, 0), a2, voffA);
            PG8_WAIT_V(8); PG8_WAIT_L(0); PG8_BAR; PG8_MMA(1, 0, At, B0); PG8_MMA(1, 1, At, B1); PG8_BAR; PG8_SCHED;
            PG8_LDB(B0, 1, 0); PG8_LDB(B1, 1, 1); PG8_SCHED; PG8_LDA(At, 1, 0); PG8_STAGE(PG8_SA(0, 1), a2 + hstep, voffA);
            PG8_WAIT_V(8); PG8_WAIT_L(0); PG8_BAR; PG8_MMA(0, 0, At, B0); PG8_MMA(0, 1, At, B1); PG8_BAR; PG8_SCHED;
            PG8_LDA(At, 1, 1); PG8_STAGE(PG8_SB(1, 0), b3, voffB); PG8_STAGE(PG8_SB(1, 1), b3 + hstep, voffB); PG8_STAGE(PG8_SA(1, 0), a3, voffA);
            PG8_WAIT_V(8); PG8_WAIT_L(0); PG8_BAR; PG8_MMA(1, 0, At, B0); PG8_MMA(1, 1, At, B1); PG8_BAR; PG8_SCHED;
            } else {
            PG8_LDB(B0, 0, 0); PG8_SCHED; PG8_LDA(At, 0, 0); PG8_STAGE(PG8_SA(1, 1), a1 + hstep, voffA);
            PG8_WAIT_L(8); PG8_BAR; PG8_WAIT_L(0); PG8_MMA(0, 0, At, B0); PG8_BAR; PG8_SCHED;
            PG8_LDB(B1, 0, 1); PG8_STAGE(PG8_SB(0, 0), b2, voffB);
            PG8_BAR; PG8_WAIT_L(0); PG8_MMA(0, 1, At, B1); PG8_BAR;
            PG8_LDA(At, 0, 1); PG8_STAGE(PG8_SA(0, 0), a2, voffA);
            PG8_BAR; PG8_WAIT_L(0); PG8_MMA(1, 0, At, B0); PG8_BAR; PG8_SCHED;
            PG8_STAGE(PG8_SB(0, 1), b2 + hstep, voffB);
            PG8_WAIT_V(6); PG8_BAR; PG8_MMA(1, 1, At, B1); PG8_BAR;
            PG8_LDB(B0, 1, 0); PG8_SCHED; PG8_LDA(At, 1, 0); PG8_STAGE(PG8_SA(0, 1), a2 + hstep, voffA);
            PG8_WAIT_L(8); PG8_BAR; PG8_WAIT_L(0); PG8_MMA(0, 0, At, B0); PG8_BAR; PG8_SCHED;
            PG8_LDB(B1, 1, 1); PG8_STAGE(PG8_SB(1, 0), b3, voffB);
            PG8_BAR; PG8_WAIT_L(0); PG8_MMA(0, 1, At, B1); PG8_BAR;
            PG8_LDA(At, 1, 1); PG8_STAGE(PG8_SA(1, 0), a3, voffA);
            PG8_BAR; PG8_WAIT_L(0); PG8_MMA(1, 0, At, B0); PG8_BAR; PG8_SCHED;
            PG8_STAGE(PG8_SB(1, 1), b3 + hstep, voffB);
            PG8_WAIT_V(6); PG8_BAR; PG8_MMA(1, 1, At, B1); PG8_BAR;
            }
        }
        if constexpr (ALIGN_EPI) { if (wr == 0) PG8_BAR; }
        if constexpr (!Epi::AFTER_DRAIN) { E(acc, cur, wr, wc, fr, fq); S.done(cur); }
        if (!has_next) break;
#pragma unroll
        for (int a = 0; a < 2; ++a)
#pragma unroll
            for (int b = 0; b < 2; ++b)
#pragma unroll
                for (int m = 0; m < 4; ++m)
#pragma unroll
                    for (int n = 0; n < 2; ++n) acc[a][b][m][n] = (f32x4){0.f, 0.f, 0.f, 0.f};
        cur = nxt; cA = nA; cB = nB; ++ui;
        if constexpr (ALIGN_EPI) { if (wr == 1) PG8_BAR; }
    }
    PG8_WAIT_V(0);
    if constexpr (!ALIGN_EPI) { if (wr == 0) PG8_BAR; }
    PG8_BAR;
    if constexpr (Epi::AFTER_DRAIN) { E.fused(acc, cur, wr, wc, fr, fq, lds, wid, lane); S.done(cur); }
#undef PG8_SA
#undef PG8_SB
#undef PG8_STAGE
#undef PG8_LDA
#undef PG8_LDB
#undef PG8_MMA
#undef PG8_WAIT_V
#undef PG8_WAIT_L
#undef PG8_BAR
#undef PG8_SCHED
}
}

constexpr int NWAVES = 8;
constexpr int BATCH = 2, SEQ = 8192, DM = 4096, NLAYER = 2, GW = 1024, DIN = 8192, DFF = 16384;
constexpr int M = BATCH * SEQ;
constexpr int ZC_A = 0, ZC_B = 2048, ZC_C = 4096, ZC_Q = 5120, ZC_K = 6144, ZC_V = 7168;
constexpr int YC_A = 0, YC_B = 1024, YC_C = 2048, YC_D = 3072;
constexpr float QSCALE = 0.125f * 1.4426950408889634f;
#ifndef MK_SPLIT
#define MK_SPLIT 0
#endif

constexpr size_t MiB = 1u << 20;
constexpr size_t WS_CTL = 0, CTL_ZERO_BYTES = 64 * 1024;
constexpr size_t WS_ROPE = 1 * MiB;
constexpr size_t WS_PWT = 2 * MiB;
constexpr size_t WS_GWS = 3 * MiB;
constexpr size_t WS_SS = 4 * MiB;
constexpr size_t WS_SV = 8 * MiB;
constexpr size_t WS_WIN = 16 * MiB;
constexpr size_t WS_WOUT = 144 * MiB;
constexpr size_t WS_WUP = 208 * MiB;
constexpr size_t WS_WDN = 464 * MiB;
constexpr size_t WS_XN = 720 * MiB;
constexpr size_t WS_Z = 848 * MiB;
constexpr size_t WS_YC = 1104 * MiB;
constexpr size_t WS_HB = 1232 * MiB;
constexpr size_t WS_OS = 1744 * MiB;
constexpr size_t WS_QH = 1808 * MiB;
constexpr size_t WS_KH = 1840 * MiB;
constexpr size_t WS_VH = 1872 * MiB;
constexpr size_t WS_END = 1904 * MiB;
constexpr int CW_BAR = 1024;

constexpr int RING_OFF = 0, RING_BYTES = 131072;
constexpr int LDSCTL_OFF = RING_BYTES, MISC_OFF = LDSCTL_OFF + 320;
constexpr int RSTAB_OFF = RING_BYTES + 1024;
constexpr int LDS_BYTES = 147456;

#define GAS __attribute__((address_space(1)))
#define LAS __attribute__((address_space(3)))
typedef unsigned short bf16;
typedef unsigned v4u __attribute__((ext_vector_type(4)));
typedef float f32x4 __attribute__((ext_vector_type(4)));
typedef short bf16x8 __attribute__((ext_vector_type(8)));
typedef GAS unsigned gu32;
typedef GAS unsigned long long gu64;
#define RLX_AGENT __ATOMIC_RELAXED, __HIP_MEMORY_SCOPE_AGENT
#define LDS_WAIT() asm volatile("s_waitcnt lgkmcnt(0)" ::: "memory")
#define VM_WAIT() asm volatile("s_waitcnt vmcnt(0)" ::: "memory")
__device__ __forceinline__ unsigned long long rt() { return __builtin_amdgcn_s_memrealtime(); }
__device__ __forceinline__ unsigned f2bf(float f) { unsigned u = __builtin_bit_cast(unsigned, f); return (u + 0x7fffu + ((u >> 16) & 1u)) >> 16; }
__device__ __forceinline__ unsigned pk2(float lo, float hi) { return f2bf(lo) | (f2bf(hi) << 16); }

#define XB_TMO      128
#define XB_XCNT(j)  (256  + 64 * (j))
#define XB_XSUB(j)  (1280 + 64 * (j))
#define XB_XGEN(j)  (2304 + 64 * (j))
#define XB_TOP      3328
#define XB_TOPGEN   3392
#define XCD_BAR_WORDS 3456
#define XB_SPIN_CAP (1u << 18)

__device__ __forceinline__ unsigned xb_ld(unsigned* p)              { return __hip_atomic_load(p, __ATOMIC_RELAXED, __HIP_MEMORY_SCOPE_AGENT); }
__device__ __forceinline__ unsigned xb_add(unsigned* p, unsigned v) { return __hip_atomic_fetch_add(p, v, __ATOMIC_RELAXED, __HIP_MEMORY_SCOPE_AGENT); }
__device__ __forceinline__ unsigned xb_xcc_id() { return (unsigned)__builtin_amdgcn_s_getreg((3 << 11) | 20) & 0xFu; }
#define XB_SPIN(cond, bar) do { unsigned _sp = 0; while (cond) { __builtin_amdgcn_s_sleep(1); \
    if ((++_sp & 255u) == 0u) { if (xb_ld(&(bar)[XB_TMO])) break; if (_sp > XB_SPIN_CAP) { atomicAdd(&(bar)[XB_TMO], 1u); break; } } } } while (0)

struct XcdBarrier {
    unsigned* bar; unsigned x;
    volatile LAS unsigned* st;
};

__device__ __forceinline__ XcdBarrier xcd_barrier_post(unsigned* bar, volatile LAS unsigned* st) {
    XcdBarrier b; b.bar = bar; b.x = xb_xcc_id(); b.st = st;
    if (threadIdx.x == 0) (void)xb_add(&bar[XB_XCNT(b.x)], 1u);
    return b;
}
__device__ __forceinline__ void xcd_barrier_complete(unsigned* bar, unsigned x, unsigned& nloc, unsigned& nx) {
    const unsigned G = gridDim.x * gridDim.y * gridDim.z;
    unsigned sum, cnt, mine, sp = 0u;
    for (;;) {
        sum = 0u; cnt = 0u; mine = 0u;
#pragma unroll
        for (unsigned j = 0; j < 16; ++j) { const unsigned c = xb_ld(&bar[XB_XCNT(j)]); sum += c; cnt += (c > 0u) ? 1u : 0u; mine = (j == x) ? c : mine; }
        if (sum == G) break;
        __builtin_amdgcn_s_sleep(1);
        if ((++sp & 255u) == 0u) { if (xb_ld(&bar[XB_TMO])) break; if (sp > XB_SPIN_CAP) { atomicAdd(&bar[XB_TMO], 1u); break; } }
    }
    nloc = mine > 0u ? mine : 1u; nx = cnt > 0u ? cnt : 1u;
}

__device__ __forceinline__ void xcd_barrier_leader(const XcdBarrier& b) {
        unsigned* bar = b.bar;
        __builtin_amdgcn_s_waitcnt(0);
        unsigned nloc = b.st[0], nx = b.st[1];
        if (nloc == 0u) { xcd_barrier_complete(bar, b.x, nloc, nx); b.st[0] = nloc; b.st[1] = nx; }
        const unsigned old = xb_add(&bar[XB_XSUB(b.x)], 1u);
        const unsigned gen = old / nloc;
        if (old + 1u == (gen + 1u) * nloc) {
            __builtin_amdgcn_fence(__ATOMIC_RELEASE, "agent");
            asm volatile("s_waitcnt vmcnt(0)" ::: "memory");
            const unsigned og = xb_add(&bar[XB_TOP], 1u);
            const unsigned tg = og / nx;
            if (og + 1u == (tg + 1u) * nx) xb_add(&bar[XB_TOPGEN], 1u);
            else XB_SPIN(xb_ld(&bar[XB_TOPGEN]) == tg, bar);
            __builtin_amdgcn_fence(__ATOMIC_ACQUIRE, "agent");
            xb_add(&bar[XB_XGEN(b.x)], 1u);
            asm volatile("s_waitcnt vmcnt(0)" ::: "memory");
        } else {
            XB_SPIN(xb_ld(&bar[XB_XGEN(b.x)]) == gen, bar);
            __builtin_amdgcn_fence(__ATOMIC_ACQUIRE, "agent");
            asm volatile("s_waitcnt vmcnt(0)" ::: "memory");
        }
}
__device__ __forceinline__ void xcd_barrier(const XcdBarrier& b) {
    asm volatile("s_waitcnt vmcnt(0)" ::: "memory");
    __syncthreads();
    if (threadIdx.x == 0) xcd_barrier_leader(b);
    __syncthreads();
}

typedef unsigned u32x2 __attribute__((ext_vector_type(2)));
typedef float f32x2v __attribute__((ext_vector_type(2)));
struct Frame {
    LAS unsigned char* lds;
    volatile LAS unsigned* MISC;
    gu32* ctl;
    int tid, lane, wave;
    int vcu, G;
};
struct Args { const float* in[24]; float* out; unsigned char* ws; int ph_lo, ph_hi; };

__device__ __forceinline__ float wave_sum(float v) {
#pragma unroll
    for (int o = 1; o < 64; o <<= 1) v += __shfl_xor(v, o);
    return v;
}
__device__ __forceinline__ float bf_lo(unsigned w) { return __builtin_bit_cast(float, w << 16); }
__device__ __forceinline__ float bf_hi(unsigned w) { return __builtin_bit_cast(float, w & 0xffff0000u); }
__device__ __forceinline__ float sigmoidf_fast(float x) { return __builtin_amdgcn_rcpf(1.0f + __builtin_amdgcn_exp2f(-1.4426950408889634f * x)); }

__device__ __forceinline__ int zin_dest(int n) {
    if (n < 2048 || (n >= 4096 && n < 5120) || n >= 7168) return n;
    if (n < 4096) { const int j = n - 2048, half = j >> 10, c = j & 1023; return 2048 + 256 * (c >> 7) + 128 * half + (c & 127); }
    const int base = (n < 6144) ? 5120 : 6144, j = n - base, hc = j >> 6, d = j & 63;
    const int pos = (d < 16) ? ((d & 3) | ((d & 4) << 1) | ((d & 8) >> 1)) : d;
    return base + 256 * (hc >> 2) + 32 * (hc & 3) + (d < 32 ? pos : 128 + (d - 32));
}
template <bool PERMZ>
__device__ __forceinline__ void p0_transpose_item(const float* W, int K, int N, bf16* WT, LAS float* scr, int item, int lane, const float* gain = nullptr) {
    const int nblk = N / 32, kb = item / nblk, nb = item % nblk, k0 = 64 * kb, n0 = 32 * nb;
    const GAS float* Wg = (const GAS float*)W;
    const int c = lane & 7;
    f32x4 g0 = (f32x4){1.f, 1.f, 1.f, 1.f}, g1 = g0;
    if (gain) { g0 = *(const GAS f32x4*)(gain + k0 + 8 * c); g1 = *(const GAS f32x4*)(gain + k0 + 8 * c + 4); }
    float tv[32];
#pragma unroll
    for (int i = 0; i < 32; ++i) { const int kk = 2 * i + (lane >> 5); tv[i] = __builtin_nontemporal_load(Wg + (size_t)(k0 + kk) * N + n0 + (lane & 31)); }
#pragma unroll
    for (int i = 0; i < 32; ++i) { const int kk = 2 * i + (lane >> 5); scr[kk * 33 + (lane & 31)] = tv[i]; }
    LDS_WAIT(); asm volatile("" ::: "memory");
#pragma unroll
    for (int j = 0; j < 4; ++j) { const int n = (lane >> 3) + 8 * j; const LAS float* s = scr + (8 * c) * 33 + n;
        v4u o; o.x = pk2(s[0 * 33] * g0.x, s[1 * 33] * g0.y); o.y = pk2(s[2 * 33] * g0.z, s[3 * 33] * g0.w); o.z = pk2(s[4 * 33] * g1.x, s[5 * 33] * g1.y); o.w = pk2(s[6 * 33] * g1.z, s[7 * 33] * g1.w);
        const int dn = PERMZ ? zin_dest(n0 + n) : n0 + n;
        *(GAS v4u*)(WT + (size_t)dn * K + k0 + 8 * c) = o; }
    LDS_WAIT(); asm volatile("" ::: "memory");
}
template <bool PERMZ>
__device__ __forceinline__ void p0_transpose_pair(const float* W, int K, int N, bf16* WT, LAS float* scr, int item, int lane, const float* gain = nullptr) {
    const int nblk = N / 32, kb = item / nblk, nb = item % nblk, k0 = 64 * kb, n0 = 32 * nb;
    const GAS float* Wg = (const GAS float*)W;
    const int c = lane & 7;
    f32x4 g0 = (f32x4){1.f, 1.f, 1.f, 1.f}, g1 = g0;
    if (gain) { g0 = *(const GAS f32x4*)(gain + k0 + 8 * c); g1 = *(const GAS f32x4*)(gain + k0 + 8 * c + 4); }
    float tv[2][32];
#pragma unroll
    for (int h = 0; h < 2; ++h)
#pragma unroll
        for (int i = 0; i < 32; ++i) { const int kk = 2 * i + (lane >> 5); tv[h][i] = __builtin_nontemporal_load(Wg + (size_t)(k0 + kk) * N + n0 + 32 * h + (lane & 31)); }
#pragma unroll
    for (int h = 0; h < 2; ++h) {
#pragma unroll
        for (int i = 0; i < 32; ++i) { const int kk = 2 * i + (lane >> 5); scr[kk * 33 + (lane & 31)] = tv[h][i]; }
        LDS_WAIT(); asm volatile("" ::: "memory");
#pragma unroll
        for (int j = 0; j < 4; ++j) { const int n = (lane >> 3) + 8 * j; const LAS float* s = scr + (8 * c) * 33 + n;
            v4u o; o.x = pk2(s[0 * 33] * g0.x, s[1 * 33] * g0.y); o.y = pk2(s[2 * 33] * g0.z, s[3 * 33] * g0.w); o.z = pk2(s[4 * 33] * g1.x, s[5 * 33] * g1.y); o.w = pk2(s[6 * 33] * g1.z, s[7 * 33] * g1.w);
            const int dn = PERMZ ? zin_dest(n0 + 32 * h + n) : n0 + 32 * h + n;
            __builtin_nontemporal_store(o, (GAS v4u*)(WT + (size_t)dn * K + k0 + 8 * c)); }
        LDS_WAIT(); asm volatile("" ::: "memory");
    }
}
constexpr int CV_IN = (DM / 64) * (DIN / 32), CV_OUT = (DM / 64) * (DM / 32), CV_UP = (DM / 64) * (DFF / 32), CV_DN = (DFF / 64) * (DM / 32), CV_L = CV_IN + CV_OUT + CV_UP + CV_DN;
constexpr int CV_TOTAL = NLAYER * CV_L - CV_IN, CV_CHUNK = 16, CV_NCHUNK = CV_TOTAL / CV_CHUNK;
constexpr unsigned CV_EXH = 0xFFFFFFFFu;
constexpr int CW_Q = 8192;
constexpr int QST_OFF = LDSCTL_OFF + 4096;
static_assert(CV_TOTAL % (CV_CHUNK * 256) == 0 && CV_IN % (CV_CHUNK * 256) == 0 && CV_OUT % (CV_CHUNK * 256) == 0 && CV_UP % (CV_CHUNK * 256) == 0, "chunking");
__device__ __forceinline__ constexpr int cv_deadline(int l, int which) { return l * CV_L + (which == 0 ? CV_IN : which == 1 ? CV_IN + CV_OUT : which == 2 ? CV_IN + CV_OUT + CV_UP : CV_L) - CV_IN; }
__device__ __forceinline__ void cv_item(const Args& a, LAS float* scr, int I, int lane) {
    unsigned char* ws = a.ws;
    const int J = I + CV_IN, l = (J >= CV_L) ? 1 : 0; int r = J - l * CV_L;
    if (r < CV_IN) { p0_transpose_pair<true>(a.in[2] + (size_t)l * DM * DIN, DM, DIN, (bf16*)(ws + WS_WIN) + (size_t)l * DIN * DM, scr, r, lane, a.in[1] + (size_t)l * DM); return; } r -= CV_IN;
    if (r < CV_OUT) { p0_transpose_pair<false>(a.in[20] + (size_t)l * DM * DM, DM, DM, (bf16*)(ws + WS_WOUT) + (size_t)l * DM * DM, scr, r, lane); return; } r -= CV_OUT;
    if (r < CV_UP) { p0_transpose_pair<false>(a.in[22] + (size_t)l * DM * DFF, DM, DFF, (bf16*)(ws + WS_WUP) + (size_t)l * DFF * DM, scr, r, lane, a.in[21] + (size_t)l * DM); return; } r -= CV_UP;
    p0_transpose_pair<false>(a.in[23] + (size_t)l * DFF * DM, DFF, DM, (bf16*)(ws + WS_WDN) + (size_t)l * DM * DFF, scr, r, lane);
}
#ifndef NO_WAIT_STEAL
#define NO_WAIT_STEAL 0
#endif
__device__ __forceinline__ void seam_steal(const Frame& F, const Args& a, const XcdBarrier& b, int DI) {
    volatile LAS unsigned* QS = (volatile LAS unsigned*)(F.lds + QST_OFF);
    LAS float* scr = (LAS float*)(F.lds + RING_OFF + F.wave * 16384);
    const unsigned cu = blockIdx.x, DJ = (unsigned)DI / 256u, TJ = (unsigned)CV_TOTAL / 256u;
    __syncthreads();
    const unsigned e0 = (unsigned)__builtin_amdgcn_readfirstlane((int)QS[0]);
    unsigned cur = (unsigned)__builtin_amdgcn_readfirstlane((int)QS[8 + 2 * F.wave]), end = (unsigned)__builtin_amdgcn_readfirstlane((int)QS[9 + 2 * F.wave]);
    int mode = 0;
#ifdef DIAG_STEAL
    unsigned stolen = 0u;
#endif
    for (;;) {
        if (mode == 1 && (unsigned)__builtin_amdgcn_readfirstlane((int)QS[0]) != e0) break;
        if (cur == end) {
            bool arrive = false;
            if (end == CV_EXH) { if (mode == 0) arrive = true; else { __builtin_amdgcn_s_sleep(8); continue; } }
            else {
                if (mode == 0 && (unsigned)__builtin_amdgcn_readfirstlane((int)QS[1]) >= DJ) arrive = true;
                else {
                    unsigned j0 = 0u; if (F.lane == 0) j0 = __hip_atomic_fetch_add((LAS unsigned*)(F.lds + QST_OFF + 4), 2u, __ATOMIC_RELAXED, __HIP_MEMORY_SCOPE_WORKGROUP);
                    j0 = (unsigned)__builtin_amdgcn_readfirstlane((int)j0);
                    if (j0 >= TJ) { cur = end = CV_EXH; continue; }
                    cur = j0; end = j0 + 2u;
                }
            }
            if (arrive) {
                asm volatile("s_waitcnt vmcnt(0)" ::: "memory");
                __syncthreads();
                if (F.wave == 0 || NO_WAIT_STEAL) { if (threadIdx.x == 0) { xcd_barrier_leader(b); QS[0] = e0 + 1u; } break; }
                mode = 1; continue;
            }
        }
        cv_item(a, scr, (int)(16u * (256u * (cur >> 4) + cu) + (cur & 15u)), F.lane); cur += 2u;
#ifdef DIAG_STEAL
        stolen += 2u * (unsigned)mode;
#endif
    }
    if (F.lane == 0) { QS[8 + 2 * F.wave] = cur; QS[9 + 2 * F.wave] = end; }
#ifdef DIAG_STEAL
    if (F.lane == 0 && stolen) __hip_atomic_fetch_add((unsigned*)(F.ctl + CW_Q + 1024), stolen, RLX_AGENT);
#endif
    __syncthreads();
}
__device__ __forceinline__ void p0_prologue(const Frame& F, const Args& a) {
    LAS float* scr = (LAS float*)(F.lds + RING_OFF + F.wave * 16384);
    unsigned char* ws = a.ws;
    const int gw = F.vcu * NWAVES + F.wave, NGW = F.G * NWAVES;
    constexpr int I_PW1 = (256 / 64) * (256 / 32), I_PW = 4 * I_PW1;
    for (int it = gw; it < CV_IN + NLAYER * I_PW; it += NGW) {
        if (it < CV_IN) { p0_transpose_item<true>(a.in[2], DM, DIN, (bf16*)(ws + WS_WIN), scr, it, F.lane, a.in[1]); continue; }
        const int r = it - CV_IN, lg = r / I_PW1, ri = r % I_PW1;
        p0_transpose_item<false>(a.in[11] + (size_t)lg * 65536, 256, 256, (bf16*)(ws + WS_PWT) + (size_t)lg * 65536, scr, ri, F.lane);
    }
    const int gt = F.vcu * (NWAVES * 64) + F.tid, NGT = F.G * NWAVES * 64;
    { const GAS float* src = (const GAS float*)a.in[5]; GAS unsigned* dst = (GAS unsigned*)(ws + WS_GWS);
      for (int i = gt; i < NLAYER * 8 * 128 * 128 / 2; i += NGT) dst[i] = pk2(src[2 * i], src[2 * i + 1]); }
    { GAS float* rope = (GAS float*)(ws + WS_ROPE);
      for (int e = gt; e < SEQ * 8; e += NGT) {
          const int pos = e >> 3, i = e & 7;
          const float invf = (i == 0) ? 1.0f : (i == 1) ? 0x1.8d275ep-3f : (i == 2) ? 0x1.341190p-5f : (i == 3) ? 0x1.ddee9cp-8f : (i == 4) ? 0x1.72ba44p-10f : (i == 5) ? 0x1.1f91f0p-12f : (i == 6) ? 0x1.be218ap-15f : 0x1.5a0f50p-17f;
          const float angf = (float)pos * invf;
          const double ad = (double)angf;
          const double kq = __builtin_rint(ad * 0.63661977236758134308);
          const double y = __builtin_fma(-kq, 1.57079632679489661923, ad);
          const double y2 = y * y;
          const double sn = y * (1.0 + y2 * (-1.0 / 6 + y2 * (1.0 / 120 + y2 * (-1.0 / 5040 + y2 * (1.0 / 362880 + y2 * (-1.0 / 39916800))))));
          const double cs = 1.0 + y2 * (-0.5 + y2 * (1.0 / 24 + y2 * (-1.0 / 720 + y2 * (1.0 / 40320 + y2 * (-1.0 / 3628800 + y2 * (1.0 / 479001600))))));
          const int q = ((int)kq) & 3;
          const double c = (q == 0) ? cs : (q == 1) ? -sn : (q == 2) ? -cs : sn;
          const double s = (q == 0) ? sn : (q == 1) ? cs : (q == 2) ? -sn : -cs;
          rope[2 * e] = (float)c; rope[2 * e + 1] = (float)s;
      } }
}

__device__ __forceinline__ void xprep_phase(const Frame& F, const float* x, bf16* XB, float* SS) {
    const int gw = F.vcu * NWAVES + F.wave, NGW = F.G * NWAVES;
    for (int m = gw; m < M; m += NGW) {
        const GAS f32x4* xr = (const GAS f32x4*)(x + (size_t)m * DM) + F.lane;
        f32x4 v[16]; float s = 0.f;
#pragma unroll
        for (int j = 0; j < 16; ++j) { v[j] = __builtin_nontemporal_load(xr + 64 * j); s += (v[j].x * v[j].x + v[j].y * v[j].y) + (v[j].z * v[j].z + v[j].w * v[j].w); }
        GAS u32x2* o8 = (GAS u32x2*)(XB + (size_t)m * DM) + F.lane;
#pragma unroll
        for (int j = 0; j < 16; ++j) { u32x2 w; w.x = pk2(v[j].x, v[j].y); w.y = pk2(v[j].z, v[j].w); o8[64 * j] = w; }
        ((GAS float*)SS)[(size_t)m * 64 + F.lane] = s;
    }
}
__device__ __forceinline__ void rs_table(const Frame& F, const float* SS, int pm) {
    LAS float* tab = (LAS float*)(F.lds + RSTAB_OFF);
    if (F.tid < 256) { const GAS f32x4* p = (const GAS f32x4*)(SS + (size_t)(pm * 256 + F.tid) * 64); float s = 0.f;
#pragma unroll
        for (int j = 0; j < 16; ++j) { const f32x4 v = p[j]; s += (v.x + v.y) + (v.z + v.w); }
        tab[F.tid] = 1.0f / sqrtf(s * (1.f / DM) + 1e-6f); }
    __syncthreads();
}

__device__ __forceinline__ int vimg_st(int k, int c) { const int kk = (k & ~0xC) | ((k & 4) << 1) | ((k & 8) >> 1); return ((kk >> 3) * 4 + (c >> 5)) * 512 + ((kk & 7) * 32 + (c & 31)) * 2; }
__device__ __forceinline__ int vimg_rd_base(int lane) { return ((lane & 3) << 3) | (((lane >> 2) & 3) << 6) | (((lane >> 4) & 1) << 5) | (((lane >> 5) & 1) << 8); }
typedef __attribute__((ext_vector_type(4))) short s16x4;
typedef __attribute__((ext_vector_type(16))) float f32x16;
template <int OFF> __device__ __forceinline__ s16x4 vimg_tr(int vb) { s16x4 r; asm volatile("ds_read_b64_tr_b16 %0, %1 offset:%2" : "=&v"(r) : "v"(vb), "i"(OFF) : "memory"); return r; }
__device__ __forceinline__ void unpack8(const v4u a, float (&v)[8]) { v[0] = bf_lo(a.x); v[1] = bf_hi(a.x); v[2] = bf_lo(a.y); v[3] = bf_hi(a.y); v[4] = bf_lo(a.z); v[5] = bf_hi(a.z); v[6] = bf_lo(a.w); v[7] = bf_hi(a.w); }

__device__ __forceinline__ void gmlp_unit(const Frame& F, const bf16* Z, bf16* YC, const float* SV, const bf16* Wsb, const float* bs, const float* lng, const float* lnb, int unit, char* ldsg) {
    const int chunk = unit >> 2, hp = unit & 3, r0 = chunk * 128, tid = F.tid, lane = F.lane, w = F.wave, r32 = lane & 31, hi = lane >> 5;
    LAS float* st = (LAS float*)(F.lds + RING_OFF);
    LAS unsigned char* VI = F.lds + RING_OFF + 1024;
    LAS float* OT = (LAS float*)(F.lds + RING_OFF + 1024 + 32768);
    if (tid < 128) { const GAS f32x4* p = (const GAS f32x4*)(SV + (size_t)(r0 + tid) * 32); float s1 = 0.f, s2 = 0.f;
#pragma unroll
        for (int j = 0; j < 8; ++j) { const f32x4 v = p[j]; s1 += v.x + v.z; s2 += v.y + v.w; }
        const float mean = s1 * (1.f / 1024.f), var = s2 * (1.f / 1024.f) - mean * mean;
        st[tid * 2] = mean; st[tid * 2 + 1] = 1.0f / sqrtf(fmaxf(var, 0.f) + 1e-5f); }
    __syncthreads();
    const int d0 = w & 3, ib0 = (w >> 2) * 2;
    const int vb = (int)(uintptr_t)(ldsg + RING_OFF + 1024) + vimg_rd_base(lane) + d0 * 512;
#pragma unroll 1
    for (int hq = 0; hq < 2; ++hq) {
        const int h = hp * 2 + hq;
        bf16x8 wa[8], wb[8];
        { const GAS bf16* wrow = (const GAS bf16*)Wsb + (size_t)(h * 128 + 32 * ib0 + r32) * 128 + 8 * hi;
#pragma unroll
          for (int ks = 0; ks < 8; ++ks) { wa[ks] = *(const GAS bf16x8*)(wrow + 16 * ks); wb[ks] = *(const GAS bf16x8*)(wrow + 32 * 128 + 16 * ks); } }
        { const int j = tid >> 2, cq = tid & 3; const float mean = st[j * 2], rstd = st[j * 2 + 1];
          const GAS v4u* p = (const GAS v4u*)(Z + (size_t)(r0 + j) * DIN + ZC_A + 1024 + h * 128 + cq * 32);
          const GAS f32x4* gp = (const GAS f32x4*)(lng + h * 128 + cq * 32); const GAS f32x4* bp = (const GAS f32x4*)(lnb + h * 128 + cq * 32);
          v4u a[4];
#pragma unroll
          for (int k4 = 0; k4 < 4; ++k4) a[k4] = p[k4];
#pragma unroll
          for (int k4 = 0; k4 < 4; ++k4) { float v[8]; unpack8(a[k4], v); const f32x4 g0 = gp[2 * k4], g1 = gp[2 * k4 + 1], b0 = bp[2 * k4], b1 = bp[2 * k4 + 1];
              v4u o; o.x = pk2((v[0] - mean) * rstd * g0.x + b0.x, (v[1] - mean) * rstd * g0.y + b0.y); o.y = pk2((v[2] - mean) * rstd * g0.z + b0.z, (v[3] - mean) * rstd * g0.w + b0.w);
              o.z = pk2((v[4] - mean) * rstd * g1.x + b1.x, (v[5] - mean) * rstd * g1.y + b1.y); o.w = pk2((v[6] - mean) * rstd * g1.z + b1.z, (v[7] - mean) * rstd * g1.w + b1.w);
              *(LAS v4u*)(VI + (j >> 6) * 16384 + vimg_st(j & 63, cq * 32 + k4 * 8)) = o; } }
        __syncthreads();
        f32x16 acc[2]; acc[0] = f32x16{}; acc[1] = f32x16{};
#define GM_RD(KS) lo_[KS] = vimg_tr<((KS) >> 2) * 16384 + ((KS) & 3) * 4096>(vb), hi_[KS] = vimg_tr<((KS) >> 2) * 16384 + ((KS) & 3) * 4096 + 2048>(vb)
#define GM_MM(KS) do { const bf16x8 b_ = (bf16x8){lo_[KS][0], lo_[KS][1], lo_[KS][2], lo_[KS][3], hi_[KS][0], hi_[KS][1], hi_[KS][2], hi_[KS][3]}; \
        acc[0] = __builtin_amdgcn_mfma_f32_32x32x16_bf16(wa[KS], b_, acc[0], 0, 0, 0); acc[1] = __builtin_amdgcn_mfma_f32_32x32x16_bf16(wb[KS], b_, acc[1], 0, 0, 0); } while (0)
        { s16x4 lo_[8], hi_[8];
          GM_RD(0); GM_RD(1); GM_RD(2); GM_RD(3); GM_RD(4); GM_RD(5); GM_RD(6); GM_RD(7);
          asm volatile("s_waitcnt lgkmcnt(0)" ::: "memory"); __builtin_amdgcn_sched_barrier(0);
          GM_MM(0); GM_MM(1); GM_MM(2); GM_MM(3); GM_MM(4); GM_MM(5); GM_MM(6); GM_MM(7); }
#undef GM_RD
#undef GM_MM
#define GM_STEP(KS) do { } while (0)
#undef GM_STEP
#pragma unroll
        for (int t = 0; t < 2; ++t)
#pragma unroll
            for (int r = 0; r < 16; ++r) OT[(32 * (ib0 + t) + (r & 3) + 8 * (r >> 2) + 4 * hi) * 132 + 32 * d0 + r32] = acc[t][r];
        __syncthreads();
        { const int i = tid >> 2, cq = tid & 3; const float b = bs[h * 128 + i];
          const GAS v4u* up = (const GAS v4u*)(Z + (size_t)(r0 + i) * DIN + ZC_A + h * 128 + cq * 32); GAS v4u* yp = (GAS v4u*)(YC + (size_t)(r0 + i) * DM + YC_A + h * 128 + cq * 32);
          v4u a[4];
#pragma unroll
          for (int k4 = 0; k4 < 4; ++k4) a[k4] = up[k4];
#pragma unroll
          for (int k4 = 0; k4 < 4; ++k4) { float u[8]; unpack8(a[k4], u); const f32x4 o0 = *(const LAS f32x4*)(OT + i * 132 + cq * 32 + k4 * 8), o1 = *(const LAS f32x4*)(OT + i * 132 + cq * 32 + k4 * 8 + 4);
              v4u o; o.x = pk2((o0.x + b) * u[0], (o0.y + b) * u[1]); o.y = pk2((o0.z + b) * u[2], (o0.w + b) * u[3]); o.z = pk2((o1.x + b) * u[4], (o1.y + b) * u[5]); o.w = pk2((o1.z + b) * u[6], (o1.w + b) * u[7]);
              yp[k4] = o; } }
    }
    __syncthreads();
}

template <int R> __device__ __forceinline__ void conv_rows(const unsigned (&hraw)[62], const f32x2v (&w)[31], f32x2v (&acc)[31], const f32x2v bias, LAS float* cvp, int rlo, int rhi) {
    const unsigned hv = (R >= rlo && R < rhi) ? hraw[R] : 0u;
    const f32x2v h = (f32x2v){bf_lo(hv), bf_hi(hv)};
#pragma unroll
    for (int k = 0; k < 31; ++k) { const int o = R - k; if (o >= 0 && o <= 31) acc[(o + 31) % 31] = acc[(o + 31) % 31] + h * w[k]; }
    if constexpr (R >= 30) { constexpr int o = R - 30; *(LAS f32x2v*)(cvp + o * GW) = acc[o % 31] + bias; acc[o % 31] = (f32x2v){0.f, 0.f}; }
    if constexpr (R + 1 < 62) conv_rows<R + 1>(hraw, w, acc, bias, cvp, rlo, rhi);
}
__device__ __forceinline__ void conv_unit(const Frame& F, const bf16* Z, bf16* YC, const float* cw, const float* cb, const float* lng, const float* lnb, int unit) {
    const int t0 = unit * 32, bstart = (t0 / SEQ) * SEQ, bend = bstart + SEQ, tid = F.tid, lane = F.lane, c0 = 2 * tid;
    LAS float* CV = (LAS float*)(F.lds + RING_OFF);
    unsigned hraw[62];
    { const GAS bf16* zp = (const GAS bf16*)Z + (ptrdiff_t)(t0 - 15) * DIN + ZC_B + c0;
#pragma unroll
      for (int r = 0; r < 62; ++r) { hraw[r] = *(const GAS unsigned*)zp; zp += DIN; asm volatile("" : "+v"(zp)); } }
    f32x2v w[31], acc[31];
    { const GAS float* wp = (const GAS float*)cw + c0;
#pragma unroll
      for (int k = 0; k < 31; ++k) { w[k] = *(const GAS f32x2v*)wp; acc[k] = (f32x2v){0.f, 0.f}; wp += GW; asm volatile("" : "+v"(wp)); } }
    const f32x2v bias = *(const GAS f32x2v*)(cb + c0);
    conv_rows<0>(hraw, w, acc, bias, CV + c0, bstart - (t0 - 15), bend - (t0 - 15));
    __syncthreads();
    { f32x4 x[4][4]; float sm[4], qv[4];
#pragma unroll
      for (int oo = 0; oo < 4; ++oo) { const int o = F.wave * 4 + oo; float s_ = 0.f;
#pragma unroll
          for (int j = 0; j < 4; ++j) { x[oo][j] = *(const LAS f32x4*)(CV + o * GW + lane * 4 + 256 * j); s_ += (x[oo][j].x + x[oo][j].y) + (x[oo][j].z + x[oo][j].w); }
          sm[oo] = s_; }
#pragma unroll
      for (int st = 1; st < 64; st <<= 1) {
#pragma unroll
          for (int oo = 0; oo < 4; ++oo) sm[oo] += __shfl_xor(sm[oo], st); }
#pragma unroll
      for (int oo = 0; oo < 4; ++oo) { const float mean = sm[oo] * (1.f / GW); float q = 0.f;
#pragma unroll
          for (int j = 0; j < 4; ++j) { x[oo][j] = x[oo][j] - mean; q += (x[oo][j].x * x[oo][j].x + x[oo][j].y * x[oo][j].y) + (x[oo][j].z * x[oo][j].z + x[oo][j].w * x[oo][j].w); }
          qv[oo] = q; }
#pragma unroll
      for (int st = 1; st < 64; st <<= 1) {
#pragma unroll
          for (int oo = 0; oo < 4; ++oo) qv[oo] += __shfl_xor(qv[oo], st); }
#pragma unroll
      for (int j = 0; j < 4; ++j) { const int c = lane * 4 + 256 * j; const f32x4 gv = *(const GAS f32x4*)(lng + c), bv = *(const GAS f32x4*)(lnb + c);
#pragma unroll
          for (int oo = 0; oo < 4; ++oo) { const int o = F.wave * 4 + oo; const float rstd = 1.0f / sqrtf(qv[oo] * (1.f / GW) + 1e-5f);
              f32x4 y = x[oo][j] * rstd * gv + bv; y.x *= sigmoidf_fast(y.x); y.y *= sigmoidf_fast(y.y); y.z *= sigmoidf_fast(y.z); y.w *= sigmoidf_fast(y.w);
              u32x2 wv; wv.x = pk2(y.x, y.y); wv.y = pk2(y.z, y.w);
              *(GAS u32x2*)(YC + (size_t)(t0 + o) * DM + YC_B + c) = wv; } } }
    __syncthreads();
}

__device__ __forceinline__ void pool_unit(const Frame& F, const bf16* Z, bf16* YC, const bf16* PWT, const float* scale, int unit) {
    const int g = unit & 3, tile = unit >> 2, t0 = tile * 64, bstart = (t0 / SEQ) * SEQ, tid = F.tid, lane = F.lane, fr = lane & 15, fq = lane >> 4, w = F.wave;
    const int wh = 1 << g;
    LAS bf16* ZT = (LAS bf16*)(F.lds + RING_OFF);
    LAS bf16* P = (LAS bf16*)(F.lds + RING_OFF + 80 * 264 * 2);
    const GAS bf16* pw = (const GAS bf16*)PWT + (size_t)g * 65536;
    bf16x8 Bf[8][2];
#pragma unroll
    for (int kk = 0; kk < 8; ++kk)
#pragma unroll
        for (int n = 0; n < 2; ++n) Bf[kk][n] = *(const GAS bf16x8*)(pw + (size_t)(32 * w + 16 * n + fr) * 256 + 32 * kk + 8 * fq);
    { const GAS bf16* zc = (const GAS bf16*)Z + ZC_C + g * 256; v4u a[5];
#pragma unroll
      for (int i = 0; i < 5; ++i) { const int q = tid + 512 * i, rr = q >> 5, cc = q & 31; int row = t0 - 8 + rr; row = row < bstart ? bstart : (row >= bstart + SEQ ? bstart + SEQ - 1 : row);
          a[i] = *(const GAS v4u*)(zc + (size_t)row * DIN + cc * 8); }
#pragma unroll
      for (int i = 0; i < 5; ++i) { const int q = tid + 512 * i, rr = q >> 5, cc = q & 31; *(LAS v4u*)(ZT + rr * 264 + cc * 8) = a[i]; } }
    __syncthreads();
    { const int cc = tid & 31, rg = tid >> 5;
      auto body = [&](auto GC) __attribute__((always_inline)) { constexpr int WH = 1 << decltype(GC)::value, NU = 2 * WH + 3;
          const int pos0 = t0 - bstart + 4 * rg - WH;
          v4u raw[NU];
#pragma unroll
          for (int i = 0; i < NU; ++i) raw[i] = *(const LAS v4u*)(ZT + (4 * rg - WH + i + 8) * 264 + cc * 8);
          float sw[8];
#pragma unroll
          for (int e = 0; e < 8; ++e) sw[e] = 0.f;
#pragma unroll
          for (int i = 0; i < 2 * WH; ++i) { const unsigned ps = (unsigned)(pos0 + i); float v[8]; unpack8(raw[i], v); const float mk = ps < (unsigned)SEQ ? 1.f : 0.f;
#pragma unroll
              for (int e = 0; e < 8; ++e) sw[e] += v[e] * mk; }
#pragma unroll
          for (int o = 0; o < 4; ++o) {
              if (o > 0) { float va[8], vr[8]; unpack8(raw[2 * WH - 1 + o], va); unpack8(raw[o - 1], vr);
                  const float ma = (unsigned)(pos0 + 2 * WH - 1 + o) < (unsigned)SEQ ? 1.f : 0.f, mr = (unsigned)(pos0 + o - 1) < (unsigned)SEQ ? 1.f : 0.f;
#pragma unroll
                  for (int e = 0; e < 8; ++e) sw[e] += va[e] * ma - vr[e] * mr; }
              const int pos = pos0 + WH + o; const int lo = pos - WH > 0 ? pos - WH : 0, hi = pos + WH < SEQ ? pos + WH : SEQ; const float inv = 1.0f / (float)(hi - lo);
              float v[8]; unpack8(raw[WH + o], v);
              v4u ov; ov.x = pk2(sw[0] * inv - v[0], sw[1] * inv - v[1]); ov.y = pk2(sw[2] * inv - v[2], sw[3] * inv - v[3]); ov.z = pk2(sw[4] * inv - v[4], sw[5] * inv - v[5]); ov.w = pk2(sw[6] * inv - v[6], sw[7] * inv - v[7]);
              *(LAS v4u*)(P + (4 * rg + o) * 264 + cc * 8) = ov; } };
      if (g == 0) body(std::integral_constant<int, 0>{}); else if (g == 1) body(std::integral_constant<int, 1>{}); else if (g == 2) body(std::integral_constant<int, 2>{}); else body(std::integral_constant<int, 3>{}); }
    __syncthreads();
    f32x4 acc[4][2];
#pragma unroll
    for (int m = 0; m < 4; ++m)
#pragma unroll
        for (int n = 0; n < 2; ++n) acc[m][n] = (f32x4){0.f, 0.f, 0.f, 0.f};
#pragma unroll
    for (int kk = 0; kk < 8; ++kk) {
        bf16x8 Af[4];
#pragma unroll
        for (int m = 0; m < 4; ++m) Af[m] = *(const LAS bf16x8*)(P + (16 * m + fr) * 264 + 32 * kk + 8 * fq);
#pragma unroll
        for (int m = 0; m < 4; ++m)
#pragma unroll
            for (int n = 0; n < 2; ++n) acc[m][n] = __builtin_amdgcn_mfma_f32_16x16x32_bf16(Bf[kk][n], Af[m], acc[m][n], 0, 0, 0);
    }
#pragma unroll
    for (int n = 0; n < 2; ++n) { const int d = 32 * w + 16 * n + 4 * fq; const f32x4 sc = *(const GAS f32x4*)(scale + g * 256 + d);
#pragma unroll
        for (int m = 0; m < 4; ++m) { const f32x4 v = acc[m][n] * sc; u32x2 wv; wv.x = pk2(v[0], v[1]); wv.y = pk2(v[2], v[3]);
            *(GAS u32x2*)(YC + (size_t)(t0 + 16 * m + fr) * DM + YC_C + g * 256 + d) = wv; } }
    __syncthreads();
}

namespace att {
typedef __attribute__((ext_vector_type(8))) short bf16x8;
typedef __attribute__((ext_vector_type(4))) short s16x4;
typedef __attribute__((ext_vector_type(16))) float f32x16;
typedef __attribute__((ext_vector_type(4))) unsigned u32x4;
constexpr int QBLK = 32, KVBLK = 64, NW = 8, LDQK = 64, LDV = 128;
constexpr int SHM_V = KVBLK * 128 * 2, SHM_K = KVBLK * 64 * 2;
constexpr int OFF_V = 0, OFF_K = 2 * SHM_V, OFF_WS = OFF_K + 2 * SHM_K, ATT_LDS = OFF_WS + NW * 64 * 4;
constexpr float THR = 8.0f;
#define KSWZ(row, colB) ((row) * 128 + ((colB) ^ ((((row) >> 1) & 7) << 4)))
#define SBAR() __builtin_amdgcn_sched_barrier(0)
__device__ __forceinline__ int crow(int r, int hi) { return (r & 3) + 8 * (r >> 2) + 4 * hi; }
__device__ __forceinline__ unsigned cvtpk(float lo, float hi) { unsigned r; asm volatile("v_cvt_pk_bf16_f32 %0, %1, %2" : "=v"(r) : "v"(lo), "v"(hi)); return r; }

__device__ __forceinline__ void partialSM(f32x16& p0, f32x16& p1, float& m_reg, float& alpha) {
    float pmax = p0[0];
#pragma unroll
    for (int r = 1; r < 16; ++r) pmax = fmaxf(pmax, p0[r]);
#pragma unroll
    for (int r = 0; r < 16; ++r) pmax = fmaxf(pmax, p1[r]);
    { auto rr = __builtin_amdgcn_permlane32_swap(__float_as_uint(pmax), __float_as_uint(pmax), false, false);
      pmax = fmaxf(__uint_as_float(rr[0]), __uint_as_float(rr[1])); }
    if (__builtin_expect(__all(pmax - m_reg <= THR), 1)) { alpha = 1.f; }
    else { const float mn = fmaxf(m_reg, pmax); alpha = __builtin_amdgcn_exp2f(m_reg - mn); m_reg = mn; }
    const float mm = m_reg;
#pragma unroll
    for (int r = 0; r < 16; ++r) { p0[r] -= mm; p1[r] -= mm; }
#pragma unroll
    for (int r = 0; r < 16; ++r) p0[r] = __builtin_amdgcn_exp2f(p0[r]);
}
__device__ __forceinline__ void finishSM(f32x16& p0, f32x16& p1, float alpha, float& l_reg, bf16x8& pa0, bf16x8& pa1, bf16x8& pa2, bf16x8& pa3) {
#pragma unroll
    for (int r = 0; r < 16; ++r) p1[r] = __builtin_amdgcn_exp2f(p1[r]);
    float ps = 0.f;
#pragma unroll
    for (int r = 0; r < 16; ++r) ps += p0[r];
#pragma unroll
    for (int r = 0; r < 16; ++r) ps += p1[r];
    { auto rr = __builtin_amdgcn_permlane32_swap(__float_as_uint(ps), __float_as_uint(ps), false, false);
      ps = __uint_as_float(rr[0]) + __uint_as_float(rr[1]); }
    l_reg = l_reg * alpha + ps;
#define PK4(P, BASE, OUT) do { unsigned a0 = cvtpk(P[BASE + 0], P[BASE + 1]), a1 = cvtpk(P[BASE + 2], P[BASE + 3]);   \
    unsigned b0 = cvtpk(P[BASE + 4], P[BASE + 5]), b1 = cvtpk(P[BASE + 6], P[BASE + 7]);                              \
    auto r0 = __builtin_amdgcn_permlane32_swap(a0, b0, false, false); auto r1 = __builtin_amdgcn_permlane32_swap(a1, b1, false, false); \
    u32x4 w = {r0[0], r1[0], r0[1], r1[1]}; OUT = *reinterpret_cast<bf16x8*>(&w); } while (0)
    PK4(p0, 0, pa0); PK4(p0, 8, pa1); PK4(p1, 0, pa2); PK4(p1, 8, pa3);
#undef PK4
}
__device__ __forceinline__ void qkt(f32x16& p0, f32x16& p1, const char* Ks, const bf16x8* qr, int r32, int hi) {
    p0 = f32x16{}; p1 = f32x16{};
#pragma unroll
    for (int d0 = 0; d0 < 4; ++d0) { const int cb = (d0 * 16 + hi * 8) * 2;
        const bf16x8 b0 = *reinterpret_cast<const bf16x8*>(Ks + KSWZ(r32, cb));
        const bf16x8 b1 = *reinterpret_cast<const bf16x8*>(Ks + KSWZ(32 + r32, cb));
        p0 = __builtin_amdgcn_mfma_f32_32x32x16_bf16(b0, qr[d0], p0, 0, 0, 0);
        p1 = __builtin_amdgcn_mfma_f32_32x32x16_bf16(b1, qr[d0], p1, 0, 0, 0); }
}
__device__ __forceinline__ int v_st(int k, int c) { const int kk = (k & ~0xC) | ((k & 4) << 1) | ((k & 8) >> 1); return ((kk >> 3) * 4 + (c >> 5)) * 512 + ((kk & 7) * 32 + (c & 31)) * 2; }
__device__ __forceinline__ int v_rd_base(int lane) { return ((lane & 3) << 3) | (((lane >> 2) & 3) << 6) | (((lane >> 4) & 1) << 5) | (((lane >> 5) & 1) << 8); }
constexpr int v_rd_off(int d0, int ks, int half) { return d0 * 512 + ks * 4096 + half * 2048; }
template <int OFF> __device__ __forceinline__ s16x4 tr_read(int vb) {
    s16x4 r; asm volatile("ds_read_b64_tr_b16 %0, %1 offset:%2" : "=&v"(r) : "v"(vb), "i"(OFF) : "memory"); return r;
}
template <int D0> __device__ __forceinline__ void pv_one(f32x16& od, int vb, bf16x8 pa0, bf16x8 pa1, bf16x8 pa2, bf16x8 pa3) {
    const s16x4 l0 = tr_read<v_rd_off(D0, 0, 0)>(vb), h0 = tr_read<v_rd_off(D0, 0, 1)>(vb), l1 = tr_read<v_rd_off(D0, 1, 0)>(vb), h1 = tr_read<v_rd_off(D0, 1, 1)>(vb);
    const s16x4 l2 = tr_read<v_rd_off(D0, 2, 0)>(vb), h2 = tr_read<v_rd_off(D0, 2, 1)>(vb), l3 = tr_read<v_rd_off(D0, 3, 0)>(vb), h3 = tr_read<v_rd_off(D0, 3, 1)>(vb);
    asm volatile("s_waitcnt lgkmcnt(0)" ::: "memory"); SBAR();
#define PK(L, H) (bf16x8){L[0], L[1], L[2], L[3], H[0], H[1], H[2], H[3]}
    od = __builtin_amdgcn_mfma_f32_32x32x16_bf16(pa0, PK(l0, h0), od, 0, 0, 0);
    od = __builtin_amdgcn_mfma_f32_32x32x16_bf16(pa1, PK(l1, h1), od, 0, 0, 0);
    od = __builtin_amdgcn_mfma_f32_32x32x16_bf16(pa2, PK(l2, h2), od, 0, 0, 0);
    od = __builtin_amdgcn_mfma_f32_32x32x16_bf16(pa3, PK(l3, h3), od, 0, 0, 0);
#undef PK
}
__device__ __forceinline__ void pv_d0(f32x16* o, int vb, bf16x8 pa0, bf16x8 pa1, bf16x8 pa2, bf16x8 pa3) {
    pv_one<0>(o[0], vb, pa0, pa1, pa2, pa3); pv_one<1>(o[1], vb, pa0, pa1, pa2, pa3); pv_one<2>(o[2], vb, pa0, pa1, pa2, pa3); pv_one<3>(o[3], vb, pa0, pa1, pa2, pa3);
}

__device__ __forceinline__ void attn_pass(const bf16* __restrict__ Qb, const bf16* __restrict__ Kh, const bf16* __restrict__ Vh, char* lds, f32x16 (&o)[4], float& l_out) {
    int tid_ = threadIdx.x; asm volatile("" : "+v"(tid_));
    const int tid = tid_, wid = tid >> 6, lane = tid & 63, r32 = lane & 31, hi = lane >> 5;
    char* V_lds = lds + OFF_V; char* K_lds = lds + OFF_K;
    float* ws = (float*)(lds + OFF_WS) + wid * 64; float* al_l = ws + 32;
    float m_reg = -1e30f, l_reg = 0.f; bf16x8 qr[4];
#pragma unroll
    for (int d = 0; d < 4; ++d) o[d] = f32x16{};
    const GAS bf16* Qw = (const GAS bf16*)Qb + (size_t)(wid * QBLK + r32) * LDQK + hi * 8;
#pragma unroll
    for (int d0 = 0; d0 < 4; ++d0) qr[d0] = *(const GAS bf16x8*)(Qw + d0 * 16);
    const int sr = tid >> 4, sc = (tid & 15) * 8, vst0 = v_st(sr, sc), vst1 = v_st(32 + sr, sc);
    const int kr = tid >> 3, kc = (tid & 7) * 16, kst = KSWZ(kr, kc);
    const int vb0 = (int)(uintptr_t)V_lds + v_rd_base(lane);
    const GAS bf16* Kg = (const GAS bf16*)Kh + (size_t)kr * LDQK + (tid & 7) * 8;
    const GAS bf16* Vg = (const GAS bf16*)Vh + (size_t)sr * LDV + sc;
    struct { bf16x8 vs0, vs1, ks0; } sr_[2];
#define SLOAD(i, k0) do { sr_[i].vs0 = *(const GAS bf16x8*)(Vg + (size_t)(k0) * LDV); sr_[i].vs1 = *(const GAS bf16x8*)(Vg + (size_t)((k0) + 32) * LDV); \
    sr_[i].ks0 = *(const GAS bf16x8*)(Kg + (size_t)(k0) * LDQK); } while (0)
#define SWRITE(b, i) do { *(bf16x8*)(V_lds + (b) * SHM_V + vst0) = sr_[i].vs0; *(bf16x8*)(V_lds + (b) * SHM_V + vst1) = sr_[i].vs1; \
    *(bf16x8*)(K_lds + (b) * SHM_K + kst) = sr_[i].ks0; } while (0)
#define SWAIT() asm volatile("s_waitcnt vmcnt(3)" ::: "memory")
#define RESC(a) do { if (__any((a) < 1.f)) { if (hi == 0) al_l[r32] = (a); asm volatile("s_waitcnt lgkmcnt(0)" ::: "memory"); \
    _Pragma("unroll") for (int d = 0; d < 4; ++d) _Pragma("unroll") for (int r = 0; r < 16; ++r) o[d][r] *= al_l[crow(r, hi)]; } } while (0)
    f32x16 pA0, pA1, pB0, pB1; float alA, alB; bf16x8 pa0, pa1, pa2, pa3; constexpr int NT = SEQ / KVBLK;
    constexpr int SE = 0, SO = 1;
    SLOAD(SE, 0); asm volatile("s_waitcnt vmcnt(0)" ::: "memory"); SWRITE(0, SE); __syncthreads();
    qkt(pA0, pA1, K_lds, qr, r32, hi); partialSM(pA0, pA1, m_reg, alA);
    SLOAD(SO, KVBLK); SLOAD(SE, 2 * KVBLK);
    SWAIT(); SWRITE(1, SO); __syncthreads();
    for (int j = 1; j + 1 < NT; j += 2) {
        SBAR(); qkt(pB0, pB1, K_lds + SHM_K, qr, r32, hi);
        finishSM(pA0, pA1, alA, l_reg, pa0, pa1, pa2, pa3); SBAR();
        SLOAD(SO, (j + 2) * KVBLK); SBAR();
        pv_d0(o, vb0, pa0, pa1, pa2, pa3); partialSM(pB0, pB1, m_reg, alB);
        __syncthreads(); SWAIT(); SWRITE(0, SE);
        RESC(alB); __syncthreads();
        SBAR(); qkt(pA0, pA1, K_lds, qr, r32, hi);
        finishSM(pB0, pB1, alB, l_reg, pa0, pa1, pa2, pa3); SBAR();
        if (j + 3 < NT) SLOAD(SE, (j + 3) * KVBLK); SBAR();
        pv_d0(o, vb0 + SHM_V, pa0, pa1, pa2, pa3); partialSM(pA0, pA1, m_reg, alA);
        __syncthreads(); SWAIT(); SWRITE(1, SO);
        RESC(alA); __syncthreads();
    }
    SBAR(); qkt(pB0, pB1, K_lds + SHM_K, qr, r32, hi);
    finishSM(pA0, pA1, alA, l_reg, pa0, pa1, pa2, pa3); SBAR();
    pv_d0(o, vb0, pa0, pa1, pa2, pa3); partialSM(pB0, pB1, m_reg, alB);
    __syncthreads(); RESC(alB);
    finishSM(pB0, pB1, alB, l_reg, pa0, pa1, pa2, pa3); SBAR();
    pv_d0(o, vb0 + SHM_V, pa0, pa1, pa2, pa3);
    l_out = l_reg;
    __syncthreads();
#undef SLOAD
#undef SWRITE
#undef SWAIT
#undef RESC
}

constexpr int F_OFF_WS = 4 * SHM_V + 4 * SHM_K;
template <int G> __device__ __forceinline__ void pv_rd(s16x4 (&lo)[4], s16x4 (&hh)[4], int vb) {
    lo[0] = tr_read<v_rd_off(G, 0, 0)>(vb); hh[0] = tr_read<v_rd_off(G, 0, 1)>(vb); lo[1] = tr_read<v_rd_off(G, 1, 0)>(vb); hh[1] = tr_read<v_rd_off(G, 1, 1)>(vb);
    lo[2] = tr_read<v_rd_off(G, 2, 0)>(vb); hh[2] = tr_read<v_rd_off(G, 2, 1)>(vb); lo[3] = tr_read<v_rd_off(G, 3, 0)>(vb); hh[3] = tr_read<v_rd_off(G, 3, 1)>(vb);
}
__device__ __forceinline__ void pv_mm(f32x16& od, const s16x4 (&lo)[4], const s16x4 (&hh)[4], bf16x8 pa0, bf16x8 pa1, bf16x8 pa2, bf16x8 pa3) {
#define PK(L, H) (bf16x8){L[0], L[1], L[2], L[3], H[0], H[1], H[2], H[3]}
    od = __builtin_amdgcn_mfma_f32_32x32x16_bf16(pa0, PK(lo[0], hh[0]), od, 0, 0, 0);
    od = __builtin_amdgcn_mfma_f32_32x32x16_bf16(pa1, PK(lo[1], hh[1]), od, 0, 0, 0);
    od = __builtin_amdgcn_mfma_f32_32x32x16_bf16(pa2, PK(lo[2], hh[2]), od, 0, 0, 0);
    od = __builtin_amdgcn_mfma_f32_32x32x16_bf16(pa3, PK(lo[3], hh[3]), od, 0, 0, 0);
#undef PK
}
template <int OFF> __device__ __forceinline__ bf16x8 lds_rd128(int addr) { bf16x8 r; asm volatile("ds_read_b128 %0, %1 offset:%2" : "=&v"(r) : "v"(addr), "i"(OFF) : "memory"); return r; }
__device__ __forceinline__ float fadd_s(float a, float b) { float r; asm("v_add_f32_e32 %0, %1, %2" : "=v"(r) : "v"(a), "v"(b)); return r; }
constexpr int F_NSLOT = 4;
constexpr int F2_OFF_V = 0, F2_OFF_K = F_NSLOT * SHM_V, F2_END = F2_OFF_K + F_NSLOT * SHM_K;
static_assert(F2_END <= F_OFF_WS, "attention rings below the per-wave scratch");
template <int ABL> __device__ __forceinline__ void attn_pass_fast(const bf16* __restrict__ Qb, const bf16* __restrict__ Kh, const bf16* __restrict__ Vh, char* lds, f32x16 (&o)[4], float& l_out) {
    int tid_ = threadIdx.x; asm volatile("" : "+v"(tid_));
    const int tid = tid_, wid = __builtin_amdgcn_readfirstlane(tid >> 6), lane = tid & 63, r32 = lane & 31, hi = lane >> 5; const bool trail = wid >= 4;
    LAS unsigned char* ldsl = (LAS unsigned char*)(unsigned)(uintptr_t)lds;
    bf16x8 qr[4];
#pragma unroll
    for (int d = 0; d < 4; ++d) o[d] = f32x16{};
    const GAS bf16* Qw = (const GAS bf16*)Qb + (size_t)(wid * QBLK + r32) * LDQK + hi * 8;
#pragma unroll
    for (int d0 = 0; d0 < 4; ++d0) qr[d0] = *(const GAS bf16x8*)(Qw + d0 * 16);
    const int krow = wid * 8 + (lane >> 3), kpos = lane & 7;
    const GAS bf16* Kg = (const GAS bf16*)Kh + (size_t)krow * LDQK + ((kpos ^ ((krow >> 1) & 7)) * 8);
    const int vsub0 = 4 * wid + (lane >> 5), vsub1 = vsub0 + 2;
    const int vkk0 = (vsub0 >> 2) * 8 + ((lane & 31) >> 2), vkk1 = (vsub1 >> 2) * 8 + ((lane & 31) >> 2);
    const GAS bf16* Vg0 = (const GAS bf16*)Vh + (size_t)vkk0 * LDV + (vsub0 & 3) * 32 + (lane & 3) * 8;
    const GAS bf16* Vg1 = (const GAS bf16*)Vh + (size_t)vkk1 * LDV + (vsub1 & 3) * 32 + (lane & 3) * 8;
    const int vb0 = (int)(unsigned)(uintptr_t)(lds + F2_OFF_V) + v_rd_base(lane);
    const int kbase = (int)(unsigned)(uintptr_t)(lds + F2_OFF_K);
    const int ka0 = kbase + KSWZ(r32, (0 * 16 + hi * 8) * 2), ka1 = kbase + KSWZ(r32, (1 * 16 + hi * 8) * 2), ka2 = kbase + KSWZ(r32, (2 * 16 + hi * 8) * 2), ka3 = kbase + KSWZ(r32, (3 * 16 + hi * 8) * 2);
    constexpr int NT = SEQ / KVBLK;
#define FBAR() do { asm volatile("s_waitcnt lgkmcnt(0)\n\ts_barrier" ::: "memory"); SBAR(); } while (0)
#define DMA_K(t, slot) __builtin_amdgcn_global_load_lds((const GAS unsigned*)(Kg + (size_t)(t) * KVBLK * LDQK), (LAS unsigned*)(ldsl + F2_OFF_K + (slot) * SHM_K + wid * 1024), 16, 0, 0)
#define DMA_V(t, slot) do { __builtin_amdgcn_global_load_lds((const GAS unsigned*)(Vg0 + (size_t)(t) * KVBLK * LDV), (LAS unsigned*)(ldsl + F2_OFF_V + (slot) * SHM_V + wid * 2048), 16, 0, 0); \
    __builtin_amdgcn_global_load_lds((const GAS unsigned*)(Vg1 + (size_t)(t) * KVBLK * LDV), (LAS unsigned*)(ldsl + F2_OFF_V + (slot) * SHM_V + wid * 2048 + 1024), 16, 0, 0); } while (0)
#define KREAD(kb) do { kf[0] = lds_rd128<0>(ka0 + (kb)); kf[1] = lds_rd128<4096>(ka0 + (kb)); kf[2] = lds_rd128<0>(ka1 + (kb)); kf[3] = lds_rd128<4096>(ka1 + (kb)); \
    kf[4] = lds_rd128<0>(ka2 + (kb)); kf[5] = lds_rd128<4096>(ka2 + (kb)); kf[6] = lds_rd128<0>(ka3 + (kb)); kf[7] = lds_rd128<4096>(ka3 + (kb)); } while (0)
#define QKT() do { p0 = __builtin_amdgcn_mfma_f32_32x32x16_bf16(kf[0], qr[0], f32x16{}, 0, 0, 0); p1 = __builtin_amdgcn_mfma_f32_32x32x16_bf16(kf[1], qr[0], f32x16{}, 0, 0, 0); \
    p0 = __builtin_amdgcn_mfma_f32_32x32x16_bf16(kf[2], qr[1], p0, 0, 0, 0); p1 = __builtin_amdgcn_mfma_f32_32x32x16_bf16(kf[3], qr[1], p1, 0, 0, 0); \
    p0 = __builtin_amdgcn_mfma_f32_32x32x16_bf16(kf[4], qr[2], p0, 0, 0, 0); p1 = __builtin_amdgcn_mfma_f32_32x32x16_bf16(kf[5], qr[2], p1, 0, 0, 0); \
    p0 = __builtin_amdgcn_mfma_f32_32x32x16_bf16(kf[6], qr[3], p0, 0, 0, 0); p1 = __builtin_amdgcn_mfma_f32_32x32x16_bf16(kf[7], qr[3], p1, 0, 0, 0); } while (0)
    bf16x8 kf[8];
    DMA_K(0, 0); DMA_K(1, 1); DMA_K(2, 2); DMA_V(0, 0); DMA_V(1, 1);
    asm volatile("s_waitcnt vmcnt(0)" ::: "memory");
    __syncthreads();
    if (trail) FBAR();
    f32x16 p0, p1; bf16x8 pa0, pa1, pa2, pa3; float l_reg = 0.f;
    KREAD(0); asm volatile("s_waitcnt lgkmcnt(0)" ::: "memory"); SBAR();
#define EXP8(P, B) do { _Pragma("unroll") for (int r_ = 0; r_ < 8; ++r_) P[(B) + r_] = __builtin_amdgcn_exp2f(P[(B) + r_]); } while (0)
    QKT();
    EXP8(p0, 0); EXP8(p0, 8); EXP8(p1, 0); EXP8(p1, 8);
    FBAR();
    int ks_w = 3, vs_w = 2;
    int kb_r = SHM_K, vb_r = 0;
    s16x4 la[4], ha[4], lb[4], hb[4];
#pragma unroll 1
    for (int x = 0; x < NT; ++x) {
        const int vb = vb0 + vb_r;
        if (x + 1 < NT) KREAD(kb_r);
        pv_rd<0>(la, ha, vb); pv_rd<1>(lb, hb, vb);
        if (x + 3 < NT) DMA_K(x + 3, ks_w);
        if (x + 2 < NT) DMA_V(x + 2, vs_w);
        { float a = fadd_s(p0[0], p0[1]), b = fadd_s(p0[2], p0[3]), c = fadd_s(p1[0], p1[1]), d = fadd_s(p1[2], p1[3]);
#pragma unroll
          for (int r = 4; r < 16; r += 4) { a = fadd_s(a, fadd_s(p0[r], p0[r + 1])); b = fadd_s(b, fadd_s(p0[r + 2], p0[r + 3])); c = fadd_s(c, fadd_s(p1[r], p1[r + 1])); d = fadd_s(d, fadd_s(p1[r + 2], p1[r + 3])); }
          l_reg = fadd_s(l_reg, fadd_s(fadd_s(a, b), fadd_s(c, d))); }
        { u32x4 w;
          w = (u32x4){cvtpk(p0[0], p0[1]), cvtpk(p0[2], p0[3]), cvtpk(p0[4], p0[5]), cvtpk(p0[6], p0[7])}; pa0 = __builtin_bit_cast(bf16x8, w);
          w = (u32x4){cvtpk(p0[8], p0[9]), cvtpk(p0[10], p0[11]), cvtpk(p0[12], p0[13]), cvtpk(p0[14], p0[15])}; pa1 = __builtin_bit_cast(bf16x8, w);
          w = (u32x4){cvtpk(p1[0], p1[1]), cvtpk(p1[2], p1[3]), cvtpk(p1[4], p1[5]), cvtpk(p1[6], p1[7])}; pa2 = __builtin_bit_cast(bf16x8, w);
          w = (u32x4){cvtpk(p1[8], p1[9]), cvtpk(p1[10], p1[11]), cvtpk(p1[12], p1[13]), cvtpk(p1[14], p1[15])}; pa3 = __builtin_bit_cast(bf16x8, w); }
        if (x + 3 < NT) asm volatile("s_waitcnt vmcnt(3)" ::: "memory"); else asm volatile("s_waitcnt vmcnt(0)" ::: "memory");
        FBAR();
        __builtin_amdgcn_s_setprio(2);
#define MIX4() do { _Pragma("unroll") for (int i_ = 0; i_ < 4; ++i_) { __builtin_amdgcn_sched_group_barrier(0x008, 1, 0); __builtin_amdgcn_sched_group_barrier(0x400, 2, 0); } } while (0)
        if (x + 1 < NT) QKT();
        SBAR();
        pv_mm(o[0], la, ha, pa0, pa1, pa2, pa3);
        EXP8(p0, 0);
        MIX4(); SBAR();
        pv_rd<2>(la, ha, vb);
        pv_mm(o[1], lb, hb, pa0, pa1, pa2, pa3);
        EXP8(p0, 8);
        MIX4(); SBAR();
        pv_rd<3>(lb, hb, vb);
        __builtin_amdgcn_s_setprio(0);
        asm volatile("s_waitcnt lgkmcnt(8)" ::: "memory"); SBAR();
        pv_mm(o[2], la, ha, pa0, pa1, pa2, pa3);
        EXP8(p1, 0);
        MIX4(); SBAR();
        asm volatile("s_waitcnt lgkmcnt(0)" ::: "memory"); SBAR();
        pv_mm(o[3], lb, hb, pa0, pa1, pa2, pa3);
        EXP8(p1, 8);
        MIX4(); SBAR();
#undef MIX4
        __builtin_amdgcn_s_setprio(0);
        ks_w = (ks_w + 1) & 3; vs_w = (vs_w + 1) & 3;
        kb_r = (kb_r + SHM_K) & (F_NSLOT * SHM_K - 1); vb_r = (vb_r + SHM_V) & (F_NSLOT * SHM_V - 1);
        FBAR();
    }
    if (!trail) FBAR();
    { auto rr = __builtin_amdgcn_permlane32_swap(__float_as_uint(l_reg), __float_as_uint(l_reg), false, false); l_reg = __uint_as_float(rr[0]) + __uint_as_float(rr[1]); }
    l_out = l_reg;
    __syncthreads();
#undef FBAR
#undef DMA_K
#undef DMA_V
#undef KREAD
#undef QKT
#undef EXP8
}

template <int ABL> __device__ __forceinline__ void attn_unit(int b, int h, int qb, const bf16* QH, const bf16* KH, const bf16* VH, bf16* YC, float* OS, const float* subg, float lam, float oscale, char* lds, bool fast) {
    int tid_ = threadIdx.x; asm volatile("" : "+v"(tid_));
    const int tid = tid_, wid = tid >> 6, lane = tid & 63, r32 = lane & 31, hi = lane >> 5;
    const size_t rowbase = (size_t)b * SEQ, q0 = rowbase + (size_t)qb * 256;
    float* wsf = (float*)(lds + F_OFF_WS) + wid * 64;
#pragma unroll 1
    for (int c = 0; c < 2; ++c) {
        f32x16 o[4]; float l;
        const size_t hcb = (size_t)((b * 16 + h * 2 + c)) * SEQ; const bf16* Qp = QH + (hcb + (size_t)qb * 256) * LDQK; const bf16* Kp = KH + hcb * LDQK; const bf16* Vp = VH + (size_t)(b * 8 + h) * SEQ * LDV;
        if (fast) attn_pass_fast<ABL>(Qp, Kp, Vp, lds, o, l);
        else attn_pass(Qp, Kp, Vp, lds, o, l);
        if (hi == 0) wsf[r32] = l; asm volatile("s_waitcnt lgkmcnt(0)" ::: "memory");
        float rli[16];
#pragma unroll
        for (int r = 0; r < 16; ++r) rli[r] = 1.0f / wsf[crow(r, hi)];
        GAS float* os = (GAS float*)OS + (q0 + wid * QBLK + 4 * hi) * GW + h * 128 + r32;
        asm volatile("" : "+v"(os));
        if (c == 0) {
#pragma unroll
            for (int r = 0; r < 16; ++r) { GAS float* p = os + ((r & 3) + 8 * (r >> 2)) * GW; asm volatile("" : "+v"(p));
#pragma unroll
                for (int d0 = 0; d0 < 4; ++d0) p[d0 * 32] = o[d0][r] * rli[r]; }
        } else {
            float ssq[16], ov[16][4];
#pragma unroll
            for (int r = 0; r < 16; ++r) { const GAS float* p = os + ((r & 3) + 8 * (r >> 2)) * GW; asm volatile("" : "+v"(p));
#pragma unroll
                for (int d0 = 0; d0 < 4; ++d0) ov[r][d0] = p[d0 * 32]; }
#pragma unroll
            for (int r = 0; r < 16; ++r) { float s = 0.f;
#pragma unroll
                for (int d0 = 0; d0 < 4; ++d0) { const float v = ov[r][d0] - lam * (o[d0][r] * rli[r]); o[d0][r] = v; s += v * v; }
                ssq[r] = s; }
#pragma unroll
            for (int r = 0; r < 16; ++r) { float s = ssq[r]; s += __shfl_xor(s, 1); s += __shfl_xor(s, 2); s += __shfl_xor(s, 4); s += __shfl_xor(s, 8); s += __shfl_xor(s, 16);
                ssq[r] = oscale / sqrtf(s * (1.f / 128.f) + 1e-6f); }
            GAS bf16* yo = (GAS bf16*)YC + (q0 + wid * QBLK + 4 * hi) * DM + YC_D + h * 128 + r32;
            asm volatile("" : "+v"(yo));
#pragma unroll
            for (int r = 0; r < 16; ++r) { GAS bf16* p = yo + ((r & 3) + 8 * (r >> 2)) * DM; asm volatile("" : "+v"(p));
#pragma unroll
                for (int d0 = 0; d0 < 4; ++d0) p[d0 * 32] = (bf16)f2bf(o[d0][r] * ssq[r] * subg[d0 * 32 + r32]); }
        }
        asm volatile("s_waitcnt vmcnt(0) lgkmcnt(0)" ::: "memory");
    }
}
#undef KSWZ
#undef SBAR
}

__global__ void __launch_bounds__(NWAVES * 64, 2) hybrid_fwd(Args args) {
    extern __shared__ __attribute__((aligned(16))) unsigned char lds[];
    Frame F;
    F.lds = (LAS unsigned char*)lds;
    F.MISC = (volatile LAS unsigned*)(F.lds + MISC_OFF);
    F.tid = threadIdx.x; F.lane = F.tid & 63; F.wave = __builtin_amdgcn_readfirstlane(F.tid >> 6);
    F.G = gridDim.x; { const int bx = blockIdx.x; F.vcu = (F.G % 8 == 0) ? (bx % 8) * (F.G / 8) + bx / 8 : bx; }
    unsigned char* ws = args.ws;
    F.ctl = (gu32*)(ws + WS_CTL);
    for (int u = F.tid; u < (LDS_BYTES - LDSCTL_OFF) / 4; u += NWAVES * 64) ((LAS unsigned*)(F.lds + LDSCTL_OFF))[u] = 0u;
    __syncthreads();
#if MK_SPLIT
#define GRID_BAR() do { } while (0)
#else
    XcdBarrier bar = xcd_barrier_post((unsigned*)(F.ctl + CW_BAR), F.MISC + 8);
#define GRID_BAR() xcd_barrier(bar)
#endif
    const int lo = args.ph_lo, hi = args.ph_hi;
#ifndef PH_MASK
#define PH_MASK 0x1FF
#endif
#define IN(k) (lo <= (k) && (k) < hi)
#define PM(b) ((PH_MASK >> (b)) & 1)
#ifndef LM
#define LM 15
#endif
#ifndef PROBE_DUP
#define PROBE_DUP 0
#endif
#define DUP(b) ((PROBE_DUP >> (b)) & 1)
#ifndef PROBE_XBAR
#define PROBE_XBAR 0
#endif
#define SEAM(k, DI) do { if ((k) + 1 < hi) { seam_steal(F, args, bar, (DI)); for (int xb_ = 0; xb_ < PROBE_XBAR; ++xb_) GRID_BAR(); } } while (0)

    bf16* const XN = (bf16*)(ws + WS_XN); bf16* const Z = (bf16*)(ws + WS_Z); bf16* const YC = (bf16*)(ws + WS_YC); bf16* const HB = (bf16*)(ws + WS_HB);
    float* const OS = (float*)(ws + WS_OS); const float* const rope = (const float*)(ws + WS_ROPE);
    const float* const x_in = args.in[0]; float* const out = args.out;

    bf16* const XB = XN; float* const SS = (float*)(ws + WS_SS);
    if (PM(8) && IN(0)) { p0_prologue(F, args); xprep_phase(F, x_in, XB, SS); if (DUP(8)) { p0_prologue(F, args); xprep_phase(F, x_in, XB, SS); } SEAM(0, 0); }

#define FRESH() do { int t_ = threadIdx.x; asm volatile("" : "+v"(t_)); F.tid = t_; F.lane = t_ & 63; F.wave = __builtin_amdgcn_readfirstlane(t_ >> 6); } while (0)
    for (int l = 0; l < NLAYER; ++l) {
        const int pb = 1 + 5 * l;
        const float* xcur = (l == 0) ? x_in : out;
        const LAS float* rstab = (const LAS float*)(F.lds + RSTAB_OFF);
        if (PM(0) && IN(pb + 0)) { FRESH();
            pg8::Gemm g{XB, (const bf16*)(ws + WS_WIN) + (size_t)l * DIN * DM, M, DIN, DM}; pg8::StaticOrder S; S.init(M, DIN, F.G, (int)blockIdx.x);
            { pg8::Unit u0; S.next(0, u0); rs_table(F, SS, u0.pm); }
            pg8::EpiZ E{Z, DIN, rstab, (float*)(ws + WS_SV), args.in[13] + l * 64, args.in[14] + l * 64, rope, QSCALE, SEQ - 1, 13, (bf16*)(ws + WS_QH), (bf16*)(ws + WS_KH), (bf16*)(ws + WS_VH)};
            pg8::gemm_phase<pg8::EpiZ, pg8::StaticOrder, true, true>(F.lds + RING_OFF, g, S, E);
            if (DUP(0)) pg8::gemm_phase<pg8::EpiZ, pg8::StaticOrder, true, true>(F.lds + RING_OFF, g, S, E);
            SEAM(pb + 0, 0);
        }
        if (PM(2) && IN(pb + 1)) { FRESH();
            float s1 = 0.f, s2 = 0.f;
            for (int i = 0; i < 64; ++i) { s1 += args.in[15][l * 64 + i] * args.in[16][l * 64 + i]; s2 += args.in[17][l * 64 + i] * args.in[18][l * 64 + i]; }
            const float lam_init = (l == 0) ? 0.2f : 0.35550907f;
            const float lam = expf(s1) - expf(s2) + lam_init;
            float gqm = 0.f, gkm = 0.f;
            for (int i = 0; i < 64; ++i) { gqm = fmaxf(gqm, fabsf(args.in[13][l * 64 + i])); gkm = fmaxf(gkm, fabsf(args.in[14][l * 64 + i])); }
            const bool fastsm = (64.0f * gqm * gkm * QSCALE * 1.02f) < 40.0f;
#ifndef ATT_ABL
#define ATT_ABL 0
#endif
            if (DUP(2)) for (int U = F.vcu; U < BATCH * 8 * (SEQ / 256); U += F.G) {
                const int xg = (U % 256) / 32, i = U / 256, qb = U % 32, bh = xg * 2 + i;
                att::attn_unit<ATT_ABL>(bh >> 3, bh & 7, qb, (const bf16*)(ws + WS_QH), (const bf16*)(ws + WS_KH), (const bf16*)(ws + WS_VH), HB, (float*)(ws + WS_HB + 256 * MiB), args.in[19] + l * 128, lam, 1.0f - lam_init, (char*)lds + RING_OFF, fastsm);
            }
            for (int U = F.vcu; U < BATCH * 8 * (SEQ / 256); U += F.G) {
                const int xg = (U % 256) / 32, i = U / 256, qb = U % 32, bh = xg * 2 + i;
                att::attn_unit<0>(bh >> 3, bh & 7, qb, (const bf16*)(ws + WS_QH), (const bf16*)(ws + WS_KH), (const bf16*)(ws + WS_VH), YC, OS, args.in[19] + l * 128, lam, 1.0f - lam_init, (char*)lds + RING_OFF, fastsm);
            }
        }
        if (PM(1) && IN(pb + 1)) { FRESH();
            for (int rep = 0; rep < 1 + DUP(1); ++rep) { FRESH();
            if (LM & 2) for (int u = F.vcu; u < (M / 128) * 4; u += F.G) gmlp_unit(F, Z, YC, (const float*)(ws + WS_SV), (const bf16*)(ws + WS_GWS) + (size_t)l * 8 * 128 * 128, args.in[6] + l * 8 * 128, args.in[3] + l * GW, args.in[4] + l * GW, u, (char*)lds);
            FRESH();
            if (LM & 4) for (int u = F.vcu; u < M / 32; u += F.G) conv_unit(F, Z, YC, args.in[7] + (size_t)l * 31 * GW, args.in[8] + l * GW, args.in[9] + l * GW, args.in[10] + l * GW, u);
            FRESH();
            if (LM & 8) for (int u = F.vcu; u < (M / 64) * 4; u += F.G) pool_unit(F, Z, YC, (const bf16*)(ws + WS_PWT) + (size_t)l * 4 * 65536, args.in[12] + l * GW, u);
            }
            SEAM(pb + 1, cv_deadline(l, 1));
        }
        if (PM(3) && IN(pb + 2)) { FRESH();
            pg8::Gemm g{YC, (const bf16*)(ws + WS_WOUT) + (size_t)l * DM * DM, M, DM, DM}; pg8::StaticOrder S; S.init(M, DM, F.G, (int)blockIdx.x);
            if (l == 0) { typedef pg8::EpiRes<false, false> E_t; E_t E{x_in, nullptr, DM, XB, SS};
                if (DUP(3)) { E_t E2{x_in, nullptr, DM, HB, OS}; pg8::gemm_phase<E_t, pg8::StaticOrder, true, true>(F.lds + RING_OFF, g, S, E2); }
                pg8::gemm_phase<E_t, pg8::StaticOrder, true, true>(F.lds + RING_OFF, g, S, E); }
            else { typedef pg8::EpiRes<true, false> E_t; E_t E{XB, nullptr, DM, XB, SS};
                if (DUP(3)) { E_t E2{XB, nullptr, DM, HB, OS}; pg8::gemm_phase<E_t, pg8::StaticOrder, true, true>(F.lds + RING_OFF, g, S, E2); }
                pg8::gemm_phase<E_t, pg8::StaticOrder, true, true>(F.lds + RING_OFF, g, S, E); }
            SEAM(pb + 2, cv_deadline(l, 2));
        }
        if (PM(4) && IN(pb + 3)) { FRESH();
            pg8::Gemm g{XB, (const bf16*)(ws + WS_WUP) + (size_t)l * DFF * DM, M, DFF, DM}; pg8::StaticOrder S; S.init(M, DFF, F.G, (int)blockIdx.x);
            { pg8::Unit u0; S.next(0, u0); rs_table(F, SS, u0.pm); }
            pg8::EpiRelu2 E{HB, DFF, rstab};
#ifdef PROBE_SPLIT_UP
            { pg8::StaticOrder S1 = S; S1.i1 = 8; pg8::gemm_phase<pg8::EpiRelu2, pg8::StaticOrder, true, true>(F.lds + RING_OFF, g, S1, E); GRID_BAR();
              pg8::StaticOrder S2 = S; S2.i0 = 8; pg8::gemm_phase<pg8::EpiRelu2, pg8::StaticOrder, true, true>(F.lds + RING_OFF, g, S2, E); }
#else
            pg8::gemm_phase<pg8::EpiRelu2, pg8::StaticOrder, true, true>(F.lds + RING_OFF, g, S, E);
#endif
            if (DUP(4)) { if (DUP(10)) { pg8::EpiRelu2T<true> E2{(bf16*)Z, DFF, rstab}; pg8::gemm_phase<pg8::EpiRelu2T<true>, pg8::StaticOrder, true, true>(F.lds + RING_OFF, g, S, E2); }
                          else pg8::gemm_phase<pg8::EpiRelu2, pg8::StaticOrder, true, true>(F.lds + RING_OFF, g, S, E); }
            SEAM(pb + 3, cv_deadline(l, 3));
        }
        if (PM(5) && IN(pb + 4)) { FRESH();
            pg8::Gemm g{HB, (const bf16*)(ws + WS_WDN) + (size_t)l * DM * DFF, M, DM, DFF}; pg8::StaticOrder S; S.init(M, DM, F.G, (int)blockIdx.x);
            if (l + 1 < NLAYER) { typedef pg8::EpiRes<true, false> E_t; E_t E{XB, nullptr, DM, XB, SS};
                if (DUP(5)) { E_t E2{XB, nullptr, DM, YC, OS}; pg8::gemm_phase<E_t, pg8::StaticOrder, true, true>(F.lds + RING_OFF, g, S, E2); }
                pg8::gemm_phase<E_t, pg8::StaticOrder, true, true>(F.lds + RING_OFF, g, S, E); }
            else { typedef pg8::EpiRes<true, true> E_t; E_t E{XB, out, DM, nullptr, nullptr};
                if (DUP(5)) { E_t E2{XB, (float*)Z, DM, nullptr, nullptr}; pg8::gemm_phase<E_t, pg8::StaticOrder, true, true>(F.lds + RING_OFF, g, S, E2); }
                pg8::gemm_phase<E_t, pg8::StaticOrder, true, true>(F.lds + RING_OFF, g, S, E); }
            SEAM(pb + 4, cv_deadline(l + 1, 0));
        }
    }
#ifdef DIAG_STEAL
    if (blockIdx.x == 0 && threadIdx.x == 0) { asm volatile("s_waitcnt vmcnt(0)" ::: "memory"); const unsigned cnt = xb_ld((unsigned*)(F.ctl + CW_Q + 1024)); out[0] = 1000.0f * (float)cnt / (float)CV_TOTAL; }
#endif
#undef IN
#undef SEAM
}

constexpr int N_PHASES = 1 + 5 * NLAYER;
extern "C" void kernel_launch(void* const* d_in, const int* in_sizes, int n_in, void* d_out, int out_size, void* d_ws, size_t ws_size, hipStream_t stream) {
    static int grid = 0;
    if (grid == 0) {
        if (n_in != 24 || in_sizes[0] != M * DM || out_size != M * DM || ws_size < WS_END) { fprintf(stderr, "kernel_launch: unexpected shapes (n_in %d, in0 %d, out %d, ws %zu; need ws >= %zu); nothing launched\n", n_in, n_in > 0 ? in_sizes[0] : -1, out_size, ws_size, (size_t)WS_END); grid = -1; return; }
        int dev = 0, cus = 0, per_cu = 0;
        if (hipGetDevice(&dev) != hipSuccess || hipDeviceGetAttribute(&cus, hipDeviceAttributeMultiprocessorCount, dev) != hipSuccess) { fprintf(stderr, "kernel_launch: device query failed\n"); grid = -1; return; }
        if (hipFuncSetAttribute((const void*)hybrid_fwd, hipFuncAttributeMaxDynamicSharedMemorySize, LDS_BYTES) != hipSuccess) { fprintf(stderr, "kernel_launch: hipFuncSetAttribute failed\n"); grid = -1; return; }
        if (hipOccupancyMaxActiveBlocksPerMultiprocessor(&per_cu, (const void*)hybrid_fwd, NWAVES * 64, LDS_BYTES) != hipSuccess || per_cu < 1)
            fprintf(stderr, "kernel_launch: note: occupancy query reports %d workgroups per CU\n", per_cu);
        (void)hipGetLastError();
        grid = cus;
        if (grid != 256) { fprintf(stderr, "kernel_launch: built for a 256-CU device (one row panel per workgroup in every GEMM phase); found %d CUs; nothing launched\n", cus); grid = -1; return; }
    }
    if (grid < 0) return;
    if (hipMemsetAsync((char*)d_ws + WS_CTL, 0, CTL_ZERO_BYTES, stream) != hipSuccess) { fprintf(stderr, "kernel_launch: memset failed\n"); return; }
    Args a{};
    for (int i = 0; i < 24; ++i) a.in[i] = (const float*)d_in[i];
    a.out = (float*)d_out; a.ws = (unsigned char*)d_ws;
#if MK_SPLIT
    for (int p = 0; p < N_PHASES; ++p) { a.ph_lo = p; a.ph_hi = p + 1; hipLaunchKernelGGL(hybrid_fwd, dim3(grid), dim3(NWAVES * 64), LDS_BYTES, stream, a); }
#else
    a.ph_lo = 0; a.ph_hi = N_PHASES; hipLaunchKernelGGL(hybrid_fwd, dim3(grid), dim3(NWAVES * 64), LDS_BYTES, stream, a);
#endif
    const hipError_t le = hipPeekAtLastError();
    if (le != hipSuccess) fprintf(stderr, "kernel_launch: launch failed: %s\n", hipGetErrorName(le));
}
```

```cpp
#include <hip/hip_runtime.h>
#include <cstdio>
#include <cstdint>
#include <type_traits>
namespace pg8 {
#define PG8_LAS __attribute__((address_space(3)))
typedef unsigned short bf16_t;
typedef short bf16x8 __attribute__((ext_vector_type(8)));
typedef float f32x4 __attribute__((ext_vector_type(4)));
typedef unsigned u32x4 __attribute__((ext_vector_type(4)));
constexpr int BM = 256, BK = 64, HALF = 128, HTB = HALF * BK * 2  , STAGE_BYTES = 8 * HTB, NXCD = 8, WGM = 8;

__host__ __device__ __forceinline__ int lds_byte(int r, int c) { const int st = (r >> 4) * 2 + (c >> 5), rr = r & 15, cc = c & 31, ob = rr * 64 + cc * 2; return st * 1024 + (ob ^ (((ob >> 9) & 1) << 5)); }
__host__ __device__ __forceinline__ void stage_rc(int b, int& R, int& C) { const int st = b / 1024, sb = b % 1024, swz = sb ^ (((sb >> 9) & 1) << 5); R = (st >> 1) * 16 + swz / 64; C = (st & 1) * 32 + (swz % 64) / 2; }
__host__ __device__ __forceinline__ int perm32(int rho) { const int n = rho >> 4, i = rho & 15; return 8 * (i >> 2) + 4 * n + (i & 3); }

struct Unit { int pm, pn; };
struct Gemm { const bf16_t* A; const bf16_t* Bt; int M, N, K; };

struct StaticOrder {
    int nM, nN, nwg, G, c, i0 = 0, i1 = 1 << 30;
    __host__ __device__ __forceinline__ void init(int M, int N, int G_, int c_) { nM = M / BM; nN = N / BM; nwg = nM * nN; G = G_; c = c_; }
    __host__ __device__ __forceinline__ bool next(int i_, Unit& u) const {
        const int i = i_ + i0; if (i >= i1) return false;
        const long L = (long)i * G + c; if (L >= nwg) return false;
        int wgid = (int)L; { const int q = nwg / NXCD, r = nwg % NXCD, xcd = wgid % NXCD, off = wgid / NXCD; wgid = (xcd < r ? xcd * (q + 1) : r * (q + 1) + (xcd - r) * q) + off; }
        const int nig = WGM * nN, gid = wgid / nig, fm = gid * WGM, gsz = (nM - fm) < WGM ? (nM - fm) : WGM;
        u.pm = fm + ((wgid % nig) % gsz); u.pn = (wgid % nig) / gsz; return true;
    }
    __device__ __forceinline__ void a_ready(const Unit&) const {}
    __device__ __forceinline__ void done(const Unit&) const {}
};

__device__ __forceinline__ unsigned cvt_pk_bf16(float lo, float hi) { unsigned r; asm volatile("v_cvt_pk_bf16_f32 %0, %1, %2" : "=v"(r) : "v"(lo), "v"(hi)); return r; }
typedef float f32x2 __attribute__((ext_vector_type(2)));
__device__ __forceinline__ f32x2 gelu_pk(f32x2 v) {
    const f32x2 av = __builtin_elementwise_abs(v), d = av * 0.2316418882f + 1.0f;
    f32x2 t; t.x = __builtin_amdgcn_rcpf(d.x); t.y = __builtin_amdgcn_rcpf(d.y);
    f32x2 q = t * 0.5307027145f + (-0.7265760135f); q = q * t + 0.7107068705f; q = q * t + (-0.142248368f); q = q * t + 0.127414796f; q = q * t;
    const f32x2 s = (v * v) * (-0.72134752044f);
    f32x2 e; e.x = __builtin_amdgcn_exp2f(s.x); e.y = __builtin_amdgcn_exp2f(s.y);
    const f32x2 m = v * (q * e), r = v - m;
    f32x2 o; o.x = v.x < 0.f ? m.x : r.x; o.y = v.y < 0.f ? m.y : r.y; return o;
}

template <int ACT  > struct EpiBf16 {
    static constexpr bool PERM = true, AFTER_DRAIN = false; static_assert(ACT == 0 || ACT == 1, "EpiBf16: ACT is 0 (none) or 1 (gelu_pk)");
    bf16_t* O; int ldc; const float* bias; int split_cols; size_t split_stride; float scale0;
    __device__ __forceinline__ void operator()(const f32x4 (&acc)[2][2][4][2], const Unit& u, int wr, int wc, int fr, int fq) const {
        const int row0 = u.pm * BM + wr * 64 + fr; int colt = u.pn * BM; bf16_t* base = O;
        float sc = 1.f; if (split_cols) { const int t = colt / split_cols; base += (size_t)t * split_stride; colt -= t * split_cols; if (t == 0) sc = scale0; }
        const int col0 = colt + wc * 32 + 8 * fq, bcol0 = u.pn * BM + wc * 32 + 8 * fq;
        f32x4 bv[2][2];
#pragma unroll
        for (int bj = 0; bj < 2; ++bj)
#pragma unroll
            for (int n = 0; n < 2; ++n) bv[bj][n] = bias ? *(const f32x4*)(bias + bcol0 + bj * HALF + 4 * n) : (f32x4){0.f, 0.f, 0.f, 0.f};
#pragma unroll
        for (int ai = 0; ai < 2; ++ai)
#pragma unroll
            for (int m = 0; m < 4; ++m) { bf16_t* rowp = base + (size_t)(row0 + ai * HALF + m * 16) * ldc + col0;
#pragma unroll
                for (int bj = 0; bj < 2; ++bj) { f32x4 v0 = acc[ai][bj][m][0] + bv[bj][0], v1 = acc[ai][bj][m][1] + bv[bj][1];
                    if (ACT == 1) { f32x2 a = gelu_pk((f32x2){v0[0], v0[1]}), b = gelu_pk((f32x2){v0[2], v0[3]}), c = gelu_pk((f32x2){v1[0], v1[1]}), d = gelu_pk((f32x2){v1[2], v1[3]});
                        v0 = (f32x4){a.x, a.y, b.x, b.y}; v1 = (f32x4){c.x, c.y, d.x, d.y}; }
                    v0 = v0 * sc; v1 = v1 * sc; u32x4 w; w.x = cvt_pk_bf16(v0[0], v0[1]); w.y = cvt_pk_bf16(v0[2], v0[3]); w.z = cvt_pk_bf16(v1[0], v1[1]); w.w = cvt_pk_bf16(v1[2], v1[3]);
                    *(u32x4*)(rowp + bj * HALF) = w; } }
    }
};

struct EpiZ {
    static constexpr bool PERM = true, AFTER_DRAIN = false;
    bf16_t* O; int ldc; const PG8_LAS float* rs; float* sv; const float* qg; const float* kg; const float* rope; float qscale; int seqmask, seqshift; bf16_t* qh; bf16_t* kh; bf16_t* vh;
    __device__ __forceinline__ void operator()(const f32x4 (&acc)[2][2][4][2], const Unit& u, int wr, int wc, int fr, int fq) const {
        const int pn = u.pn, row0 = u.pm * BM + wr * 64 + fr;
        if (pn < 8) {
            const int col0 = pn * BM + wc * 32 + 8 * fq; const bool st = pn >= 4;
#pragma unroll
            for (int ai = 0; ai < 2; ++ai)
#pragma unroll
                for (int m = 0; m < 4; ++m) { const int row = row0 + ai * HALF + m * 16; bf16_t* rowp = O + (size_t)row * ldc + col0; const float rsv = rs[ai * HALF + wr * 64 + m * 16 + fr]; float s1 = 0.f, s2 = 0.f;
#pragma unroll
                    for (int bj = 0; bj < 2; ++bj) { f32x4 v0 = acc[ai][bj][m][0] * rsv, v1 = acc[ai][bj][m][1] * rsv;
                        { f32x2 a = gelu_pk((f32x2){v0[0], v0[1]}), b = gelu_pk((f32x2){v0[2], v0[3]}), c = gelu_pk((f32x2){v1[0], v1[1]}), d = gelu_pk((f32x2){v1[2], v1[3]});
                          v0 = (f32x4){a.x, a.y, b.x, b.y}; v1 = (f32x4){c.x, c.y, d.x, d.y}; }
                        s1 += ((v0[0] + v0[1]) + (v0[2] + v0[3])) + ((v1[0] + v1[1]) + (v1[2] + v1[3]));
                        s2 += ((v0[0] * v0[0] + v0[1] * v0[1]) + (v0[2] * v0[2] + v0[3] * v0[3])) + ((v1[0] * v1[0] + v1[1] * v1[1]) + (v1[2] * v1[2] + v1[3] * v1[3]));
                        u32x4 w; w.x = cvt_pk_bf16(v0[0], v0[1]); w.y = cvt_pk_bf16(v0[2], v0[3]); w.z = cvt_pk_bf16(v1[0], v1[1]); w.w = cvt_pk_bf16(v1[2], v1[3]);
                        *(u32x4*)(rowp + bj * HALF) = w; }
                    if (st) { s1 += __shfl_xor(s1, 16); s2 += __shfl_xor(s2, 16); s1 += __shfl_xor(s1, 32); s2 += __shfl_xor(s2, 32);
                        if (fq == 0) *(f32x2*)(sv + ((size_t)row * 16 + (pn - 4) * 4 + wc) * 2) = (f32x2){s1, s2}; } }
        } else if (pn < 16) {
            const int col0 = 2048 + (pn - 8) * HALF + wc * 32 + 8 * fq;
#pragma unroll
            for (int ai = 0; ai < 2; ++ai)
#pragma unroll
                for (int m = 0; m < 4; ++m) { bf16_t* rowp = O + (size_t)(row0 + ai * HALF + m * 16) * ldc + col0; const float rsv = rs[ai * HALF + wr * 64 + m * 16 + fr], nrs = -1.4426950408889634f * rsv;
                    float h[8];
#pragma unroll
                    for (int n = 0; n < 2; ++n)
#pragma unroll
                        for (int e = 0; e < 4; ++e) h[n * 4 + e] = acc[ai][0][m][n][e] * rsv * __builtin_amdgcn_rcpf(1.0f + __builtin_amdgcn_exp2f(acc[ai][1][m][n][e] * nrs));
                    u32x4 w; w.x = cvt_pk_bf16(h[0], h[1]); w.y = cvt_pk_bf16(h[2], h[3]); w.z = cvt_pk_bf16(h[4], h[5]); w.w = cvt_pk_bf16(h[6], h[7]);
                    *(u32x4*)rowp = w; }
        } else if (pn < 20) {
            const int col0 = pn * BM + wc * 32 + 8 * fq;
#pragma unroll
            for (int ai = 0; ai < 2; ++ai)
#pragma unroll
                for (int m = 0; m < 4; ++m) { bf16_t* rowp = O + (size_t)(row0 + ai * HALF + m * 16) * ldc + col0; const float rsv = rs[ai * HALF + wr * 64 + m * 16 + fr];
#pragma unroll
                    for (int bj = 0; bj < 2; ++bj) { const f32x4 v0 = acc[ai][bj][m][0] * rsv, v1 = acc[ai][bj][m][1] * rsv;
                        u32x4 w; w.x = cvt_pk_bf16(v0[0], v0[1]); w.y = cvt_pk_bf16(v0[2], v0[3]); w.z = cvt_pk_bf16(v1[0], v1[1]); w.w = cvt_pk_bf16(v1[2], v1[3]);
                        *(u32x4*)(rowp + bj * HALF) = w; } }
        } else if (pn >= 28) {
#pragma unroll
            for (int ai = 0; ai < 2; ++ai)
#pragma unroll
                for (int m = 0; m < 4; ++m) { const int row = row0 + ai * HALF + m * 16, b = row >> seqshift, t = row & seqmask; const float rsv = rs[ai * HALF + wr * 64 + m * 16 + fr];
#pragma unroll
                    for (int bj = 0; bj < 2; ++bj) { const f32x4 v0 = acc[ai][bj][m][0] * rsv, v1 = acc[ai][bj][m][1] * rsv;
                        u32x4 w; w.x = cvt_pk_bf16(v0[0], v0[1]); w.y = cvt_pk_bf16(v0[2], v0[3]); w.z = cvt_pk_bf16(v1[0], v1[1]); w.w = cvt_pk_bf16(v1[2], v1[3]);
                        *(u32x4*)(vh + ((size_t)((b * 8 + (pn - 28) * 2 + bj)) << seqshift | (size_t)t) * 128 + wc * 32 + 8 * fq) = w; } }
        } else {
            const bool isq = pn < 24; const int hc = (pn - (isq ? 20 : 24)) * 4 + wc; bf16_t* const dst = isq ? qh : kh;
            const float* gp = isq ? qg : kg; const float sc = isq ? qscale : 1.0f;
            f32x4 g[2][2];
#pragma unroll
            for (int n = 0; n < 2; ++n) { g[0][n] = *(const f32x4*)(gp + (fq < 2 ? 4 * fq + 8 * n : 8 * fq + 4 * n)) * sc; g[1][n] = *(const f32x4*)(gp + 32 + 8 * fq + 4 * n) * sc; }
#pragma unroll
            for (int ai = 0; ai < 2; ++ai)
#pragma unroll
                for (int m = 0; m < 4; ++m) { const int row = row0 + ai * HALF + m * 16; bf16_t* rowp = dst + (((size_t)((row >> seqshift) * 16 + hc)) << seqshift | (size_t)(row & seqmask)) * 64 + 8 * fq; const float rsv = rs[ai * HALF + wr * 64 + m * 16 + fr];
                    f32x4 v[2][2]; float s = 0.f;
#pragma unroll
                    for (int bj = 0; bj < 2; ++bj)
#pragma unroll
                        for (int n = 0; n < 2; ++n) { v[bj][n] = acc[ai][bj][m][n] * rsv; s += (v[bj][n][0] * v[bj][n][0] + v[bj][n][1] * v[bj][n][1]) + (v[bj][n][2] * v[bj][n][2] + v[bj][n][3] * v[bj][n][3]); }
                    s += __shfl_xor(s, 16); s += __shfl_xor(s, 32);
                    const float rn = 1.0f / sqrtf(s * (1.f / 64.f) + 1e-6f);
#pragma unroll
                    for (int bj = 0; bj < 2; ++bj)
#pragma unroll
                        for (int n = 0; n < 2; ++n) v[bj][n] = v[bj][n] * rn * g[bj][n];
                    if (fq < 2) {
                        const float* rp = rope + (size_t)(row & seqmask) * 16 + fq * 8; const f32x4 cs0 = *(const f32x4*)rp, cs1 = *(const f32x4*)(rp + 4);
                        const f32x4 x1 = v[0][0], x2 = v[0][1]; const f32x4 cc = (f32x4){cs0[0], cs0[2], cs1[0], cs1[2]}, sn = (f32x4){cs0[1], cs0[3], cs1[1], cs1[3]};
                        v[0][0] = x1 * cc - x2 * sn; v[0][1] = x2 * cc + x1 * sn; }
#pragma unroll
                    for (int bj = 0; bj < 2; ++bj) { u32x4 w; w.x = cvt_pk_bf16(v[bj][0][0], v[bj][0][1]); w.y = cvt_pk_bf16(v[bj][0][2], v[bj][0][3]); w.z = cvt_pk_bf16(v[bj][1][0], v[bj][1][1]); w.w = cvt_pk_bf16(v[bj][1][2], v[bj][1][3]);
                        *(u32x4*)(rowp + bj * 32) = w; } }
        }
    }
};
template <bool NOSTORE = false> struct EpiRelu2T {
    static constexpr bool PERM = true, AFTER_DRAIN = false;
    bf16_t* O; int ldc; const PG8_LAS float* rs;
    __device__ __forceinline__ void operator()(const f32x4 (&acc)[2][2][4][2], const Unit& u, int wr, int wc, int fr, int fq) const {
        const int row0 = u.pm * BM + wr * 64 + fr; const int col0 = u.pn * BM + wc * 32 + 8 * fq;
#pragma unroll
        for (int ai = 0; ai < 2; ++ai)
#pragma unroll
            for (int m = 0; m < 4; ++m) { bf16_t* rowp = O + (size_t)(row0 + ai * HALF + m * 16) * ldc + col0; const float rsv = rs[ai * HALF + wr * 64 + m * 16 + fr];
#pragma unroll
                for (int bj = 0; bj < 2; ++bj) { f32x4 v0 = acc[ai][bj][m][0] * rsv, v1 = acc[ai][bj][m][1] * rsv;
                    v0 = __builtin_elementwise_max(v0, (f32x4){0.f, 0.f, 0.f, 0.f}); v1 = __builtin_elementwise_max(v1, (f32x4){0.f, 0.f, 0.f, 0.f}); v0 = v0 * v0; v1 = v1 * v1;
                    u32x4 w; w.x = cvt_pk_bf16(v0[0], v0[1]); w.y = cvt_pk_bf16(v0[2], v0[3]); w.z = cvt_pk_bf16(v1[0], v1[1]); w.w = cvt_pk_bf16(v1[2], v1[3]);
                    if (!NOSTORE || w.x == 0x12345678u) *(u32x4*)(rowp + bj * HALF) = w; } }
    }
};
typedef EpiRelu2T<false> EpiRelu2;
template <bool BASE_BF16, bool OUT_F32> struct EpiRes {
    static constexpr bool PERM = true, AFTER_DRAIN = false;
    const void* base; float* out; int ldc; bf16_t* xb; float* ss;
    __device__ __forceinline__ void operator()(const f32x4 (&acc)[2][2][4][2], const Unit& u, int wr, int wc, int fr, int fq) const {
        const int row0 = u.pm * BM + wr * 64 + fr, col0 = u.pn * BM + wc * 32 + 8 * fq;
        if constexpr (BASE_BF16) {
            u32x4 bw[2][4][2];
#pragma unroll
            for (int ai = 0; ai < 2; ++ai)
#pragma unroll
                for (int m = 0; m < 4; ++m) { const size_t off = (size_t)(row0 + ai * HALF + m * 16) * ldc + col0;
#pragma unroll
                    for (int bj = 0; bj < 2; ++bj) bw[ai][m][bj] = __builtin_nontemporal_load((const u32x4*)((const bf16_t*)base + off + bj * HALF)); }
#pragma unroll
            for (int ai = 0; ai < 2; ++ai) {
                float sq[4];
#pragma unroll
                for (int m = 0; m < 4; ++m) { const size_t off = (size_t)(row0 + ai * HALF + m * 16) * ldc + col0; float s = 0.f;
#pragma unroll
                    for (int bj = 0; bj < 2; ++bj) { const u32x4 w0 = bw[ai][m][bj];
                        const f32x4 b0 = (f32x4){__builtin_bit_cast(float, w0.x << 16), __builtin_bit_cast(float, w0.x & 0xffff0000u), __builtin_bit_cast(float, w0.y << 16), __builtin_bit_cast(float, w0.y & 0xffff0000u)};
                        const f32x4 b1 = (f32x4){__builtin_bit_cast(float, w0.z << 16), __builtin_bit_cast(float, w0.z & 0xffff0000u), __builtin_bit_cast(float, w0.w << 16), __builtin_bit_cast(float, w0.w & 0xffff0000u)};
                        const f32x4 o0 = b0 + acc[ai][bj][m][0], o1 = b1 + acc[ai][bj][m][1];
                        if constexpr (OUT_F32) { *(f32x4*)(out + off + bj * HALF) = o0; *(f32x4*)(out + off + bj * HALF + 4) = o1; }
                        else { u32x4 w; w.x = cvt_pk_bf16(o0[0], o0[1]); w.y = cvt_pk_bf16(o0[2], o0[3]); w.z = cvt_pk_bf16(o1[0], o1[1]); w.w = cvt_pk_bf16(o1[2], o1[3]); *(u32x4*)(xb + off + bj * HALF) = w;
                            s += ((o0[0] * o0[0] + o0[1] * o0[1]) + (o0[2] * o0[2] + o0[3] * o0[3])) + ((o1[0] * o1[0] + o1[1] * o1[1]) + (o1[2] * o1[2] + o1[3] * o1[3])); } }
                    sq[m] = s; }
                if constexpr (!OUT_F32) {
#pragma unroll
                    for (int m = 0; m < 4; ++m) { float s = sq[m]; s += __shfl_xor(s, 16); s += __shfl_xor(s, 32); if (fq == 0) ss[(size_t)(row0 + ai * HALF + m * 16) * 64 + u.pn * 4 + wc] = s; } }
            }
        } else {
#pragma unroll
        for (int ai = 0; ai < 2; ++ai) {
            f32x4 bs[4][2][2];
#pragma unroll
            for (int m = 0; m < 4; ++m) { const size_t off = (size_t)(row0 + ai * HALF + m * 16) * ldc + col0;
#pragma unroll
                for (int bj = 0; bj < 2; ++bj) { bs[m][bj][0] = __builtin_nontemporal_load((const f32x4*)((const float*)base + off + bj * HALF)); bs[m][bj][1] = __builtin_nontemporal_load((const f32x4*)((const float*)base + off + bj * HALF + 4)); } }
            float sq[4];
#pragma unroll
            for (int m = 0; m < 4; ++m) { const size_t off = (size_t)(row0 + ai * HALF + m * 16) * ldc + col0; float s = 0.f;
#pragma unroll
                for (int bj = 0; bj < 2; ++bj) { const f32x4 o0 = bs[m][bj][0] + acc[ai][bj][m][0], o1 = bs[m][bj][1] + acc[ai][bj][m][1];
                    if constexpr (OUT_F32) { *(f32x4*)(out + off + bj * HALF) = o0; *(f32x4*)(out + off + bj * HALF + 4) = o1; }
                    else { u32x4 w; w.x = cvt_pk_bf16(o0[0], o0[1]); w.y = cvt_pk_bf16(o0[2], o0[3]); w.z = cvt_pk_bf16(o1[0], o1[1]); w.w = cvt_pk_bf16(o1[2], o1[3]); *(u32x4*)(xb + off + bj * HALF) = w;
                        s += ((o0[0] * o0[0] + o0[1] * o0[1]) + (o0[2] * o0[2] + o0[3] * o0[3])) + ((o1[0] * o1[0] + o1[1] * o1[1]) + (o1[2] * o1[2] + o1[3] * o1[3])); } }
                sq[m] = s; }
            if constexpr (!OUT_F32) {
#pragma unroll
                for (int m = 0; m < 4; ++m) { float s = sq[m]; s += __shfl_xor(s, 16); s += __shfl_xor(s, 32); if (fq == 0) ss[(size_t)(row0 + ai * HALF + m * 16) * 64 + u.pn * 4 + wc] = s; } }
            asm volatile("" ::: "memory");
        }
        }
    }
};
template <class Epi, class Sched, bool ALIGN_EPI = false, bool SP2 = false>
__device__ __forceinline__ void gemm_phase(PG8_LAS unsigned char* lds, const Gemm g, const Sched& S, const Epi& E) {
    int tid_ = threadIdx.x; asm volatile("" : "+v"(tid_));
    const int tid = tid_, wid = __builtin_amdgcn_readfirstlane(tid >> 6), lane = tid & 63, wr = wid >> 2, wc = wid & 3, fr = lane & 15, fq = lane >> 4;
    const int K = g.K, nt = K / BK;
    unsigned voffA[2], voffB[2];
#pragma unroll
    for (int i = 0; i < 2; ++i) { int R, C; stage_rc(tid * 16 + i * 8192, R, C); const int Rb = Epi::PERM ? ((R & ~31) + perm32(R & 31)) : R;
        voffA[i] = (unsigned)(R * K + C) * 2u; voffB[i] = (unsigned)(Rb * K + C) * 2u; }
    const size_t kstep = (size_t)(BK * 2);
    const size_t hstep = (size_t)HALF * K * 2;
    const size_t tstep = 2 * hstep;
    const unsigned ldsw = (unsigned)wid * 1024u;
    const int aoff = lds_byte(wr * 64 + fr, fq * 8), boff = lds_byte(wc * 32 + fr, fq * 8);
#define PG8_SA(b, h) (((b) * 2 + (h)) * HTB)
#define PG8_SB(b, h) ((4 + (b) * 2 + (h)) * HTB)
#define PG8_STAGE(bufoff, gbase, voff) do { _Pragma("unroll") for (int _i = 0; _i < 2; ++_i) \
        __builtin_amdgcn_global_load_lds((const unsigned*)((const char*)(gbase) + (voff)[_i]), (PG8_LAS unsigned*)(lds + (bufoff) + ldsw + _i * 8192), 16, 0, 0); } while (0)
#define PG8_LDA(dst, b, h) do { _Pragma("unroll") for (int m = 0; m < 4; ++m) _Pragma("unroll") for (int k = 0; k < 2; ++k) dst[m][k] = *(const PG8_LAS bf16x8*)(lds + PG8_SA(b, h) + aoff + m * 2048 + k * 1024); } while (0)
#define PG8_LDB(dst, b, h) do { _Pragma("unroll") for (int n = 0; n < 2; ++n) _Pragma("unroll") for (int k = 0; k < 2; ++k) dst[n][k] = *(const PG8_LAS bf16x8*)(lds + PG8_SB(b, h) + boff + n * 2048 + k * 1024); } while (0)
#define PG8_MMA(ai, bj, At, Bt) do { __builtin_amdgcn_s_setprio(PG8_PRIO_MMA); _Pragma("unroll") for (int m = 0; m < 4; ++m) _Pragma("unroll") for (int n = 0; n < 2; ++n) _Pragma("unroll") for (int k = 0; k < 2; ++k) \
        acc[ai][bj][m][n] = __builtin_amdgcn_mfma_f32_16x16x32_bf16(Bt[n][k], At[m][k], acc[ai][bj][m][n], 0, 0, 0); __builtin_amdgcn_s_setprio(PG8_PRIO_LOAD); } while (0)
#ifndef PG8_PRIO_MMA
#define PG8_PRIO_MMA 1
#define PG8_PRIO_LOAD 0
#endif
#define PG8_WAIT_V(n) asm volatile("s_waitcnt vmcnt(" #n ")" ::: "memory")
#define PG8_WAIT_L(n) asm volatile("s_waitcnt lgkmcnt(" #n ")" ::: "memory")
#define PG8_BAR __builtin_amdgcn_s_barrier()
#define PG8_SCHED __builtin_amdgcn_sched_barrier(0)
    Unit cur, nxt; int ui = 0;
    if (!S.next(0, cur)) return;
    f32x4 acc[2][2][4][2];
#pragma unroll
    for (int a = 0; a < 2; ++a)
#pragma unroll
        for (int b = 0; b < 2; ++b)
#pragma unroll
            for (int m = 0; m < 4; ++m)
#pragma unroll
                for (int n = 0; n < 2; ++n) acc[a][b][m][n] = (f32x4){0.f, 0.f, 0.f, 0.f};
    bf16x8 At[4][2], B0[2][2], B1[2][2];
    const char* cA = (const char*)g.A + (size_t)cur.pm * tstep; const char* cB = (const char*)g.Bt + (size_t)cur.pn * tstep;
    S.a_ready(cur);
    if constexpr (SP2) {
        PG8_STAGE(PG8_SB(0, 0), cB, voffB); PG8_STAGE(PG8_SB(0, 1), cB + hstep, voffB); PG8_STAGE(PG8_SA(0, 0), cA, voffA); PG8_STAGE(PG8_SA(0, 1), cA + hstep, voffA);
        if (wr == 1) PG8_BAR;
        PG8_WAIT_V(2); PG8_BAR;
        PG8_STAGE(PG8_SB(1, 0), cB + kstep, voffB); PG8_STAGE(PG8_SA(1, 0), cA + kstep, voffA); PG8_STAGE(PG8_SB(1, 1), cB + hstep + kstep, voffB);
        PG8_WAIT_V(6); PG8_BAR;
    } else {
        PG8_STAGE(PG8_SB(0, 0), cB, voffB); PG8_STAGE(PG8_SA(0, 0), cA, voffA); PG8_STAGE(PG8_SB(0, 1), cB + hstep, voffB); PG8_STAGE(PG8_SA(0, 1), cA + hstep, voffA);
        if (wr == 1) PG8_BAR;
        PG8_WAIT_V(4); PG8_BAR;
        PG8_STAGE(PG8_SB(1, 0), cB + kstep, voffB); PG8_STAGE(PG8_SA(1, 0), cA + kstep, voffA); PG8_STAGE(PG8_SB(1, 1), cB + hstep + kstep, voffB);
        PG8_WAIT_V(6); PG8_BAR;
    }
    for (;;) {
        const bool has_next = S.next(ui + 1, nxt);
        const char* nA = has_next ? (const char*)g.A + (size_t)nxt.pm * tstep : cA; const char* nB = has_next ? (const char*)g.Bt + (size_t)nxt.pn * tstep : cB;
        for (int t = 0; t < nt; t += 2) {
            const bool last = (t == nt - 2);
            const char* a1 = cA + (size_t)(t + 1) * kstep;
            const char* a2 = last ? nA : cA + (size_t)(t + 2) * kstep; const char* b2 = last ? nB : cB + (size_t)(t + 2) * kstep;
            const char* a3 = a2 + kstep; const char* b3 = b2 + kstep;
            if (last && has_next) S.a_ready(nxt);
            if constexpr (SP2) {
            PG8_LDB(B0, 0, 0); PG8_LDB(B1, 0, 1); PG8_SCHED; PG8_LDA(At, 0, 0); PG8_STAGE(PG8_SA(1, 1), a1 + hstep, voffA);
            PG8_WAIT_V(8); PG8_WAIT_L(0); PG8_BAR; PG8_MMA(0, 0, At, B0); PG8_MMA(0, 1, At, B1); PG8_BAR; PG8_SCHED;
            PG8_LDA(At, 0, 1); PG8_STAGE(PG8_SB(0, 0), b2, voffB); PG8_STAGE(PG8_SB(0, 1), b2 + hstep, voffB); PG8_STAGE(PG8_SA(0, 0), a2, voffA);
            PG8_WAIT_V(8); PG8_WAIT_L(0); PG8_BAR; PG8_MMA(1, 0, At, B0); PG8_MMA(1, 1, At, B1); PG8_BAR; PG8_SCHED;
            PG8_LDB(B0, 1, 0); PG8_LDB(B1, 1, 1); PG8_SCHED; PG8_LDA(At, 1, 0); PG8_STAGE(PG8_SA(0, 1), a2 + hstep, voffA);
            PG8_WAIT_V(8); PG8_WAIT_L(0); PG8_BAR; PG8_MMA(0, 0, At, B0); PG8_MMA(0, 1, At, B1); PG8_BAR; PG8_SCHED;
            PG8_LDA(At, 1, 1); PG8_STAGE(PG8_SB(1, 0), b3, voffB); PG8_STAGE(PG8_SB(1, 1), b3 + hstep, voffB); PG8_STAGE(PG8_SA(1, 0), a3, voffA);
            PG8_WAIT_V(8); PG8_WAIT_L(0); PG8_BAR; PG8_MMA(1, 0, At, B0); PG8_MMA(1, 1, At, B1); PG8_BAR; PG8_SCHED;
            } else {
            PG8_LDB(B0, 0, 0); PG8_SCHED; PG8_LDA(At, 0, 0); PG8_STAGE(PG8_SA(1, 1), a1 + hstep, voffA);
            PG8_WAIT_L(8); PG8_BAR; PG8_WAIT_L(0); PG8_MMA(0, 0, At, B0); PG8_BAR; PG8_SCHED;
            PG8_LDB(B1, 0, 1); PG8_STAGE(PG8_SB(0, 0), b2, voffB);
            PG8_BAR; PG8_WAIT_L(0); PG8_MMA(0, 1, At, B1); PG8_BAR;
            PG8_LDA(At, 0, 1); PG8_STAGE(PG8_SA(0, 0), a2, voffA);
            PG8_BAR; PG8_WAIT_L(0); PG8_MMA(1, 0, At, B0); PG8_BAR; PG8_SCHED;
            PG8_STAGE(PG8_SB(0, 1), b2 + hstep, voffB);
            PG8_WAIT_V(6); PG8_BAR; PG8_MMA(1, 1, At, B1); PG8_BAR;
            PG8_LDB(B0, 1, 0); PG8_SCHED; PG8_LDA(At, 1, 0); PG8_STAGE(PG8_SA(0, 1), a2 + hstep, voffA);
            PG8_WAIT_L(8); PG8_BAR; PG8_WAIT_L(0); PG8_MMA(0, 0, At, B0); PG8_BAR; PG8_SCHED;
            PG8_LDB(B1, 1, 1); PG8_STAGE(PG8_SB(1, 0), b3, voffB);
            PG8_BAR; PG8_WAIT_L(0); PG8_MMA(0, 1, At, B1); PG8_BAR;
            PG8_LDA(At, 1, 1); PG8_STAGE(PG8_SA(1, 0), a3, voffA);
            PG8_BAR; PG8_WAIT_L(0); PG8_MMA(1, 0, At, B0); PG8_BAR; PG8_SCHED;
            PG8_STAGE(PG8_SB(1, 1), b3 + hstep, voffB);
            PG8_WAIT_V(6); PG8_BAR; PG8_MMA(1, 1, At, B1); PG8_BAR;
            }
        }
        if constexpr (ALIGN_EPI) { if (wr == 0) PG8_BAR; }
        if constexpr (!Epi::AFTER_DRAIN) { E(acc, cur, wr, wc, fr, fq); S.done(cur); }
        if (!has_next) break;
#pragma unroll
        for (int a = 0; a < 2; ++a)
#pragma unroll
            for (int b = 0; b < 2; ++b)
#pragma unroll
                for (int m = 0; m < 4; ++m)
#pragma unroll
                    for (int n = 0; n < 2; ++n) acc[a][b][m][n] = (f32x4){0.f, 0.f, 0.f, 0.f};
        cur = nxt; cA = nA; cB = nB; ++ui;
        if constexpr (ALIGN_EPI) { if (wr == 1) PG8_BAR; }
    }
    PG8_WAIT_V(0);
    if constexpr (!ALIGN_EPI) { if (wr == 0) PG8_BAR; }
    PG8_BAR;
    if constexpr (Epi::AFTER_DRAIN) { E.fused(acc, cur, wr, wc, fr, fq, lds, wid, lane); S.done(cur); }
#undef PG8_SA
#undef PG8_SB
#undef PG8_STAGE
#undef PG8_LDA
#undef PG8_LDB
#undef PG8_MMA
#undef PG8_WAIT_V
#undef PG8_WAIT_L
#undef PG8_BAR
#undef PG8_SCHED
}
}

constexpr int NWAVES = 8;
constexpr int BATCH = 2, SEQ = 8192, DM = 4096, NLAYER = 2, GW = 1024, DIN = 8192, DFF = 16384;
constexpr int M = BATCH * SEQ;
constexpr int ZC_A = 0, ZC_B = 2048, ZC_C = 4096, ZC_Q = 5120, ZC_K = 6144, ZC_V = 7168;
constexpr int YC_A = 0, YC_B = 1024, YC_C = 2048, YC_D = 3072;
constexpr float QSCALE = 0.125f * 1.4426950408889634f;
#ifndef MK_SPLIT
#define MK_SPLIT 0
#endif

constexpr size_t MiB = 1u << 20;
constexpr size_t WS_CTL = 0, CTL_ZERO_BYTES = 64 * 1024;
constexpr size_t WS_ROPE = 1 * MiB;
constexpr size_t WS_PWT = 2 * MiB;
constexpr size_t WS_GWS = 3 * MiB;
constexpr size_t WS_SS = 4 * MiB;
constexpr size_t WS_SV = 8 * MiB;
constexpr size_t WS_WIN = 16 * MiB;
constexpr size_t WS_WOUT = 144 * MiB;
constexpr size_t WS_WUP = 208 * MiB;
constexpr size_t WS_WDN = 464 * MiB;
constexpr size_t WS_XN = 720 * MiB;
constexpr size_t WS_Z = 848 * MiB;
constexpr size_t WS_YC = 1104 * MiB;
constexpr size_t WS_HB = 1232 * MiB;
constexpr size_t WS_OS = 1744 * MiB;
constexpr size_t WS_QH = 1808 * MiB;
constexpr size_t WS_KH = 1840 * MiB;
constexpr size_t WS_VH = 1872 * MiB;
constexpr size_t WS_END = 1904 * MiB;
constexpr int CW_BAR = 1024;

constexpr int RING_OFF = 0, RING_BYTES = 131072;
constexpr int LDSCTL_OFF = RING_BYTES, MISC_OFF = LDSCTL_OFF + 320;
constexpr int RSTAB_OFF = RING_BYTES + 1024;
constexpr int LDS_BYTES = 147456;

#define GAS __attribute__((address_space(1)))
#define LAS __attribute__((address_space(3)))
typedef unsigned short bf16;
typedef unsigned v4u __attribute__((ext_vector_type(4)));
typedef float f32x4 __attribute__((ext_vector_type(4)));
typedef short bf16x8 __attribute__((ext_vector_type(8)));
typedef GAS unsigned gu32;
typedef GAS unsigned long long gu64;
#define RLX_AGENT __ATOMIC_RELAXED, __HIP_MEMORY_SCOPE_AGENT
#define LDS_WAIT() asm volatile("s_waitcnt lgkmcnt(0)" ::: "memory")
#define VM_WAIT() asm volatile("s_waitcnt vmcnt(0)" ::: "memory")
__device__ __forceinline__ unsigned long long rt() { return __builtin_amdgcn_s_memrealtime(); }
__device__ __forceinline__ unsigned f2bf(float f) { unsigned u = __builtin_bit_cast(unsigned, f); return (u + 0x7fffu + ((u >> 16) & 1u)) >> 16; }
__device__ __forceinline__ unsigned pk2(float lo, float hi) { return f2bf(lo) | (f2bf(hi) << 16); }

#define XB_TMO      128
#define XB_XCNT(j)  (256  + 64 * (j))
#define XB_XSUB(j)  (1280 + 64 * (j))
#define XB_XGEN(j)  (2304 + 64 * (j))
#define XB_TOP      3328
#define XB_TOPGEN   3392
#define XCD_BAR_WORDS 3456
#define XB_SPIN_CAP (1u << 18)

__device__ __forceinline__ unsigned xb_ld(unsigned* p)              { return __hip_atomic_load(p, __ATOMIC_RELAXED, __HIP_MEMORY_SCOPE_AGENT); }
__device__ __forceinline__ unsigned xb_add(unsigned* p, unsigned v) { return __hip_atomic_fetch_add(p, v, __ATOMIC_RELAXED, __HIP_MEMORY_SCOPE_AGENT); }
__device__ __forceinline__ unsigned xb_xcc_id() { return (unsigned)__builtin_amdgcn_s_getreg((3 << 11) | 20) & 0xFu; }
#define XB_SPIN(cond, bar) do { unsigned _sp = 0; while (cond) { __builtin_amdgcn_s_sleep(1); \
    if ((++_sp & 255u) == 0u) { if (xb_ld(&(bar)[XB_TMO])) break; if (_sp > XB_SPIN_CAP) { atomicAdd(&(bar)[XB_TMO], 1u); break; } } } } while (0)

struct XcdBarrier {
    unsigned* bar; unsigned x;
    volatile LAS unsigned* st;
};

__device__ __forceinline__ XcdBarrier xcd_barrier_post(unsigned* bar, volatile LAS unsigned* st) {
    XcdBarrier b; b.bar = bar; b.x = xb_xcc_id(); b.st = st;
    if (threadIdx.x == 0) (void)xb_add(&bar[XB_XCNT(b.x)], 1u);
    return b;
}
__device__ __forceinline__ void xcd_barrier_complete(unsigned* bar, unsigned x, unsigned& nloc, unsigned& nx) {
    const unsigned G = gridDim.x * gridDim.y * gridDim.z;
    unsigned sum, cnt, mine, sp = 0u;
    for (;;) {
        sum = 0u; cnt = 0u; mine = 0u;
#pragma unroll
        for (unsigned j = 0; j < 16; ++j) { const unsigned c = xb_ld(&bar[XB_XCNT(j)]); sum += c; cnt += (c > 0u) ? 1u : 0u; mine = (j == x) ? c : mine; }
        if (sum == G) break;
        __builtin_amdgcn_s_sleep(1);
        if ((++sp & 255u) == 0u) { if (xb_ld(&bar[XB_TMO])) break; if (sp > XB_SPIN_CAP) { atomicAdd(&bar[XB_TMO], 1u); break; } }
    }
    nloc = mine > 0u ? mine : 1u; nx = cnt > 0u ? cnt : 1u;
}

__device__ __forceinline__ void xcd_barrier_leader(const XcdBarrier& b) {
        unsigned* bar = b.bar;
        __builtin_amdgcn_s_waitcnt(0);
        unsigned nloc = b.st[0], nx = b.st[1];
        if (nloc == 0u) { xcd_barrier_complete(bar, b.x, nloc, nx); b.st[0] = nloc; b.st[1] = nx; }
        const unsigned old = xb_add(&bar[XB_XSUB(b.x)], 1u);
        const unsigned gen = old / nloc;
        if (old + 1u == (gen + 1u) * nloc) {
            __builtin_amdgcn_fence(__ATOMIC_RELEASE, "agent");
            asm volatile("s_waitcnt vmcnt(0)" ::: "memory");
            const unsigned og = xb_add(&bar[XB_TOP], 1u);
            const unsigned tg = og / nx;
            if (og + 1u == (tg + 1u) * nx) xb_add(&bar[XB_TOPGEN], 1u);
            else XB_SPIN(xb_ld(&bar[XB_TOPGEN]) == tg, bar);
            __builtin_amdgcn_fence(__ATOMIC_ACQUIRE, "agent");
            xb_add(&bar[XB_XGEN(b.x)], 1u);
            asm volatile("s_waitcnt vmcnt(0)" ::: "memory");
        } else {
            XB_SPIN(xb_ld(&bar[XB_XGEN(b.x)]) == gen, bar);
            __builtin_amdgcn_fence(__ATOMIC_ACQUIRE, "agent");
            asm volatile("s_waitcnt vmcnt(0)" ::: "memory");
        }
}
__device__ __forceinline__ void xcd_barrier(const XcdBarrier& b) {
    asm volatile("s_waitcnt vmcnt(0)" ::: "memory");
    __syncthreads();
    if (threadIdx.x == 0) xcd_barrier_leader(b);
    __syncthreads();
}

typedef unsigned u32x2 __attribute__((ext_vector_type(2)));
typedef float f32x2v __attribute__((ext_vector_type(2)));
struct Frame {
    LAS unsigned char* lds;
    volatile LAS unsigned* MISC;
    gu32* ctl;
    int tid, lane, wave;
    int vcu, G;
};
struct Args { const float* in[24]; float* out; unsigned char* ws; int ph_lo, ph_hi; };

__device__ __forceinline__ float wave_sum(float v) {
#pragma unroll
    for (int o = 1; o < 64; o <<= 1) v += __shfl_xor(v, o);
    return v;
}
__device__ __forceinline__ float bf_lo(unsigned w) { return __builtin_bit_cast(float, w << 16); }
__device__ __forceinline__ float bf_hi(unsigned w) { return __builtin_bit_cast(float, w & 0xffff0000u); }
__device__ __forceinline__ float sigmoidf_fast(float x) { return __builtin_amdgcn_rcpf(1.0f + __builtin_amdgcn_exp2f(-1.4426950408889634f * x)); }

__device__ __forceinline__ int zin_dest(int n) {
    if (n < 2048 || (n >= 4096 && n < 5120) || n >= 7168) return n;
    if (n < 4096) { const int j = n - 2048, half = j >> 10, c = j & 1023; return 2048 + 256 * (c >> 7) + 128 * half + (c & 127); }
    const int base = (n < 6144) ? 5120 : 6144, j = n - base, hc = j >> 6, d = j & 63;
    const int pos = (d < 16) ? ((d & 3) | ((d & 4) << 1) | ((d & 8) >> 1)) : d;
    return base + 256 * (hc >> 2) + 32 * (hc & 3) + (d < 32 ? pos : 128 + (d - 32));
}
template <bool PERMZ>
__device__ __forceinline__ void p0_transpose_item(const float* W, int K, int N, bf16* WT, LAS float* scr, int item, int lane, const float* gain = nullptr) {
    const int nblk = N / 32, kb = item / nblk, nb = item % nblk, k0 = 64 * kb, n0 = 32 * nb;
    const GAS float* Wg = (const GAS float*)W;
    const int c = lane & 7;
    f32x4 g0 = (f32x4){1.f, 1.f, 1.f, 1.f}, g1 = g0;
    if (gain) { g0 = *(const GAS f32x4*)(gain + k0 + 8 * c); g1 = *(const GAS f32x4*)(gain + k0 + 8 * c + 4); }
    float tv[32];
#pragma unroll
    for (int i = 0; i < 32; ++i) { const int kk = 2 * i + (lane >> 5); tv[i] = __builtin_nontemporal_load(Wg + (size_t)(k0 + kk) * N + n0 + (lane & 31)); }
#pragma unroll
    for (int i = 0; i < 32; ++i) { const int kk = 2 * i + (lane >> 5); scr[kk * 33 + (lane & 31)] = tv[i]; }
    LDS_WAIT(); asm volatile("" ::: "memory");
#pragma unroll
    for (int j = 0; j < 4; ++j) { const int n = (lane >> 3) + 8 * j; const LAS float* s = scr + (8 * c) * 33 + n;
        v4u o; o.x = pk2(s[0 * 33] * g0.x, s[1 * 33] * g0.y); o.y = pk2(s[2 * 33] * g0.z, s[3 * 33] * g0.w); o.z = pk2(s[4 * 33] * g1.x, s[5 * 33] * g1.y); o.w = pk2(s[6 * 33] * g1.z, s[7 * 33] * g1.w);
        const int dn = PERMZ ? zin_dest(n0 + n) : n0 + n;
        *(GAS v4u*)(WT + (size_t)dn * K + k0 + 8 * c) = o; }
    LDS_WAIT(); asm volatile("" ::: "memory");
}
template <bool PERMZ>
__device__ __forceinline__ void p0_transpose_pair(const float* W, int K, int N, bf16* WT, LAS float* scr, int item, int lane, const float* gain = nullptr) {
    const int nblk = N / 32, kb = item / nblk, nb = item % nblk, k0 = 64 * kb, n0 = 32 * nb;
    const GAS float* Wg = (const GAS float*)W;
    const int c = lane & 7;
    f32x4 g0 = (f32x4){1.f, 1.f, 1.f, 1.f}, g1 = g0;
    if (gain) { g0 = *(const GAS f32x4*)(gain + k0 + 8 * c); g1 = *(const GAS f32x4*)(gain + k0 + 8 * c + 4); }
    float tv[2][32];
#pragma unroll
    for (int h = 0; h < 2; ++h)
#pragma unroll
        for (int i = 0; i < 32; ++i) { const int kk = 2 * i + (lane >> 5); tv[h][i] = __builtin_nontemporal_load(Wg + (size_t)(k0 + kk) * N + n0 + 32 * h + (lane & 31)); }
#pragma unroll
    for (int h = 0; h < 2; ++h) {
#pragma unroll
        for (int i = 0; i < 32; ++i) { const int kk = 2 * i + (lane >> 5); scr[kk * 33 + (lane & 31)] = tv[h][i]; }
        LDS_WAIT(); asm volatile("" ::: "memory");
#pragma unroll
        for (int j = 0; j < 4; ++j) { const int n = (lane >> 3) + 8 * j; const LAS float* s = scr + (8 * c) * 33 + n;
            v4u o; o.x = pk2(s[0 * 33] * g0.x, s[1 * 33] * g0.y); o.y = pk2(s[2 * 33] * g0.z, s[3 * 33] * g0.w); o.z = pk2(s[4 * 33] * g1.x, s[5 * 33] * g1.y); o.w = pk2(s[6 * 33] * g1.z, s[7 * 33] * g1.w);
            const int dn = PERMZ ? zin_dest(n0 + 32 * h + n) : n0 + 32 * h + n;
            __builtin_nontemporal_store(o, (GAS v4u*)(WT + (size_t)dn * K + k0 + 8 * c)); }
        LDS_WAIT(); asm volatile("" ::: "memory");
    }
}
constexpr int CV_IN = (DM / 64) * (DIN / 32), CV_OUT = (DM / 64) * (DM / 32), CV_UP = (DM / 64) * (DFF / 32), CV_DN = (DFF / 64) * (DM / 32), CV_L = CV_IN + CV_OUT + CV_UP + CV_DN;
constexpr int CV_TOTAL = NLAYER * CV_L - CV_IN, CV_CHUNK = 16, CV_NCHUNK = CV_TOTAL / CV_CHUNK;
constexpr unsigned CV_EXH = 0xFFFFFFFFu;
constexpr int CW_Q = 8192;
constexpr int QST_OFF = LDSCTL_OFF + 4096;
static_assert(CV_TOTAL % (CV_CHUNK * 256) == 0 && CV_IN % (CV_CHUNK * 256) == 0 && CV_OUT % (CV_CHUNK * 256) == 0 && CV_UP % (CV_CHUNK * 256) == 0, "chunking");
__device__ __forceinline__ constexpr int cv_deadline(int l, int which) { return l * CV_L + (which == 0 ? CV_IN : which == 1 ? CV_IN + CV_OUT : which == 2 ? CV_IN + CV_OUT + CV_UP : CV_L) - CV_IN; }
__device__ __forceinline__ void cv_item(const Args& a, LAS float* scr, int I, int lane) {
    unsigned char* ws = a.ws;
    const int J = I + CV_IN, l = (J >= CV_L) ? 1 : 0; int r = J - l * CV_L;
    if (r < CV_IN) { p0_transpose_pair<true>(a.in[2] + (size_t)l * DM * DIN, DM, DIN, (bf16*)(ws + WS_WIN) + (size_t)l * DIN * DM, scr, r, lane, a.in[1] + (size_t)l * DM); return; } r -= CV_IN;
    if (r < CV_OUT) { p0_transpose_pair<false>(a.in[20] + (size_t)l * DM * DM, DM, DM, (bf16*)(ws + WS_WOUT) + (size_t)l * DM * DM, scr, r, lane); return; } r -= CV_OUT;
    if (r < CV_UP) { p0_transpose_pair<false>(a.in[22] + (size_t)l * DM * DFF, DM, DFF, (bf16*)(ws + WS_WUP) + (size_t)l * DFF * DM, scr, r, lane, a.in[21] + (size_t)l * DM); return; } r -= CV_UP;
    p0_transpose_pair<false>(a.in[23] + (size_t)l * DFF * DM, DFF, DM, (bf16*)(ws + WS_WDN) + (size_t)l * DM * DFF, scr, r, lane);
}
#ifndef NO_WAIT_STEAL
#define NO_WAIT_STEAL 0
#endif
__device__ __forceinline__ void seam_steal(const Frame& F, const Args& a, const XcdBarrier& b, int DI) {
    volatile LAS unsigned* QS = (volatile LAS unsigned*)(F.lds + QST_OFF);
    LAS float* scr = (LAS float*)(F.lds + RING_OFF + F.wave * 16384);
    const unsigned cu = blockIdx.x, DJ = (unsigned)DI / 256u, TJ = (unsigned)CV_TOTAL / 256u;
    __syncthreads();
    const unsigned e0 = (unsigned)__builtin_amdgcn_readfirstlane((int)QS[0]);
    unsigned cur = (unsigned)__builtin_amdgcn_readfirstlane((int)QS[8 + 2 * F.wave]), end = (unsigned)__builtin_amdgcn_readfirstlane((int)QS[9 + 2 * F.wave]);
    int mode = 0;
#ifdef DIAG_STEAL
    unsigned stolen = 0u;
#endif
    for (;;) {
        if (mode == 1 && (unsigned)__builtin_amdgcn_readfirstlane((int)QS[0]) != e0) break;
        if (cur == end) {
            bool arrive = false;
            if (end == CV_EXH) { if (mode == 0) arrive = true; else { __builtin_amdgcn_s_sleep(8); continue; } }
            else {
                if (mode == 0 && (unsigned)__builtin_amdgcn_readfirstlane((int)QS[1]) >= DJ) arrive = true;
                else {
                    unsigned j0 = 0u; if (F.lane == 0) j0 = __hip_atomic_fetch_add((LAS unsigned*)(F.lds + QST_OFF + 4), 2u, __ATOMIC_RELAXED, __HIP_MEMORY_SCOPE_WORKGROUP);
                    j0 = (unsigned)__builtin_amdgcn_readfirstlane((int)j0);
                    if (j0 >= TJ) { cur = end = CV_EXH; continue; }
                    cur = j0; end = j0 + 2u;
                }
            }
            if (arrive) {
                asm volatile("s_waitcnt vmcnt(0)" ::: "memory");
                __syncthreads();
                if (F.wave == 0 || NO_WAIT_STEAL) { if (threadIdx.x == 0) { xcd_barrier_leader(b); QS[0] = e0 + 1u; } break; }
                mode = 1; continue;
            }
        }
        cv_item(a, scr, (int)(16u * (256u * (cur >> 4) + cu) + (cur & 15u)), F.lane); cur += 2u;
#ifdef DIAG_STEAL
        stolen += 2u * (unsigned)mode;
#endif
    }
    if (F.lane == 0) { QS[8 + 2 * F.wave] = cur; QS[9 + 2 * F.wave] = end; }
#ifdef DIAG_STEAL
    if (F.lane == 0 && stolen) __hip_atomic_fetch_add((unsigned*)(F.ctl + CW_Q + 1024), stolen, RLX_AGENT);
#endif
    __syncthreads();
}
__device__ __forceinline__ void p0_prologue(const Frame& F, const Args& a) {
    LAS float* scr = (LAS float*)(F.lds + RING_OFF + F.wave * 16384);
    unsigned char* ws = a.ws;
    const int gw = F.vcu * NWAVES + F.wave, NGW = F.G * NWAVES;
    constexpr int I_PW1 = (256 / 64) * (256 / 32), I_PW = 4 * I_PW1;
    for (int it = gw; it < CV_IN + NLAYER * I_PW; it += NGW) {
        if (it < CV_IN) { p0_transpose_item<true>(a.in[2], DM, DIN, (bf16*)(ws + WS_WIN), scr, it, F.lane, a.in[1]); continue; }
        const int r = it - CV_IN, lg = r / I_PW1, ri = r % I_PW1;
        p0_transpose_item<false>(a.in[11] + (size_t)lg * 65536, 256, 256, (bf16*)(ws + WS_PWT) + (size_t)lg * 65536, scr, ri, F.lane);
    }
    const int gt = F.vcu * (NWAVES * 64) + F.tid, NGT = F.G * NWAVES * 64;
    { const GAS float* src = (const GAS float*)a.in[5]; GAS unsigned* dst = (GAS unsigned*)(ws + WS_GWS);
      for (int i = gt; i < NLAYER * 8 * 128 * 128 / 2; i += NGT) dst[i] = pk2(src[2 * i], src[2 * i + 1]); }
    { GAS float* rope = (GAS float*)(ws + WS_ROPE);
      for (int e = gt; e < SEQ * 8; e += NGT) {
          const int pos = e >> 3, i = e & 7;
          const float invf = (i == 0) ? 1.0f : (i == 1) ? 0x1.8d275ep-3f : (i == 2) ? 0x1.341190p-5f : (i == 3) ? 0x1.ddee9cp-8f : (i == 4) ? 0x1.72ba44p-10f : (i == 5) ? 0x1.1f91f0p-12f : (i == 6) ? 0x1.be218ap-15f : 0x1.5a0f50p-17f;
          const float angf = (float)pos * invf;
          const double ad = (double)angf;
          const double kq = __builtin_rint(ad * 0.63661977236758134308);
          const double y = __builtin_fma(-kq, 1.57079632679489661923, ad);
          const double y2 = y * y;
          const double sn = y * (1.0 + y2 * (-1.0 / 6 + y2 * (1.0 / 120 + y2 * (-1.0 / 5040 + y2 * (1.0 / 362880 + y2 * (-1.0 / 39916800))))));
          const double cs = 1.0 + y2 * (-0.5 + y2 * (1.0 / 24 + y2 * (-1.0 / 720 + y2 * (1.0 / 40320 + y2 * (-1.0 / 3628800 + y2 * (1.0 / 479001600))))));
          const int q = ((int)kq) & 3;
          const double c = (q == 0) ? cs : (q == 1) ? -sn : (q == 2) ? -cs : sn;
          const double s = (q == 0) ? sn : (q == 1) ? cs : (q == 2) ? -sn : -cs;
          rope[2 * e] = (float)c; rope[2 * e + 1] = (float)s;
      } }
}

__device__ __forceinline__ void xprep_phase(const Frame& F, const float* x, bf16* XB, float* SS) {
    const int gw = F.vcu * NWAVES + F.wave, NGW = F.G * NWAVES;
    for (int m = gw; m < M; m += NGW) {
        const GAS f32x4* xr = (const GAS f32x4*)(x + (size_t)m * DM) + F.lane;
        f32x4 v[16]; float s = 0.f;
#pragma unroll
        for (int j = 0; j < 16; ++j) { v[j] = __builtin_nontemporal_load(xr + 64 * j); s += (v[j].x * v[j].x + v[j].y * v[j].y) + (v[j].z * v[j].z + v[j].w * v[j].w); }
        GAS u32x2* o8 = (GAS u32x2*)(XB + (size_t)m * DM) + F.lane;
#pragma unroll
        for (int j = 0; j < 16; ++j) { u32x2 w; w.x = pk2(v[j].x, v[j].y); w.y = pk2(v[j].z, v[j].w); o8[64 * j] = w; }
        ((GAS float*)SS)[(size_t)m * 64 + F.lane] = s;
    }
}
__device__ __forceinline__ void rs_table(const Frame& F, const float* SS, int pm) {
    LAS float* tab = (LAS float*)(F.lds + RSTAB_OFF);
    if (F.tid < 256) { const GAS f32x4* p = (const GAS f32x4*)(SS + (size_t)(pm * 256 + F.tid) * 64); float s = 0.f;
#pragma unroll
        for (int j = 0; j < 16; ++j) { const f32x4 v = p[j]; s += (v.x + v.y) + (v.z + v.w); }
        tab[F.tid] = 1.0f / sqrtf(s * (1.f / DM) + 1e-6f); }
    __syncthreads();
}

__device__ __forceinline__ int vimg_st(int k, int c) { const int kk = (k & ~0xC) | ((k & 4) << 1) | ((k & 8) >> 1); return ((kk >> 3) * 4 + (c >> 5)) * 512 + ((kk & 7) * 32 + (c & 31)) * 2; }
__device__ __forceinline__ int vimg_rd_base(int lane) { return ((lane & 3) << 3) | (((lane >> 2) & 3) << 6) | (((lane >> 4) & 1) << 5) | (((lane >> 5) & 1) << 8); }
typedef __attribute__((ext_vector_type(4))) short s16x4;
typedef __attribute__((ext_vector_type(16))) float f32x16;
template <int OFF> __device__ __forceinline__ s16x4 vimg_tr(int vb) { s16x4 r; asm volatile("ds_read_b64_tr_b16 %0, %1 offset:%2" : "=&v"(r) : "v"(vb), "i"(OFF) : "memory"); return r; }
__device__ __forceinline__ void unpack8(const v4u a, float (&v)[8]) { v[0] = bf_lo(a.x); v[1] = bf_hi(a.x); v[2] = bf_lo(a.y); v[3] = bf_hi(a.y); v[4] = bf_lo(a.z); v[5] = bf_hi(a.z); v[6] = bf_lo(a.w); v[7] = bf_hi(a.w); }

__device__ __forceinline__ void gmlp_unit(const Frame& F, const bf16* Z, bf16* YC, const float* SV, const bf16* Wsb, const float* bs, const float* lng, const float* lnb, int unit, char* ldsg) {
    const int chunk = unit >> 2, hp = unit & 3, r0 = chunk * 128, tid = F.tid, lane = F.lane, w = F.wave, r32 = lane & 31, hi = lane >> 5;
    LAS float* st = (LAS float*)(F.lds + RING_OFF);
    LAS unsigned char* VI = F.lds + RING_OFF + 1024;
    LAS float* OT = (LAS float*)(F.lds + RING_OFF + 1024 + 32768);
    if (tid < 128) { const GAS f32x4* p = (const GAS f32x4*)(SV + (size_t)(r0 + tid) * 32); float s1 = 0.f, s2 = 0.f;
#pragma unroll
        for (int j = 0; j < 8; ++j) { const f32x4 v = p[j]; s1 += v.x + v.z; s2 += v.y + v.w; }
        const float mean = s1 * (1.f / 1024.f), var = s2 * (1.f / 1024.f) - mean * mean;
        st[tid * 2] = mean; st[tid * 2 + 1] = 1.0f / sqrtf(fmaxf(var, 0.f) + 1e-5f); }
    __syncthreads();
    const int d0 = w & 3, ib0 = (w >> 2) * 2;
    const int vb = (int)(uintptr_t)(ldsg + RING_OFF + 1024) + vimg_rd_base(lane) + d0 * 512;
#pragma unroll 1
    for (int hq = 0; hq < 2; ++hq) {
        const int h = hp * 2 + hq;
        bf16x8 wa[8], wb[8];
        { const GAS bf16* wrow = (const GAS bf16*)Wsb + (size_t)(h * 128 + 32 * ib0 + r32) * 128 + 8 * hi;
#pragma unroll
          for (int ks = 0; ks < 8; ++ks) { wa[ks] = *(const GAS bf16x8*)(wrow + 16 * ks); wb[ks] = *(const GAS bf16x8*)(wrow + 32 * 128 + 16 * ks); } }
        { const int j = tid >> 2, cq = tid & 3; const float mean = st[j * 2], rstd = st[j * 2 + 1];
          const GAS v4u* p = (const GAS v4u*)(Z + (size_t)(r0 + j) * DIN + ZC_A + 1024 + h * 128 + cq * 32);
          const GAS f32x4* gp = (const GAS f32x4*)(lng + h * 128 + cq * 32); const GAS f32x4* bp = (const GAS f32x4*)(lnb + h * 128 + cq * 32);
          v4u a[4];
#pragma unroll
          for (int k4 = 0; k4 < 4; ++k4) a[k4] = p[k4];
#pragma unroll
          for (int k4 = 0; k4 < 4; ++k4) { float v[8]; unpack8(a[k4], v); const f32x4 g0 = gp[2 * k4], g1 = gp[2 * k4 + 1], b0 = bp[2 * k4], b1 = bp[2 * k4 + 1];
              v4u o; o.x = pk2((v[0] - mean) * rstd * g0.x + b0.x, (v[1] - mean) * rstd * g0.y + b0.y); o.y = pk2((v[2] - mean) * rstd * g0.z + b0.z, (v[3] - mean) * rstd * g0.w + b0.w);
              o.z = pk2((v[4] - mean) * rstd * g1.x + b1.x, (v[5] - mean) * rstd * g1.y + b1.y); o.w = pk2((v[6] - mean) * rstd * g1.z + b1.z, (v[7] - mean) * rstd * g1.w + b1.w);
              *(LAS v4u*)(VI + (j >> 6) * 16384 + vimg_st(j & 63, cq * 32 + k4 * 8)) = o; } }
        __syncthreads();
        f32x16 acc[2]; acc[0] = f32x16{}; acc[1] = f32x16{};
#define GM_RD(KS) lo_[KS] = vimg_tr<((KS) >> 2) * 16384 + ((KS) & 3) * 4096>(vb), hi_[KS] = vimg_tr<((KS) >> 2) * 16384 + ((KS) & 3) * 4096 + 2048>(vb)
#define GM_MM(KS) do { const bf16x8 b_ = (bf16x8){lo_[KS][0], lo_[KS][1], lo_[KS][2], lo_[KS][3], hi_[KS][0], hi_[KS][1], hi_[KS][2], hi_[KS][3]}; \
        acc[0] = __builtin_amdgcn_mfma_f32_32x32x16_bf16(wa[KS], b_, acc[0], 0, 0, 0); acc[1] = __builtin_amdgcn_mfma_f32_32x32x16_bf16(wb[KS], b_, acc[1], 0, 0, 0); } while (0)
        { s16x4 lo_[8], hi_[8];
          GM_RD(0); GM_RD(1); GM_RD(2); GM_RD(3); GM_RD(4); GM_RD(5); GM_RD(6); GM_RD(7);
          asm volatile("s_waitcnt lgkmcnt(0)" ::: "memory"); __builtin_amdgcn_sched_barrier(0);
          GM_MM(0); GM_MM(1); GM_MM(2); GM_MM(3); GM_MM(4); GM_MM(5); GM_MM(6); GM_MM(7); }
#undef GM_RD
#undef GM_MM
#define GM_STEP(KS) do { } while (0)
#undef GM_STEP
#pragma unroll
        for (int t = 0; t < 2; ++t)
#pragma unroll
            for (int r = 0; r < 16; ++r) OT[(32 * (ib0 + t) + (r & 3) + 8 * (r >> 2) + 4 * hi) * 132 + 32 * d0 + r32] = acc[t][r];
        __syncthreads();
        { const int i = tid >> 2, cq = tid & 3; const float b = bs[h * 128 + i];
          const GAS v4u* up = (const GAS v4u*)(Z + (size_t)(r0 + i) * DIN + ZC_A + h * 128 + cq * 32); GAS v4u* yp = (GAS v4u*)(YC + (size_t)(r0 + i) * DM + YC_A + h * 128 + cq * 32);
          v4u a[4];
#pragma unroll
          for (int k4 = 0; k4 < 4; ++k4) a[k4] = up[k4];
#pragma unroll
          for (int k4 = 0; k4 < 4; ++k4) { float u[8]; unpack8(a[k4], u); const f32x4 o0 = *(const LAS f32x4*)(OT + i * 132 + cq * 32 + k4 * 8), o1 = *(const LAS f32x4*)(OT + i * 132 + cq * 32 + k4 * 8 + 4);
              v4u o; o.x = pk2((o0.x + b) * u[0], (o0.y + b) * u[1]); o.y = pk2((o0.z + b) * u[2], (o0.w + b) * u[3]); o.z = pk2((o1.x + b) * u[4], (o1.y + b) * u[5]); o.w = pk2((o1.z + b) * u[6], (o1.w + b) * u[7]);
              yp[k4] = o; } }
    }
    __syncthreads();
}

template <int R> __device__ __forceinline__ void conv_rows(const unsigned (&hraw)[62], const f32x2v (&w)[31], f32x2v (&acc)[31], const f32x2v bias, LAS float* cvp, int rlo, int rhi) {
    const unsigned hv = (R >= rlo && R < rhi) ? hraw[R] : 0u;
    const f32x2v h = (f32x2v){bf_lo(hv), bf_hi(hv)};
#pragma unroll
    for (int k = 0; k < 31; ++k) { const int o = R - k; if (o >= 0 && o <= 31) acc[(o + 31) % 31] = acc[(o + 31) % 31] + h * w[k]; }
    if constexpr (R >= 30) { constexpr int o = R - 30; *(LAS f32x2v*)(cvp + o * GW) = acc[o % 31] + bias; acc[o % 31] = (f32x2v){0.f, 0.f}; }
    if constexpr (R + 1 < 62) conv_rows<R + 1>(hraw, w, acc, bias, cvp, rlo, rhi);
}
__device__ __forceinline__ void conv_unit(const Frame& F, const bf16* Z, bf16* YC, const float* cw, const float* cb, const float* lng, const float* lnb, int unit) {
    const int t0 = unit * 32, bstart = (t0 / SEQ) * SEQ, bend = bstart + SEQ, tid = F.tid, lane = F.lane, c0 = 2 * tid;
    LAS float* CV = (LAS float*)(F.lds + RING_OFF);
    unsigned hraw[62];
    { const GAS bf16* zp = (const GAS bf16*)Z + (ptrdiff_t)(t0 - 15) * DIN + ZC_B + c0;
#pragma unroll
      for (int r = 0; r < 62; ++r) { hraw[r] = *(const GAS unsigned*)zp; zp += DIN; asm volatile("" : "+v"(zp)); } }
    f32x2v w[31], acc[31];
    { const GAS float* wp = (const GAS float*)cw + c0;
#pragma unroll
      for (int k = 0; k < 31; ++k) { w[k] = *(const GAS f32x2v*)wp; acc[k] = (f32x2v){0.f, 0.f}; wp += GW; asm volatile("" : "+v"(wp)); } }
    const f32x2v bias = *(const GAS f32x2v*)(cb + c0);
    conv_rows<0>(hraw, w, acc, bias, CV + c0, bstart - (t0 - 15), bend - (t0 - 15));
    __syncthreads();
    { f32x4 x[4][4]; float sm[4], qv[4];
#pragma unroll
      for (int oo = 0; oo < 4; ++oo) { const int o = F.wave * 4 + oo; float s_ = 0.f;
#pragma unroll
          for (int j = 0; j < 4; ++j) { x[oo][j] = *(const LAS f32x4*)(CV + o * GW + lane * 4 + 256 * j); s_ += (x[oo][j].x + x[oo][j].y) + (x[oo][j].z + x[oo][j].w); }
          sm[oo] = s_; }
#pragma unroll
      for (int st = 1; st < 64; st <<= 1) {
#pragma unroll
          for (int oo = 0; oo < 4; ++oo) sm[oo] += __shfl_xor(sm[oo], st); }
#pragma unroll
      for (int oo = 0; oo < 4; ++oo) { const float mean = sm[oo] * (1.f / GW); float q = 0.f;
#pragma unroll
          for (int j = 0; j < 4; ++j) { x[oo][j] = x[oo][j] - mean; q += (x[oo][j].x * x[oo][j].x + x[oo][j].y * x[oo][j].y) + (x[oo][j].z * x[oo][j].z + x[oo][j].w * x[oo][j].w); }
          qv[oo] = q; }
#pragma unroll
      for (int st = 1; st < 64; st <<= 1) {
#pragma unroll
          for (int oo = 0; oo < 4; ++oo) qv[oo] += __shfl_xor(qv[oo], st); }
#pragma unroll
      for (int j = 0; j < 4; ++j) { const int c = lane * 4 + 256 * j; const f32x4 gv = *(const GAS f32x4*)(lng + c), bv = *(const GAS f32x4*)(lnb + c);
#pragma unroll
          for (int oo = 0; oo < 4; ++oo) { const int o = F.wave * 4 + oo; const float rstd = 1.0f / sqrtf(qv[oo] * (1.f / GW) + 1e-5f);
              f32x4 y = x[oo][j] * rstd * gv + bv; y.x *= sigmoidf_fast(y.x); y.y *= sigmoidf_fast(y.y); y.z *= sigmoidf_fast(y.z); y.w *= sigmoidf_fast(y.w);
              u32x2 wv; wv.x = pk2(y.x, y.y); wv.y = pk2(y.z, y.w);
              *(GAS u32x2*)(YC + (size_t)(t0 + o) * DM + YC_B + c) = wv; } } }
    __syncthreads();
}

__device__ __forceinline__ void pool_unit(const Frame& F, const bf16* Z, bf16* YC, const bf16* PWT, const float* scale, int unit) {
    const int g = unit & 3, tile = unit >> 2, t0 = tile * 64, bstart = (t0 / SEQ) * SEQ, tid = F.tid, lane = F.lane, fr = lane & 15, fq = lane >> 4, w = F.wave;
    const int wh = 1 << g;
    LAS bf16* ZT = (LAS bf16*)(F.lds + RING_OFF);
    LAS bf16* P = (LAS bf16*)(F.lds + RING_OFF + 80 * 264 * 2);
    const GAS bf16* pw = (const GAS bf16*)PWT + (size_t)g * 65536;
    bf16x8 Bf[8][2];
#pragma unroll
    for (int kk = 0; kk < 8; ++kk)
#pragma unroll
        for (int n = 0; n < 2; ++n) Bf[kk][n] = *(const GAS bf16x8*)(pw + (size_t)(32 * w + 16 * n + fr) * 256 + 32 * kk + 8 * fq);
    { const GAS bf16* zc = (const GAS bf16*)Z + ZC_C + g * 256; v4u a[5];
#pragma unroll
      for (int i = 0; i < 5; ++i) { const int q = tid + 512 * i, rr = q >> 5, cc = q & 31; int row = t0 - 8 + rr; row = row < bstart ? bstart : (row >= bstart + SEQ ? bstart + SEQ - 1 : row);
          a[i] = *(const GAS v4u*)(zc + (size_t)row * DIN + cc * 8); }
#pragma unroll
      for (int i = 0; i < 5; ++i) { const int q = tid + 512 * i, rr = q >> 5, cc = q & 31; *(LAS v4u*)(ZT + rr * 264 + cc * 8) = a[i]; } }
    __syncthreads();
    { const int cc = tid & 31, rg = tid >> 5;
      auto body = [&](auto GC) __attribute__((always_inline)) { constexpr int WH = 1 << decltype(GC)::value, NU = 2 * WH + 3;
          const int pos0 = t0 - bstart + 4 * rg - WH;
          v4u raw[NU];
#pragma unroll
          for (int i = 0; i < NU; ++i) raw[i] = *(const LAS v4u*)(ZT + (4 * rg - WH + i + 8) * 264 + cc * 8);
          float sw[8];
#pragma unroll
          for (int e = 0; e < 8; ++e) sw[e] = 0.f;
#pragma unroll
          for (int i = 0; i < 2 * WH; ++i) { const unsigned ps = (unsigned)(pos0 + i); float v[8]; unpack8(raw[i], v); const float mk = ps < (unsigned)SEQ ? 1.f : 0.f;
#pragma unroll
              for (int e = 0; e < 8; ++e) sw[e] += v[e] * mk; }
#pragma unroll
          for (int o = 0; o < 4; ++o) {
              if (o > 0) { float va[8], vr[8]; unpack8(raw[2 * WH - 1 + o], va); unpack8(raw[o - 1], vr);
                  const float ma = (unsigned)(pos0 + 2 * WH - 1 + o) < (unsigned)SEQ ? 1.f : 0.f, mr = (unsigned)(pos0 + o - 1) < (unsigned)SEQ ? 1.f : 0.f;
#pragma unroll
                  for (int e = 0; e < 8; ++e) sw[e] += va[e] * ma - vr[e] * mr; }
              const int pos = pos0 + WH + o; const int lo = pos - WH > 0 ? pos - WH : 0, hi = pos + WH < SEQ ? pos + WH : SEQ; const float inv = 1.0f / (float)(hi - lo);
              float v[8]; unpack8(raw[WH + o], v);
              v4u ov; ov.x = pk2(sw[0] * inv - v[0], sw[1] * inv - v[1]); ov.y = pk2(sw[2] * inv - v[2], sw[3] * inv - v[3]); ov.z = pk2(sw[4] * inv - v[4], sw[5] * inv - v[5]); ov.w = pk2(sw[6] * inv - v[6], sw[7] * inv - v[7]);
              *(LAS v4u*)(P + (4 * rg + o) * 264 + cc * 8) = ov; } };
      if (g == 0) body(std::integral_constant<int, 0>{}); else if (g == 1) body(std::integral_constant<int, 1>{}); else if (g == 2) body(std::integral_constant<int, 2>{}); else body(std::integral_constant<int, 3>{}); }
    __syncthreads();
    f32x4 acc[4][2];
#pragma unroll
    for (int m = 0; m < 4; ++m)
#pragma unroll
        for (int n = 0; n < 2; ++n) acc[m][n] = (f32x4){0.f, 0.f, 0.f, 0.f};
#pragma unroll
    for (int kk = 0; kk < 8; ++kk) {
        bf16x8 Af[4];
#pragma unroll
        for (int m = 0; m < 4; ++m) Af[m] = *(const LAS bf16x8*)(P + (16 * m + fr) * 264 + 32 * kk + 8 * fq);
#pragma unroll
        for (int m = 0; m < 4; ++m)
#pragma unroll
            for (int n = 0; n < 2; ++n) acc[m][n] = __builtin_amdgcn_mfma_f32_16x16x32_bf16(Bf[kk][n], Af[m], acc[m][n], 0, 0, 0);
    }
#pragma unroll
    for (int n = 0; n < 2; ++n) { const int d = 32 * w + 16 * n + 4 * fq; const f32x4 sc = *(const GAS f32x4*)(scale + g * 256 + d);
#pragma unroll
        for (int m = 0; m < 4; ++m) { const f32x4 v = acc[m][n] * sc; u32x2 wv; wv.x = pk2(v[0], v[1]); wv.y = pk2(v[2], v[3]);
            *(GAS u32x2*)(YC + (size_t)(t0 + 16 * m + fr) * DM + YC_C + g * 256 + d) = wv; } }
    __syncthreads();
}

namespace att {
typedef __attribute__((ext_vector_type(8))) short bf16x8;
typedef __attribute__((ext_vector_type(4))) short s16x4;
typedef __attribute__((ext_vector_type(16))) float f32x16;
typedef __attribute__((ext_vector_type(4))) unsigned u32x4;
constexpr int QBLK = 32, KVBLK = 64, NW = 8, LDQK = 64, LDV = 128;
constexpr int SHM_V = KVBLK * 128 * 2, SHM_K = KVBLK * 64 * 2;
constexpr int OFF_V = 0, OFF_K = 2 * SHM_V, OFF_WS = OFF_K + 2 * SHM_K, ATT_LDS = OFF_WS + NW * 64 * 4;
constexpr float THR = 8.0f;
#define KSWZ(row, colB) ((row) * 128 + ((colB) ^ ((((row) >> 1) & 7) << 4)))
#define SBAR() __builtin_amdgcn_sched_barrier(0)
__device__ __forceinline__ int crow(int r, int hi) { return (r & 3) + 8 * (r >> 2) + 4 * hi; }
__device__ __forceinline__ unsigned cvtpk(float lo, float hi) { unsigned r; asm volatile("v_cvt_pk_bf16_f32 %0, %1, %2" : "=v"(r) : "v"(lo), "v"(hi)); return r; }

__device__ __forceinline__ void partialSM(f32x16& p0, f32x16& p1, float& m_reg, float& alpha) {
    float pmax = p0[0];
#pragma unroll
    for (int r = 1; r < 16; ++r) pmax = fmaxf(pmax, p0[r]);
#pragma unroll
    for (int r = 0; r < 16; ++r) pmax = fmaxf(pmax, p1[r]);
    { auto rr = __builtin_amdgcn_permlane32_swap(__float_as_uint(pmax), __float_as_uint(pmax), false, false);
      pmax = fmaxf(__uint_as_float(rr[0]), __uint_as_float(rr[1])); }
    if (__builtin_expect(__all(pmax - m_reg <= THR), 1)) { alpha = 1.f; }
    else { const float mn = fmaxf(m_reg, pmax); alpha = __builtin_amdgcn_exp2f(m_reg - mn); m_reg = mn; }
    const float mm = m_reg;
#pragma unroll
    for (int r = 0; r < 16; ++r) { p0[r] -= mm; p1[r] -= mm; }
#pragma unroll
    for (int r = 0; r < 16; ++r) p0[r] = __builtin_amdgcn_exp2f(p0[r]);
}
__device__ __forceinline__ void finishSM(f32x16& p0, f32x16& p1, float alpha, float& l_reg, bf16x8& pa0, bf16x8& pa1, bf16x8& pa2, bf16x8& pa3) {
#pragma unroll
    for (int r = 0; r < 16; ++r) p1[r] = __builtin_amdgcn_exp2f(p1[r]);
    float ps = 0.f;
#pragma unroll
    for (int r = 0; r < 16; ++r) ps += p0[r];
#pragma unroll
    for (int r = 0; r < 16; ++r) ps += p1[r];
    { auto rr = __builtin_amdgcn_permlane32_swap(__float_as_uint(ps), __float_as_uint(ps), false, false);
      ps = __uint_as_float(rr[0]) + __uint_as_float(rr[1]); }
    l_reg = l_reg * alpha + ps;
#define PK4(P, BASE, OUT) do { unsigned a0 = cvtpk(P[BASE + 0], P[BASE + 1]), a1 = cvtpk(P[BASE + 2], P[BASE + 3]);   \
    unsigned b0 = cvtpk(P[BASE + 4], P[BASE + 5]), b1 = cvtpk(P[BASE + 6], P[BASE + 7]);                              \
    auto r0 = __builtin_amdgcn_permlane32_swap(a0, b0, false, false); auto r1 = __builtin_amdgcn_permlane32_swap(a1, b1, false, false); \
    u32x4 w = {r0[0], r1[0], r0[1], r1[1]}; OUT = *reinterpret_cast<bf16x8*>(&w); } while (0)
    PK4(p0, 0, pa0); PK4(p0, 8, pa1); PK4(p1, 0, pa2); PK4(p1, 8, pa3);
#undef PK4
}
__device__ __forceinline__ void qkt(f32x16& p0, f32x16& p1, const char* Ks, const bf16x8* qr, int r32, int hi) {
    p0 = f32x16{}; p1 = f32x16{};
#pragma unroll
    for (int d0 = 0; d0 < 4; ++d0) { const int cb = (d0 * 16 + hi * 8) * 2;
        const bf16x8 b0 = *reinterpret_cast<const bf16x8*>(Ks + KSWZ(r32, cb));
        const bf16x8 b1 = *reinterpret_cast<const bf16x8*>(Ks + KSWZ(32 + r32, cb));
        p0 = __builtin_amdgcn_mfma_f32_32x32x16_bf16(b0, qr[d0], p0, 0, 0, 0);
        p1 = __builtin_amdgcn_mfma_f32_32x32x16_bf16(b1, qr[d0], p1, 0, 0, 0); }
}
__device__ __forceinline__ int v_st(int k, int c) { const int kk = (k & ~0xC) | ((k & 4) << 1) | ((k & 8) >> 1); return ((kk >> 3) * 4 + (c >> 5)) * 512 + ((kk & 7) * 32 + (c & 31)) * 2; }
__device__ __forceinline__ int v_rd_base(int lane) { return ((lane & 3) << 3) | (((lane >> 2) & 3) << 6) | (((lane >> 4) & 1) << 5) | (((lane >> 5) & 1) << 8); }
constexpr int v_rd_off(int d0, int ks, int half) { return d0 * 512 + ks * 4096 + half * 2048; }
template <int OFF> __device__ __forceinline__ s16x4 tr_read(int vb) {
    s16x4 r; asm volatile("ds_read_b64_tr_b16 %0, %1 offset:%2" : "=&v"(r) : "v"(vb), "i"(OFF) : "memory"); return r;
}
template <int D0> __device__ __forceinline__ void pv_one(f32x16& od, int vb, bf16x8 pa0, bf16x8 pa1, bf16x8 pa2, bf16x8 pa3) {
    const s16x4 l0 = tr_read<v_rd_off(D0, 0, 0)>(vb), h0 = tr_read<v_rd_off(D0, 0, 1)>(vb), l1 = tr_read<v_rd_off(D0, 1, 0)>(vb), h1 = tr_read<v_rd_off(D0, 1, 1)>(vb);
    const s16x4 l2 = tr_read<v_rd_off(D0, 2, 0)>(vb), h2 = tr_read<v_rd_off(D0, 2, 1)>(vb), l3 = tr_read<v_rd_off(D0, 3, 0)>(vb), h3 = tr_read<v_rd_off(D0, 3, 1)>(vb);
    asm volatile("s_waitcnt lgkmcnt(0)" ::: "memory"); SBAR();
#define PK(L, H) (bf16x8){L[0], L[1], L[2], L[3], H[0], H[1], H[2], H[3]}
    od = __builtin_amdgcn_mfma_f32_32x32x16_bf16(pa0, PK(l0, h0), od, 0, 0, 0);
    od = __builtin_amdgcn_mfma_f32_32x32x16_bf16(pa1, PK(l1, h1), od, 0, 0, 0);
    od = __builtin_amdgcn_mfma_f32_32x32x16_bf16(pa2, PK(l2, h2), od, 0, 0, 0);
    od = __builtin_amdgcn_mfma_f32_32x32x16_bf16(pa3, PK(l3, h3), od, 0, 0, 0);
#undef PK
}
__device__ __forceinline__ void pv_d0(f32x16* o, int vb, bf16x8 pa0, bf16x8 pa1, bf16x8 pa2, bf16x8 pa3) {
    pv_one<0>(o[0], vb, pa0, pa1, pa2, pa3); pv_one<1>(o[1], vb, pa0, pa1, pa2, pa3); pv_one<2>(o[2], vb, pa0, pa1, pa2, pa3); pv_one<3>(o[3], vb, pa0, pa1, pa2, pa3);
}

__device__ __forceinline__ void attn_pass(const bf16* __restrict__ Qb, const bf16* __restrict__ Kh, const bf16* __restrict__ Vh, char* lds, f32x16 (&o)[4], float& l_out) {
    int tid_ = threadIdx.x; asm volatile("" : "+v"(tid_));
    const int tid = tid_, wid = tid >> 6, lane = tid & 63, r32 = lane & 31, hi = lane >> 5;
    char* V_lds = lds + OFF_V; char* K_lds = lds + OFF_K;
    float* ws = (float*)(lds + OFF_WS) + wid * 64; float* al_l = ws + 32;
    float m_reg = -1e30f, l_reg = 0.f; bf16x8 qr[4];
#pragma unroll
    for (int d = 0; d < 4; ++d) o[d] = f32x16{};
    const GAS bf16* Qw = (const GAS bf16*)Qb + (size_t)(wid * QBLK + r32) * LDQK + hi * 8;
#pragma unroll
    for (int d0 = 0; d0 < 4; ++d0) qr[d0] = *(const GAS bf16x8*)(Qw + d0 * 16);
    const int sr = tid >> 4, sc = (tid & 15) * 8, vst0 = v_st(sr, sc), vst1 = v_st(32 + sr, sc);
    const int kr = tid >> 3, kc = (tid & 7) * 16, kst = KSWZ(kr, kc);
    const int vb0 = (int)(uintptr_t)V_lds + v_rd_base(lane);
    const GAS bf16* Kg = (const GAS bf16*)Kh + (size_t)kr * LDQK + (tid & 7) * 8;
    const GAS bf16* Vg = (const GAS bf16*)Vh + (size_t)sr * LDV + sc;
    struct { bf16x8 vs0, vs1, ks0; } sr_[2];
#define SLOAD(i, k0) do { sr_[i].vs0 = *(const GAS bf16x8*)(Vg + (size_t)(k0) * LDV); sr_[i].vs1 = *(const GAS bf16x8*)(Vg + (size_t)((k0) + 32) * LDV); \
    sr_[i].ks0 = *(const GAS bf16x8*)(Kg + (size_t)(k0) * LDQK); } while (0)
#define SWRITE(b, i) do { *(bf16x8*)(V_lds + (b) * SHM_V + vst0) = sr_[i].vs0; *(bf16x8*)(V_lds + (b) * SHM_V + vst1) = sr_[i].vs1; \
    *(bf16x8*)(K_lds + (b) * SHM_K + kst) = sr_[i].ks0; } while (0)
#define SWAIT() asm volatile("s_waitcnt vmcnt(3)" ::: "memory")
#define RESC(a) do { if (__any((a) < 1.f)) { if (hi == 0) al_l[r32] = (a); asm volatile("s_waitcnt lgkmcnt(0)" ::: "memory"); \
    _Pragma("unroll") for (int d = 0; d < 4; ++d) _Pragma("unroll") for (int r = 0; r < 16; ++r) o[d][r] *= al_l[crow(r, hi)]; } } while (0)
    f32x16 pA0, pA1, pB0, pB1; float alA, alB; bf16x8 pa0, pa1, pa2, pa3; constexpr int NT = SEQ / KVBLK;
    constexpr int SE = 0, SO = 1;
    SLOAD(SE, 0); asm volatile("s_waitcnt vmcnt(0)" ::: "memory"); SWRITE(0, SE); __syncthreads();
    qkt(pA0, pA1, K_lds, qr, r32, hi); partialSM(pA0, pA1, m_reg, alA);
    SLOAD(SO, KVBLK); SLOAD(SE, 2 * KVBLK);
    SWAIT(); SWRITE(1, SO); __syncthreads();
    for (int j = 1; j + 1 < NT; j += 2) {
        SBAR(); qkt(pB0, pB1, K_lds + SHM_K, qr, r32, hi);
        finishSM(pA0, pA1, alA, l_reg, pa0, pa1, pa2, pa3); SBAR();
        SLOAD(SO, (j + 2) * KVBLK); SBAR();
        pv_d0(o, vb0, pa0, pa1, pa2, pa3); partialSM(pB0, pB1, m_reg, alB);
        __syncthreads(); SWAIT(); SWRITE(0, SE);
        RESC(alB); __syncthreads();
        SBAR(); qkt(pA0, pA1, K_lds, qr, r32, hi);
        finishSM(pB0, pB1, alB, l_reg, pa0, pa1, pa2, pa3); SBAR();
        if (j + 3 < NT) SLOAD(SE, (j + 3) * KVBLK); SBAR();
        pv_d0(o, vb0 + SHM_V, pa0, pa1, pa2, pa3); partialSM(pA0, pA1, m_reg, alA);
        __syncthreads(); SWAIT(); SWRITE(1, SO);
        RESC(alA); __syncthreads();
    }
    SBAR(); qkt(pB0, pB1, K_lds + SHM_K, qr, r32, hi);
    finishSM(pA0, pA1, alA, l_reg, pa0, pa1, pa2, pa3); SBAR();
    pv_d0(o, vb0, pa0, pa1, pa2, pa3); partialSM(pB0, pB1, m_reg, alB);
    __syncthreads(); RESC(alB);
    finishSM(pB0, pB1, alB, l_reg, pa0, pa1, pa2, pa3); SBAR();
    pv_d0(o, vb0 + SHM_V, pa0, pa1, pa2, pa3);
    l_out = l_reg;
    __syncthreads();
#undef SLOAD
#undef SWRITE
#undef SWAIT
#undef RESC
}

constexpr int F_OFF_WS = 4 * SHM_V + 4 * SHM_K;
template <int G> __device__ __forceinline__ void pv_rd(s16x4 (&lo)[4], s16x4 (&hh)[4], int vb) {
    lo[0] = tr_read<v_rd_off(G, 0, 0)>(vb); hh[0] = tr_read<v_rd_off(G, 0, 1)>(vb); lo[1] = tr_read<v_rd_off(G, 1, 0)>(vb); hh[1] = tr_read<v_rd_off(G, 1, 1)>(vb);
    lo[2] = tr_read<v_rd_off(G, 2, 0)>(vb); hh[2] = tr_read<v_rd_off(G, 2, 1)>(vb); lo[3] = tr_read<v_rd_off(G, 3, 0)>(vb); hh[3] = tr_read<v_rd_off(G, 3, 1)>(vb);
}
__device__ __forceinline__ void pv_mm(f32x16& od, const s16x4 (&lo)[4], const s16x4 (&hh)[4], bf16x8 pa0, bf16x8 pa1, bf16x8 pa2, bf16x8 pa3) {
#define PK(L, H) (bf16x8){L[0], L[1], L[2], L[3], H[0], H[1], H[2], H[3]}
    od = __builtin_amdgcn_mfma_f32_32x32x16_bf16(pa0, PK(lo[0], hh[0]), od, 0, 0, 0);
    od = __builtin_amdgcn_mfma_f32_32x32x16_bf16(pa1, PK(lo[1], hh[1]), od, 0, 0, 0);
    od = __builtin_amdgcn_mfma_f32_32x32x16_bf16(pa2, PK(lo[2], hh[2]), od, 0, 0, 0);
    od = __builtin_amdgcn_mfma_f32_32x32x16_bf16(pa3, PK(lo[3], hh[3]), od, 0, 0, 0);
#undef PK
}
template <int OFF> __device__ __forceinline__ bf16x8 lds_rd128(int addr) { bf16x8 r; asm volatile("ds_read_b128 %0, %1 offset:%2" : "=&v"(r) : "v"(addr), "i"(OFF) : "memory"); return r; }
__device__ __forceinline__ float fadd_s(float a, float b) { float r; asm("v_add_f32_e32 %0, %1, %2" : "=v"(r) : "v"(a), "v"(b)); return r; }
constexpr int F_NSLOT = 4;
constexpr int F2_OFF_V = 0, F2_OFF_K = F_NSLOT * SHM_V, F2_END = F2_OFF_K + F_NSLOT * SHM_K;
static_assert(F2_END <= F_OFF_WS, "attention rings below the per-wave scratch");
template <int ABL> __device__ __forceinline__ void attn_pass_fast(const bf16* __restrict__ Qb, const bf16* __restrict__ Kh, const bf16* __restrict__ Vh, char* lds, f32x16 (&o)[4], float& l_out) {
    int tid_ = threadIdx.x; asm volatile("" : "+v"(tid_));
    const int tid = tid_, wid = __builtin_amdgcn_readfirstlane(tid >> 6), lane = tid & 63, r32 = lane & 31, hi = lane >> 5; const bool trail = wid >= 4;
    LAS unsigned char* ldsl = (LAS unsigned char*)(unsigned)(uintptr_t)lds;
    bf16x8 qr[4];
#pragma unroll
    for (int d = 0; d < 4; ++d) o[d] = f32x16{};
    const GAS bf16* Qw = (const GAS bf16*)Qb + (size_t)(wid * QBLK + r32) * LDQK + hi * 8;
#pragma unroll
    for (int d0 = 0; d0 < 4; ++d0) qr[d0] = *(const GAS bf16x8*)(Qw + d0 * 16);
    const int krow = wid * 8 + (lane >> 3), kpos = lane & 7;
    const GAS bf16* Kg = (const GAS bf16*)Kh + (size_t)krow * LDQK + ((kpos ^ ((krow >> 1) & 7)) * 8);
    const int vsub0 = 4 * wid + (lane >> 5), vsub1 = vsub0 + 2;
    const int vkk0 = (vsub0 >> 2) * 8 + ((lane & 31) >> 2), vkk1 = (vsub1 >> 2) * 8 + ((lane & 31) >> 2);
    const GAS bf16* Vg0 = (const GAS bf16*)Vh + (size_t)vkk0 * LDV + (vsub0 & 3) * 32 + (lane & 3) * 8;
    const GAS bf16* Vg1 = (const GAS bf16*)Vh + (size_t)vkk1 * LDV + (vsub1 & 3) * 32 + (lane & 3) * 8;
    const int vb0 = (int)(unsigned)(uintptr_t)(lds + F2_OFF_V) + v_rd_base(lane);
    const int kbase = (int)(unsigned)(uintptr_t)(lds + F2_OFF_K);
    const int ka0 = kbase + KSWZ(r32, (0 * 16 + hi * 8) * 2), ka1 = kbase + KSWZ(r32, (1 * 16 + hi * 8) * 2), ka2 = kbase + KSWZ(r32, (2 * 16 + hi * 8) * 2), ka3 = kbase + KSWZ(r32, (3 * 16 + hi * 8) * 2);
    constexpr int NT = SEQ / KVBLK;
#define FBAR() do { asm volatile("s_waitcnt lgkmcnt(0)\n\ts_barrier" ::: "memory"); SBAR(); } while (0)
#define DMA_K(t, slot) __builtin_amdgcn_global_load_lds((const GAS unsigned*)(Kg + (size_t)(t) * KVBLK * LDQK), (LAS unsigned*)(ldsl + F2_OFF_K + (slot) * SHM_K + wid * 1024), 16, 0, 0)
#define DMA_V(t, slot) do { __builtin_amdgcn_global_load_lds((const GAS unsigned*)(Vg0 + (size_t)(t) * KVBLK * LDV), (LAS unsigned*)(ldsl + F2_OFF_V + (slot) * SHM_V + wid * 2048), 16, 0, 0); \
    __builtin_amdgcn_global_load_lds((const GAS unsigned*)(Vg1 + (size_t)(t) * KVBLK * LDV), (LAS unsigned*)(ldsl + F2_OFF_V + (slot) * SHM_V + wid * 2048 + 1024), 16, 0, 0); } while (0)
#define KREAD(kb) do { kf[0] = lds_rd128<0>(ka0 + (kb)); kf[1] = lds_rd128<4096>(ka0 + (kb)); kf[2] = lds_rd128<0>(ka1 + (kb)); kf[3] = lds_rd128<4096>(ka1 + (kb)); \
    kf[4] = lds_rd128<0>(ka2 + (kb)); kf[5] = lds_rd128<4096>(ka2 + (kb)); kf[6] = lds_rd128<0>(ka3 + (kb)); kf[7] = lds_rd128<4096>(ka3 + (kb)); } while (0)
#define QKT() do { p0 = __builtin_amdgcn_mfma_f32_32x32x16_bf16(kf[0], qr[0], f32x16{}, 0, 0, 0); p1 = __builtin_amdgcn_mfma_f32_32x32x16_bf16(kf[1], qr[0], f32x16{}, 0, 0, 0); \
    p0 = __builtin_amdgcn_mfma_f32_32x32x16_bf16(kf[2], qr[1], p0, 0, 0, 0); p1 = __builtin_amdgcn_mfma_f32_32x32x16_bf16(kf[3], qr[1], p1, 0, 0, 0); \
    p0 = __builtin_amdgcn_mfma_f32_32x32x16_bf16(kf[4], qr[2], p0, 0, 0, 0); p1 = __builtin_amdgcn_mfma_f32_32x32x16_bf16(kf[5], qr[2], p1, 0, 0, 0); \
    p0 = __builtin_amdgcn_mfma_f32_32x32x16_bf16(kf[6], qr[3], p0, 0, 0, 0); p1 = __builtin_amdgcn_mfma_f32_32x32x16_bf16(kf[7], qr[3], p1, 0, 0, 0); } while (0)
    bf16x8 kf[8];
    DMA_K(0, 0); DMA_K(1, 1); DMA_K(2, 2); DMA_V(0, 0); DMA_V(1, 1);
    asm volatile("s_waitcnt vmcnt(0)" ::: "memory");
    __syncthreads();
    if (trail) FBAR();
    f32x16 p0, p1; bf16x8 pa0, pa1, pa2, pa3; float l_reg = 0.f;
    KREAD(0); asm volatile("s_waitcnt lgkmcnt(0)" ::: "memory"); SBAR();
#define EXP8(P, B) do { _Pragma("unroll") for (int r_ = 0; r_ < 8; ++r_) P[(B) + r_] = __builtin_amdgcn_exp2f(P[(B) + r_]); } while (0)
    QKT();
    EXP8(p0, 0); EXP8(p0, 8); EXP8(p1, 0); EXP8(p1, 8);
    FBAR();
    int ks_w = 3, vs_w = 2;
    int kb_r = SHM_K, vb_r = 0;
    s16x4 la[4], ha[4], lb[4], hb[4];
#pragma unroll 1
    for (int x = 0; x < NT; ++x) {
        const int vb = vb0 + vb_r;
        if (x + 1 < NT) KREAD(kb_r);
        pv_rd<0>(la, ha, vb); pv_rd<1>(lb, hb, vb);
        if (x + 3 < NT) DMA_K(x + 3, ks_w);
        if (x + 2 < NT) DMA_V(x + 2, vs_w);
        { float a = fadd_s(p0[0], p0[1]), b = fadd_s(p0[2], p0[3]), c = fadd_s(p1[0], p1[1]), d = fadd_s(p1[2], p1[3]);
#pragma unroll
          for (int r = 4; r < 16; r += 4) { a = fadd_s(a, fadd_s(p0[r], p0[r + 1])); b = fadd_s(b, fadd_s(p0[r + 2], p0[r + 3])); c = fadd_s(c, fadd_s(p1[r], p1[r + 1])); d = fadd_s(d, fadd_s(p1[r + 2], p1[r + 3])); }
          l_reg = fadd_s(l_reg, fadd_s(fadd_s(a, b), fadd_s(c, d))); }
        { u32x4 w;
          w = (u32x4){cvtpk(p0[0], p0[1]), cvtpk(p0[2], p0[3]), cvtpk(p0[4], p0[5]), cvtpk(p0[6], p0[7])}; pa0 = __builtin_bit_cast(bf16x8, w);
          w = (u32x4){cvtpk(p0[8], p0[9]), cvtpk(p0[10], p0[11]), cvtpk(p0[12], p0[13]), cvtpk(p0[14], p0[15])}; pa1 = __builtin_bit_cast(bf16x8, w);
          w = (u32x4){cvtpk(p1[0], p1[1]), cvtpk(p1[2], p1[3]), cvtpk(p1[4], p1[5]), cvtpk(p1[6], p1[7])}; pa2 = __builtin_bit_cast(bf16x8, w);
          w = (u32x4){cvtpk(p1[8], p1[9]), cvtpk(p1[10], p1[11]), cvtpk(p1[12], p1[13]), cvtpk(p1[14], p1[15])}; pa3 = __builtin_bit_cast(bf16x8, w); }
        if (x + 3 < NT) asm volatile("s_waitcnt vmcnt(3)" ::: "memory"); else asm volatile("s_waitcnt vmcnt(0)" ::: "memory");
        FBAR();
        __builtin_amdgcn_s_setprio(2);
#define MIX4() do { _Pragma("unroll") for (int i_ = 0; i_ < 4; ++i_) { __builtin_amdgcn_sched_group_barrier(0x008, 1, 0); __builtin_amdgcn_sched_group_barrier(0x400, 2, 0); } } while (0)
        if (x + 1 < NT) QKT();
        SBAR();
        pv_mm(o[0], la, ha, pa0, pa1, pa2, pa3);
        EXP8(p0, 0);
        MIX4(); SBAR();
        pv_rd<2>(la, ha, vb);
        pv_mm(o[1], lb, hb, pa0, pa1, pa2, pa3);
        EXP8(p0, 8);
        MIX4(); SBAR();
        pv_rd<3>(lb, hb, vb);
        __builtin_amdgcn_s_setprio(0);
        asm volatile("s_waitcnt lgkmcnt(8)" ::: "memory"); SBAR();
        pv_mm(o[2], la, ha, pa0, pa1, pa2, pa3);
        EXP8(p1, 0);
        MIX4(); SBAR();
        asm volatile("s_waitcnt lgkmcnt(0)" ::: "memory"); SBAR();
        pv_mm(o[3], lb, hb, pa0, pa1, pa2, pa3);
        EXP8(p1, 8);
        MIX4(); SBAR();
#undef MIX4
        __builtin_amdgcn_s_setprio(0);
        ks_w = (ks_w + 1) & 3; vs_w = (vs_w + 1) & 3;
        kb_r = (kb_r + SHM_K) & (F_NSLOT * SHM_K - 1); vb_r = (vb_r + SHM_V) & (F_NSLOT * SHM_V - 1);
        FBAR();
    }
    if (!trail) FBAR();
    { auto rr = __builtin_amdgcn_permlane32_swap(__float_as_uint(l_reg), __float_as_uint(l_reg), false, false); l_reg = __uint_as_float(rr[0]) + __uint_as_float(rr[1]); }
    l_out = l_reg;
    __syncthreads();
#undef FBAR
#undef DMA_K
#undef DMA_V
#undef KREAD
#undef QKT
#undef EXP8
}

template <int ABL> __device__ __forceinline__ void attn_unit(int b, int h, int qb, const bf16* QH, const bf16* KH, const bf16* VH, bf16* YC, float* OS, const float* subg, float lam, float oscale, char* lds, bool fast) {
    int tid_ = threadIdx.x; asm volatile("" : "+v"(tid_));
    const int tid = tid_, wid = tid >> 6, lane = tid & 63, r32 = lane & 31, hi = lane >> 5;
    const size_t rowbase = (size_t)b * SEQ, q0 = rowbase + (size_t)qb * 256;
    float* wsf = (float*)(lds + F_OFF_WS) + wid * 64;
#pragma unroll 1
    for (int c = 0; c < 2; ++c) {
        f32x16 o[4]; float l;
        const size_t hcb = (size_t)((b * 16 + h * 2 + c)) * SEQ; const bf16* Qp = QH + (hcb + (size_t)qb * 256) * LDQK; const bf16* Kp = KH + hcb * LDQK; const bf16* Vp = VH + (size_t)(b * 8 + h) * SEQ * LDV;
        if (fast) attn_pass_fast<ABL>(Qp, Kp, Vp, lds, o, l);
        else attn_pass(Qp, Kp, Vp, lds, o, l);
        if (hi == 0) wsf[r32] = l; asm volatile("s_waitcnt lgkmcnt(0)" ::: "memory");
        float rli[16];
#pragma unroll
        for (int r = 0; r < 16; ++r) rli[r] = 1.0f / wsf[crow(r, hi)];
        GAS float* os = (GAS float*)OS + (q0 + wid * QBLK + 4 * hi) * GW + h * 128 + r32;
        asm volatile("" : "+v"(os));
        if (c == 0) {
#pragma unroll
            for (int r = 0; r < 16; ++r) { GAS float* p = os + ((r & 3) + 8 * (r >> 2)) * GW; asm volatile("" : "+v"(p));
#pragma unroll
                for (int d0 = 0; d0 < 4; ++d0) p[d0 * 32] = o[d0][r] * rli[r]; }
        } else {
            float ssq[16], ov[16][4];
#pragma unroll
            for (int r = 0; r < 16; ++r) { const GAS float* p = os + ((r & 3) + 8 * (r >> 2)) * GW; asm volatile("" : "+v"(p));
#pragma unroll
                for (int d0 = 0; d0 < 4; ++d0) ov[r][d0] = p[d0 * 32]; }
#pragma unroll
            for (int r = 0; r < 16; ++r) { float s = 0.f;
#pragma unroll
                for (int d0 = 0; d0 < 4; ++d0) { const float v = ov[r][d0] - lam * (o[d0][r] * rli[r]); o[d0][r] = v; s += v * v; }
                ssq[r] = s; }
#pragma unroll
            for (int r = 0; r < 16; ++r) { float s = ssq[r]; s += __shfl_xor(s, 1); s += __shfl_xor(s, 2); s += __shfl_xor(s, 4); s += __shfl_xor(s, 8); s += __shfl_xor(s, 16);
                ssq[r] = oscale / sqrtf(s * (1.f / 128.f) + 1e-6f); }
            GAS bf16* yo = (GAS bf16*)YC + (q0 + wid * QBLK + 4 * hi) * DM + YC_D + h * 128 + r32;
            asm volatile("" : "+v"(yo));
#pragma unroll
            for (int r = 0; r < 16; ++r) { GAS bf16* p = yo + ((r & 3) + 8 * (r >> 2)) * DM; asm volatile("" : "+v"(p));
#pragma unroll
                for (int d0 = 0; d0 < 4; ++d0) p[d0 * 32] = (bf16)f2bf(o[d0][r] * ssq[r] * subg[d0 * 32 + r32]); }
        }
        asm volatile("s_waitcnt vmcnt(0) lgkmcnt(0)" ::: "memory");
    }
}
#undef KSWZ
#undef SBAR
}

__global__ void __launch_bounds__(NWAVES * 64, 2) hybrid_fwd(Args args) {
    extern __shared__ __attribute__((aligned(16))) unsigned char lds[];
    Frame F;
    F.lds = (LAS unsigned char*)lds;
    F.MISC = (volatile LAS unsigned*)(F.lds + MISC_OFF);
    F.tid = threadIdx.x; F.lane = F.tid & 63; F.wave = __builtin_amdgcn_readfirstlane(F.tid >> 6);
    F.G = gridDim.x; { const int bx = blockIdx.x; F.vcu = (F.G % 8 == 0) ? (bx % 8) * (F.G / 8) + bx / 8 : bx; }
    unsigned char* ws = args.ws;
    F.ctl = (gu32*)(ws + WS_CTL);
    for (int u = F.tid; u < (LDS_BYTES - LDSCTL_OFF) / 4; u += NWAVES * 64) ((LAS unsigned*)(F.lds + LDSCTL_OFF))[u] = 0u;
    __syncthreads();
#if MK_SPLIT
#define GRID_BAR() do { } while (0)
#else
    XcdBarrier bar = xcd_barrier_post((unsigned*)(F.ctl + CW_BAR), F.MISC + 8);
#define GRID_BAR() xcd_barrier(bar)
#endif
    const int lo = args.ph_lo, hi = args.ph_hi;
#ifndef PH_MASK
#define PH_MASK 0x1FF
#endif
#define IN(k) (lo <= (k) && (k) < hi)
#define PM(b) ((PH_MASK >> (b)) & 1)
#ifndef LM
#define LM 15
#endif
#ifndef PROBE_DUP
#define PROBE_DUP 0
#endif
#define DUP(b) ((PROBE_DUP >> (b)) & 1)
#ifndef PROBE_XBAR
#define PROBE_XBAR 0
#endif
#define SEAM(k, DI) do { if ((k) + 1 < hi) { seam_steal(F, args, bar, (DI)); for (int xb_ = 0; xb_ < PROBE_XBAR; ++xb_) GRID_BAR(); } } while (0)

    bf16* const XN = (bf16*)(ws + WS_XN); bf16* const Z = (bf16*)(ws + WS_Z); bf16* const YC = (bf16*)(ws + WS_YC); bf16* const HB = (bf16*)(ws + WS_HB);
    float* const OS = (float*)(ws + WS_OS); const float* const rope = (const float*)(ws + WS_ROPE);
    const float* const x_in = args.in[0]; float* const out = args.out;

    bf16* const XB = XN; float* const SS = (float*)(ws + WS_SS);
    if (PM(8) && IN(0)) { p0_prologue(F, args); xprep_phase(F, x_in, XB, SS); if (DUP(8)) { p0_prologue(F, args); xprep_phase(F, x_in, XB, SS); } SEAM(0, 0); }

#define FRESH() do { int t_ = threadIdx.x; asm volatile("" : "+v"(t_)); F.tid = t_; F.lane = t_ & 63; F.wave = __builtin_amdgcn_readfirstlane(t_ >> 6); } while (0)
    for (int l = 0; l < NLAYER; ++l) {
        const int pb = 1 + 5 * l;
        const float* xcur = (l == 0) ? x_in : out;
        const LAS float* rstab = (const LAS float*)(F.lds + RSTAB_OFF);
        if (PM(0) && IN(pb + 0)) { FRESH();
            pg8::Gemm g{XB, (const bf16*)(ws + WS_WIN) + (size_t)l * DIN * DM, M, DIN, DM}; pg8::StaticOrder S; S.init(M, DIN, F.G, (int)blockIdx.x);
            { pg8::Unit u0; S.next(0, u0); rs_table(F, SS, u0.pm); }
            pg8::EpiZ E{Z, DIN, rstab, (float*)(ws + WS_SV), args.in[13] + l * 64, args.in[14] + l * 64, rope, QSCALE, SEQ - 1, 13, (bf16*)(ws + WS_QH), (bf16*)(ws + WS_KH), (bf16*)(ws + WS_VH)};
            pg8::gemm_phase<pg8::EpiZ, pg8::StaticOrder, true, true>(F.lds + RING_OFF, g, S, E);
            if (DUP(0)) pg8::gemm_phase<pg8::EpiZ, pg8::StaticOrder, true, true>(F.lds + RING_OFF, g, S, E);
            SEAM(pb + 0, 0);
        }
        if (PM(2) && IN(pb + 1)) { FRESH();
            float s1 = 0.f, s2 = 0.f;
            for (int i = 0; i < 64; ++i) { s1 += args.in[15][l * 64 + i] * args.in[16][l * 64 + i]; s2 += args.in[17][l * 64 + i] * args.in[18][l * 64 + i]; }
            const float lam_init = (l == 0) ? 0.2f : 0.35550907f;
            const float lam = expf(s1) - expf(s2) + lam_init;
            float gqm = 0.f, gkm = 0.f;
            for (int i = 0; i < 64; ++i) { gqm = fmaxf(gqm, fabsf(args.in[13][l * 64 + i])); gkm = fmaxf(gkm, fabsf(args.in[14][l * 64 + i])); }
            const bool fastsm = (64.0f * gqm * gkm * QSCALE * 1.02f) < 40.0f;
#ifndef ATT_ABL
#define ATT_ABL 0
#endif
            if (DUP(2)) for (int U = F.vcu; U < BATCH * 8 * (SEQ / 256); U += F.G) {
                const int xg = (U % 256) / 32, i = U / 256, qb = U % 32, bh = xg * 2 + i;
                att::attn_unit<ATT_ABL>(bh >> 3, bh & 7, qb, (const bf16*)(ws + WS_QH), (const bf16*)(ws + WS_KH), (const bf16*)(ws + WS_VH), HB, (float*)(ws + WS_HB + 256 * MiB), args.in[19] + l * 128, lam, 1.0f - lam_init, (char*)lds + RING_OFF, fastsm);
            }
            for (int U = F.vcu; U < BATCH * 8 * (SEQ / 256); U += F.G) {
                const int xg = (U % 256) / 32, i = U / 256, qb = U % 32, bh = xg * 2 + i;
                att::attn_unit<0>(bh >> 3, bh & 7, qb, (const bf16*)(ws + WS_QH), (const bf16*)(ws + WS_KH), (const bf16*)(ws + WS_VH), YC, OS, args.in[19] + l * 128, lam, 1.0f - lam_init, (char*)lds + RING_OFF, fastsm);
            }
        }
        if (PM(1) && IN(pb + 1)) { FRESH();
            for (int rep = 0; rep < 1 + DUP(1); ++rep) { FRESH();
            if (LM & 2) for (int u = F.vcu; u < (M / 128) * 4; u += F.G) gmlp_unit(F, Z, YC, (const float*)(ws + WS_SV), (const bf16*)(ws + WS_GWS) + (size_t)l * 8 * 128 * 128, args.in[6] + l * 8 * 128, args.in[3] + l * GW, args.in[4] + l * GW, u, (char*)lds);
            FRESH();
            if (LM & 4) for (int u = F.vcu; u < M / 32; u += F.G) conv_unit(F, Z, YC, args.in[7] + (size_t)l * 31 * GW, args.in[8] + l * GW, args.in[9] + l * GW, args.in[10] + l * GW, u);
            FRESH();
            if (LM & 8) for (int u = F.vcu; u < (M / 64) * 4; u += F.G) pool_unit(F, Z, YC, (const bf16*)(ws + WS_PWT) + (size_t)l * 4 * 65536, args.in[12] + l * GW, u);
            }
            SEAM(pb + 1, cv_deadline(l, 1));
        }
        if (PM(3) && IN(pb + 2)) { FRESH();
            pg8::Gemm g{YC, (const bf16*)(ws + WS_WOUT) + (size_t)l * DM * DM, M, DM, DM}; pg8::StaticOrder S; S.init(M, DM, F.G, (int)blockIdx.x);
            if (l == 0) { typedef pg8::EpiRes<false, false> E_t; E_t E{x_in, nullptr, DM, XB, SS};
                if (DUP(3)) { E_t E2{x_in, nullptr, DM, HB, OS}; pg8::gemm_phase<E_t, pg8::StaticOrder, true, true>(F.lds + RING_OFF, g, S, E2); }
                pg8::gemm_phase<E_t, pg8::StaticOrder, true, true>(F.lds + RING_OFF, g, S, E); }
            else { typedef pg8::EpiRes<true, false> E_t; E_t E{XB, nullptr, DM, XB, SS};
                if (DUP(3)) { E_t E2{XB, nullptr, DM, HB, OS}; pg8::gemm_phase<E_t, pg8::StaticOrder, true, true>(F.lds + RING_OFF, g, S, E2); }
                pg8::gemm_phase<E_t, pg8::StaticOrder, true, true>(F.lds + RING_OFF, g, S, E); }
            SEAM(pb + 2, cv_deadline(l, 2));
        }
        if (PM(4) && IN(pb + 3)) { FRESH();
            pg8::Gemm g{XB, (const bf16*)(ws + WS_WUP) + (size_t)l * DFF * DM, M, DFF, DM}; pg8::StaticOrder S; S.init(M, DFF, F.G, (int)blockIdx.x);
            { pg8::Unit u0; S.next(0, u0); rs_table(F, SS, u0.pm); }
            pg8::EpiRelu2 E{HB, DFF, rstab};
#ifdef PROBE_SPLIT_UP
            { pg8::StaticOrder S1 = S; S1.i1 = 8; pg8::gemm_phase<pg8::EpiRelu2, pg8::StaticOrder, true, true>(F.lds + RING_OFF, g, S1, E); GRID_BAR();
              pg8::StaticOrder S2 = S; S2.i0 = 8; pg8::gemm_phase<pg8::EpiRelu2, pg8::StaticOrder, true, true>(F.lds + RING_OFF, g, S2, E); }
#else
            pg8::gemm_phase<pg8::EpiRelu2, pg8::StaticOrder, true, true>(F.lds + RING_OFF, g, S, E);
#endif
            if (DUP(4)) { if (DUP(10)) { pg8::EpiRelu2T<true> E2{(bf16*)Z, DFF, rstab}; pg8::gemm_phase<pg8::EpiRelu2T<true>, pg8::StaticOrder, true, true>(F.lds + RING_OFF, g, S, E2); }
                          else pg8::gemm_phase<pg8::EpiRelu2, pg8::StaticOrder, true, true>(F.lds + RING_OFF, g, S, E); }
            SEAM(pb + 3, cv_deadline(l, 3));
        }
        if (PM(5) && IN(pb + 4)) { FRESH();
            pg8::Gemm g{HB, (const bf16*)(ws + WS_WDN) + (size_t)l * DM * DFF, M, DM, DFF}; pg8::StaticOrder S; S.init(M, DM, F.G, (int)blockIdx.x);
            if (l + 1 < NLAYER) { typedef pg8::EpiRes<true, false> E_t; E_t E{XB, nullptr, DM, XB, SS};
                if (DUP(5)) { E_t E2{XB, nullptr, DM, YC, OS}; pg8::gemm_phase<E_t, pg8::StaticOrder, true, true>(F.lds + RING_OFF, g, S, E2); }
                pg8::gemm_phase<E_t, pg8::StaticOrder, true, true>(F.lds + RING_OFF, g, S, E); }
            else { typedef pg8::EpiRes<true, true> E_t; E_t E{XB, out, DM, nullptr, nullptr};
                if (DUP(5)) { E_t E2{XB, (float*)Z, DM, nullptr, nullptr}; pg8::gemm_phase<E_t, pg8::StaticOrder, true, true>(F.lds + RING_OFF, g, S, E2); }
                pg8::gemm_phase<E_t, pg8::StaticOrder, true, true>(F.lds + RING_OFF, g, S, E); }
            SEAM(pb + 4, cv_deadline(l + 1, 0));
        }
    }
#ifdef DIAG_STEAL
    if (blockIdx.x == 0 && threadIdx.x == 0) { asm volatile("s_waitcnt vmcnt(0)" ::: "memory"); const unsigned cnt = xb_ld((unsigned*)(F.ctl + CW_Q + 1024)); out[0] = 1000.0f * (float)cnt / (float)CV_TOTAL; }
#endif
#undef IN
#undef SEAM
}

constexpr int N_PHASES = 1 + 5 * NLAYER;
extern "C" void kernel_launch(void* const* d_in, const int* in_sizes, int n_in, void* d_out, int out_size, void* d_ws, size_t ws_size, hipStream_t stream) {
    static int grid = 0;
    if (grid == 0) {
        if (n_in != 24 || in_sizes[0] != M * DM || out_size != M * DM || ws_size < WS_END) { fprintf(stderr, "kernel_launch: unexpected shapes (n_in %d, in0 %d, out %d, ws %zu; need ws >= %zu); nothing launched\n", n_in, n_in > 0 ? in_sizes[0] : -1, out_size, ws_size, (size_t)WS_END); grid = -1; return; }
        int dev = 0, cus = 0, per_cu = 0;
        if (hipGetDevice(&dev) != hipSuccess || hipDeviceGetAttribute(&cus, hipDeviceAttributeMultiprocessorCount, dev) != hipSuccess) { fprintf(stderr, "kernel_launch: device query failed\n"); grid = -1; return; }
        if (hipFuncSetAttribute((const void*)hybrid_fwd, hipFuncAttributeMaxDynamicSharedMemorySize, LDS_BYTES) != hipSuccess) { fprintf(stderr, "kernel_launch: hipFuncSetAttribute failed\n"); grid = -1; return; }
        if (hipOccupancyMaxActiveBlocksPerMultiprocessor(&per_cu, (const void*)hybrid_fwd, NWAVES * 64, LDS_BYTES) != hipSuccess || per_cu < 1)
            fprintf(stderr, "kernel_launch: note: occupancy query reports %d workgroups per CU\n", per_cu);
        (void)hipGetLastError();
        grid = cus;
        if (grid != 256) { fprintf(stderr, "kernel_launch: built for a 256-CU device (one row panel per workgroup in every GEMM phase); found %d CUs; nothing launched\n", cus); grid = -1; return; }
    }
    if (grid < 0) return;
    if (hipMemsetAsync((char*)d_ws + WS_CTL, 0, CTL_ZERO_BYTES, stream) != hipSuccess) { fprintf(stderr, "kernel_launch: memset failed\n"); return; }
    Args a{};
    for (int i = 0; i < 24; ++i) a.in[i] = (const float*)d_in[i];
    a.out = (float*)d_out; a.ws = (unsigned char*)d_ws;
#if MK_SPLIT
    for (int p = 0; p < N_PHASES; ++p) { a.ph_lo = p; a.ph_hi = p + 1; hipLaunchKernelGGL(hybrid_fwd, dim3(grid), dim3(NWAVES * 64), LDS_BYTES, stream, a); }
#else
    a.ph_lo = 0; a.ph_hi = N_PHASES; hipLaunchKernelGGL(hybrid_fwd, dim3(grid), dim3(NWAVES * 64), LDS_BYTES, stream, a);
#endif
    const hipError_t le = hipPeekAtLastError();
    if (le != hipSuccess) fprintf(stderr, "kernel_launch: launch failed: %s\n", hipGetErrorName(le));
}
```
